# Optimizing an MI355X kernel written in HIP

```python
import jax, jax.numpy as jnp
from jax import lax
import numpy as np

D_MODEL = 1024
BATCH = 8
SEQ = 8192
DEPTH = 4

HEAD_DIM = 64
N_FOX_HEADS = D_MODEL // (2 * HEAD_DIM)
N_RET_HEADS = D_MODEL // (2 * HEAD_DIM)
FOX_WIDTH = N_FOX_HEADS * HEAD_DIM
RET_WIDTH = N_RET_HEADS * HEAD_DIM
MIX_WIDTH = FOX_WIDTH + RET_WIDTH
D_FF = -(-8 * D_MODEL // (3 * 128)) * 128
CONV_WIDTH = 3
PLE_DIM = 256
Q_BLOCK = 128
RET_CHUNK = 128
ROPE_BASE = 10000.0
NORM_EPS = 1e-6
GN_EPS = 1e-5
IN_SIZES = (FOX_WIDTH, FOX_WIDTH, FOX_WIDTH, N_FOX_HEADS, RET_WIDTH, RET_WIDTH, RET_WIDTH, RET_WIDTH)
IN_WIDTH = sum(IN_SIZES)
SPLIT_POINTS = tuple(int(v) for v in np.cumsum(IN_SIZES)[:-1])

kernel_name = "hymba_fox_retnet_convffn_ple"


def rms_norm(x, w):
    xf = x.astype(jnp.float32)
    y = xf * lax.rsqrt(jnp.mean(xf * xf, axis=-1, keepdims=True) + NORM_EPS)
    return (y * w.astype(jnp.float32)).astype(x.dtype)


def split_heads(t, n_heads):
    b, s, _ = t.shape
    return t.reshape(b, s, n_heads, HEAD_DIM)


def rotary_tables(seq):
    inv_freq = ROPE_BASE ** (-jnp.arange(0, HEAD_DIM, 2, dtype=jnp.float32) / HEAD_DIM)
    ang = jnp.arange(seq, dtype=jnp.float32)[:, None] * inv_freq[None, :]
    return jnp.cos(ang), jnp.sin(ang)


def apply_rotary(t, cos, sin):
    half = HEAD_DIM // 2
    t1, t2 = t[..., :half], t[..., half:]
    c = cos[None, :, None, :]
    s = sin[None, :, None, :]
    return jnp.concatenate([t1 * c - t2 * s, t1 * s + t2 * c], axis=-1).astype(t.dtype)


def forgetting_attention(q, k, v, f_logit):
    b, s, h, d = q.shape
    q = q.transpose(0, 2, 1, 3)
    k = k.transpose(0, 2, 1, 3)
    v = v.transpose(0, 2, 1, 3)
    log_f = jax.nn.log_sigmoid(f_logit.astype(jnp.float32))
    cum = jnp.cumsum(log_f, axis=1).transpose(0, 2, 1)
    scale = HEAD_DIM ** -0.5
    kpos = jnp.arange(s)
    n_blocks = s // Q_BLOCK

    def one_block(bi):
        start = bi * Q_BLOCK
        qb = lax.dynamic_slice_in_dim(q, start, Q_BLOCK, axis=2)
        cq = lax.dynamic_slice_in_dim(cum, start, Q_BLOCK, axis=2)
        logits = jnp.einsum('bhqd,bhkd->bhqk', qb, k).astype(jnp.float32) * scale
        logits = logits + cq[..., :, None] - cum[..., None, :]
        qpos = start + jnp.arange(Q_BLOCK)
        logits = jnp.where(kpos[None, :] <= qpos[:, None], logits, -jnp.inf)
        probs = jax.nn.softmax(logits, axis=-1)
        return jnp.einsum('bhqk,bhkd->bhqd', probs.astype(v.dtype), v)

    out = lax.map(one_block, jnp.arange(n_blocks))
    return out.transpose(1, 0, 3, 2, 4).reshape(b, s, h * d)


def chunkwise_retention(q, k, v, log_gamma):
    b, s, h, d = q.shape
    n_chunks = s // RET_CHUNK

    def to_chunks(t):
        return t.reshape(b, n_chunks, RET_CHUNK, h, d).transpose(1, 0, 3, 2, 4)

    idx = jnp.arange(RET_CHUNK, dtype=jnp.float32)
    rel = idx[:, None] - idx[None, :]
    lg = log_gamma[:, None, None]
    intra_decay = jnp.where(rel >= 0, jnp.exp(lg * jnp.maximum(rel, 0.0)), 0.0)
    q_decay = jnp.exp(log_gamma[:, None] * (idx + 1.0))
    k_decay = jnp.exp(log_gamma[:, None] * (RET_CHUNK - 1.0 - idx))
    chunk_decay = jnp.exp(log_gamma * RET_CHUNK)

    def step(state, qkv):
        qc, kc, vc = qkv
        scores = jnp.einsum('bhid,bhjd->bhij', qc, kc) * intra_decay
        inner = jnp.einsum('bhij,bhje->bhie', scores, vc)
        cross = jnp.einsum('bhid,bhde->bhie', qc, state) * q_decay[:, :, None]
        new_state = state * chunk_decay[:, None, None] + jnp.einsum(
            'bhjd,bhje->bhde', kc * k_decay[:, :, None], vc)
        return new_state, inner + cross

    state0 = jnp.zeros((b, h, d, d), jnp.float32)
    _, out = lax.scan(step, state0, (to_chunks(q), to_chunks(k), to_chunks(v)))
    return out.transpose(1, 0, 3, 2, 4).reshape(b, s, h, d)


def head_group_norm(y):
    yf = y.astype(jnp.float32)
    mu = jnp.mean(yf, axis=-1, keepdims=True)
    var = jnp.mean(jnp.square(yf - mu), axis=-1, keepdims=True)
    return (yf - mu) * lax.rsqrt(var + GN_EPS)


def causal_depthwise_conv(a, w, bias):
    s = a.shape[1]
    ap = jnp.pad(a, ((0, 0), (CONV_WIDTH - 1, 0), (0, 0)))
    y = bias
    for j in range(CONV_WIDTH):
        y = y + ap[:, j:j + s, :] * w[j]
    return y


def gated_conv_ffn(u, w_up, conv_w, conv_b, w_down):
    up = u @ w_up
    a, g = up[..., :D_FF], up[..., D_FF:]
    a = causal_depthwise_conv(a, conv_w, conv_b)
    return (jax.nn.gelu(a, approximate=False) * g) @ w_down


def setup_inputs(seed: int = 0) -> dict:
    key = jax.random.key(seed)
    ks = jax.random.split(key, 16)
    nrm = jax.random.normal
    f32 = jnp.float32
    return {
        'x': nrm(ks[0], (BATCH, SEQ, D_MODEL), f32),
        'p': nrm(ks[1], (DEPTH, BATCH, SEQ, PLE_DIM), f32),
        'attn_norm_w': 1.0 + 0.05 * nrm(ks[2], (DEPTH, D_MODEL), f32),
        'w_in': nrm(ks[3], (DEPTH, D_MODEL, IN_WIDTH), f32) * D_MODEL ** -0.5,
        'forget_bias': 2.0 + 0.1 * nrm(ks[4], (DEPTH, N_FOX_HEADS), f32),
        'w_out': nrm(ks[5], (DEPTH, MIX_WIDTH, D_MODEL), f32) * MIX_WIDTH ** -0.5,
        'ffn_norm_w': 1.0 + 0.05 * nrm(ks[6], (DEPTH, D_MODEL), f32),
        'w_up': nrm(ks[7], (DEPTH, D_MODEL, 2 * D_FF), f32) * D_MODEL ** -0.5,
        'conv_w': nrm(ks[8], (DEPTH, CONV_WIDTH, D_FF), f32) * CONV_WIDTH ** -0.5,
        'conv_b': 0.01 * nrm(ks[9], (DEPTH, D_FF), f32),
        'w_down': nrm(ks[10], (DEPTH, D_FF, D_MODEL), f32) * D_FF ** -0.5,
        'ple_norm_w': 1.0 + 0.05 * nrm(ks[11], (DEPTH, D_MODEL), f32),
        'w_ple_gate': nrm(ks[12], (DEPTH, D_MODEL, D_MODEL), f32) * D_MODEL ** -0.5,
        'w_ple_proj': nrm(ks[13], (DEPTH, PLE_DIM, D_MODEL), f32) * PLE_DIM ** -0.5,
        'final_norm_w': 1.0 + 0.05 * nrm(ks[14], (D_MODEL,), f32),
    }


def reference(x, p, attn_norm_w, w_in, forget_bias, w_out, ffn_norm_w, w_up, conv_w, conv_b,
              w_down, ple_norm_w, w_ple_gate, w_ple_proj, final_norm_w):
    seq = x.shape[1]
    cos, sin = rotary_tables(seq)
    log_gamma = jnp.log1p(-jnp.exp2(-5.0 - jnp.arange(N_RET_HEADS, dtype=jnp.float32)))
    h = x
    for i in range(DEPTH):
        u = rms_norm(h, attn_norm_w[i])
        proj = u @ w_in[i]
        fq, fk, fv, f_logit, rq, rk, rv, rg = jnp.split(proj, SPLIT_POINTS, axis=-1)
        fox = forgetting_attention(split_heads(fq, N_FOX_HEADS), split_heads(fk, N_FOX_HEADS),
                                   split_heads(fv, N_FOX_HEADS), f_logit + forget_bias[i])
        rq_h = apply_rotary(split_heads(rq, N_RET_HEADS), cos, sin)
        rk_h = apply_rotary(split_heads(rk, N_RET_HEADS), cos, sin) * (HEAD_DIM ** -0.5)
        ret = chunkwise_retention(rq_h, rk_h, split_heads(rv, N_RET_HEADS), log_gamma)
        ret = head_group_norm(ret).reshape(ret.shape[0], seq, RET_WIDTH)
        ret = (jax.nn.silu(rg.astype(jnp.float32)) * ret).astype(x.dtype)
        mixed = jnp.concatenate([fox.astype(x.dtype), ret], axis=-1)
        h = h + mixed @ w_out[i]
        h = h + gated_conv_ffn(rms_norm(h, ffn_norm_w[i]), w_up[i], conv_w[i], conv_b[i], w_down[i])
        gate = jax.nn.sigmoid(rms_norm(h, ple_norm_w[i]) @ w_ple_gate[i])
        h = h + gate * (p[i] @ w_ple_proj[i])
    return rms_norm(h, final_norm_w)
```

```cpp
#include <hip/hip_runtime.h>
#include <cstdio>
#include <cstdint>
namespace pg8 {
#define PG8_LAS __attribute__((address_space(3)))
typedef unsigned short bf16_t;
typedef short bf16x8 __attribute__((ext_vector_type(8)));
typedef float f32x4 __attribute__((ext_vector_type(4)));
typedef unsigned u32x4 __attribute__((ext_vector_type(4)));
constexpr int BM = 256, BK = 64, HALF = 128, HTB = HALF * BK * 2  , STAGE_BYTES = 8 * HTB, NXCD = 8, WGM = 8;

__host__ __device__ __forceinline__ int lds_byte(int r, int c) { const int st = (r >> 4) * 2 + (c >> 5), rr = r & 15, cc = c & 31, ob = rr * 64 + cc * 2; return st * 1024 + (ob ^ (((ob >> 9) & 1) << 5)); }
__host__ __device__ __forceinline__ void stage_rc(int b, int& R, int& C) { const int st = b / 1024, sb = b % 1024, swz = sb ^ (((sb >> 9) & 1) << 5); R = (st >> 1) * 16 + swz / 64; C = (st & 1) * 32 + (swz % 64) / 2; }
__host__ __device__ __forceinline__ int perm32(int rho) { const int n = rho >> 4, i = rho & 15; return 8 * (i >> 2) + 4 * n + (i & 3); }

struct Unit { int pm, pn; };
struct Gemm { const bf16_t* A; const bf16_t* Bt; int M, N, K; };

struct StaticOrder {
    int nM, nN, nwg, G, c;
    __host__ __device__ void init(int M, int N, int G_, int c_) { nM = M / BM; nN = N / BM; nwg = nM * nN; G = G_; c = c_; }
    __host__ __device__ bool next(int i, Unit& u) const {
        const long L = (long)i * G + c; if (L >= nwg) return false;
        int wgid = (int)L; { const int q = nwg / NXCD, r = nwg % NXCD, xcd = wgid % NXCD, off = wgid / NXCD; wgid = (xcd < r ? xcd * (q + 1) : r * (q + 1) + (xcd - r) * q) + off; }
        const int nig = WGM * nN, gid = wgid / nig, fm = gid * WGM, gsz = (nM - fm) < WGM ? (nM - fm) : WGM;
        u.pm = fm + ((wgid % nig) % gsz); u.pn = (wgid % nig) / gsz; return true;
    }
    __device__ __forceinline__ void a_ready(const Unit&) const {}
    __device__ __forceinline__ void done(const Unit&) const {}
};

__device__ __forceinline__ unsigned cvt_pk_bf16(float lo, float hi) { unsigned r; asm volatile("v_cvt_pk_bf16_f32 %0, %1, %2" : "=v"(r) : "v"(lo), "v"(hi)); return r; }
typedef float f32x2 __attribute__((ext_vector_type(2)));
__device__ __forceinline__ f32x2 gelu_pk(f32x2 v) {
    const f32x2 av = __builtin_elementwise_abs(v), d = av * 0.2316418882f + 1.0f;
    f32x2 t; t.x = __builtin_amdgcn_rcpf(d.x); t.y = __builtin_amdgcn_rcpf(d.y);
    f32x2 q = t * 0.5307027145f + (-0.7265760135f); q = q * t + 0.7107068705f; q = q * t + (-0.142248368f); q = q * t + 0.127414796f; q = q * t;
    const f32x2 s = (v * v) * (-0.72134752044f);
    f32x2 e; e.x = __builtin_amdgcn_exp2f(s.x); e.y = __builtin_amdgcn_exp2f(s.y);
    const f32x2 m = v * (q * e), r = v - m;
    f32x2 o; o.x = v.x < 0.f ? m.x : r.x; o.y = v.y < 0.f ? m.y : r.y; return o;
}

template <int ACT  > struct EpiBf16 {
    static constexpr bool PERM = true, AFTER_DRAIN = false; static_assert(ACT == 0 || ACT == 1, "EpiBf16: ACT is 0 (none) or 1 (gelu_pk)");
    bf16_t* O; int ldc; const float* bias; int split_cols; size_t split_stride; float scale0;
    __device__ __forceinline__ void operator()(const f32x4 (&acc)[2][2][4][2], const Unit& u, int wr, int wc, int fr, int fq) const {
        const int row0 = u.pm * BM + wr * 64 + fr; int colt = u.pn * BM; bf16_t* base = O;
        float sc = 1.f; if (split_cols) { const int t = colt / split_cols; base += (size_t)t * split_stride; colt -= t * split_cols; if (t == 0) sc = scale0; }
        const int col0 = colt + wc * 32 + 8 * fq, bcol0 = u.pn * BM + wc * 32 + 8 * fq;
        f32x4 bv[2][2];
#pragma unroll
        for (int bj = 0; bj < 2; ++bj)
#pragma unroll
            for (int n = 0; n < 2; ++n) bv[bj][n] = bias ? *(const f32x4*)(bias + bcol0 + bj * HALF + 4 * n) : (f32x4){0.f, 0.f, 0.f, 0.f};
#pragma unroll
        for (int ai = 0; ai < 2; ++ai)
#pragma unroll
            for (int m = 0; m < 4; ++m) { bf16_t* rowp = base + (size_t)(row0 + ai * HALF + m * 16) * ldc + col0;
#pragma unroll
                for (int bj = 0; bj < 2; ++bj) { f32x4 v0 = acc[ai][bj][m][0] + bv[bj][0], v1 = acc[ai][bj][m][1] + bv[bj][1];
                    if (ACT == 1) { f32x2 a = gelu_pk((f32x2){v0[0], v0[1]}), b = gelu_pk((f32x2){v0[2], v0[3]}), c = gelu_pk((f32x2){v1[0], v1[1]}), d = gelu_pk((f32x2){v1[2], v1[3]});
                        v0 = (f32x4){a.x, a.y, b.x, b.y}; v1 = (f32x4){c.x, c.y, d.x, d.y}; }
                    v0 = v0 * sc; v1 = v1 * sc; u32x4 w; w.x = cvt_pk_bf16(v0[0], v0[1]); w.y = cvt_pk_bf16(v0[2], v0[3]); w.z = cvt_pk_bf16(v1[0], v1[1]); w.w = cvt_pk_bf16(v1[2], v1[3]);
                    *(u32x4*)(rowp + bj * HALF) = w; } }
    }
};
constexpr float ATT_C2 = 0.125f * 1.4426950408889634f;
constexpr float RMS_EPS = 1e-6f;
__device__ __forceinline__ float lg2gamma(int h) { const float x = __builtin_amdgcn_exp2f(-5.0f - (float)h);
    return -x * (1.0f + x * (0.5f + x * (0.33333334f + x * (0.25f + x * (0.2f + x * 0.16666667f))))) * 1.4426950408889634f; }
__device__ __forceinline__ float row_rstd(const float* ssq16, int row) {
    const f32x4* p = (const f32x4*)(ssq16 + (size_t)row * 16);
    const f32x4 a = p[0], b = p[1], c = p[2], d = p[3];
    const float s = (((a[0] + a[1]) + (a[2] + a[3])) + ((b[0] + b[1]) + (b[2] + b[3]))) + (((c[0] + c[1]) + (c[2] + c[3])) + ((d[0] + d[1]) + (d[2] + d[3])));
    return __builtin_amdgcn_rsqf(s * (1.0f / 1024.0f) + RMS_EPS);
}
__device__ __forceinline__ u32x4 pack8(const f32x4& v0, const f32x4& v1) { u32x4 w; w.x = cvt_pk_bf16(v0[0], v0[1]); w.y = cvt_pk_bf16(v0[2], v0[3]); w.z = cvt_pk_bf16(v1[0], v1[1]); w.w = cvt_pk_bf16(v1[2], v1[3]); return w; }
__device__ __forceinline__ float bf_lo(unsigned w) { return __uint_as_float(w << 16); }
__device__ __forceinline__ float bf_hi(unsigned w) { return __uint_as_float(w & 0xffff0000u); }
__device__ __forceinline__ void unpack8(const u32x4& w, f32x4& v0, f32x4& v1) { v0 = (f32x4){bf_lo(w.x), bf_hi(w.x), bf_lo(w.y), bf_hi(w.y)}; v1 = (f32x4){bf_lo(w.z), bf_hi(w.z), bf_lo(w.w), bf_hi(w.w)}; }
__device__ __forceinline__ float sigmoidf_(float x) { return __builtin_amdgcn_rcpf(1.0f + __expf(-x)); }

struct EpiIn {
    static constexpr bool PERM = true, AFTER_DRAIN = false;
    bf16_t *QO, *KK, *VV, *G; const float* ssq; const float* cs;
    template <int TYPE> __device__ __forceinline__ void run(const f32x4 (&acc)[2][2][4][2], const Unit& u, int wr, int wc, int fr, int fq) const {
        const int half = u.pn & 1, row0 = u.pm * BM + wr * 64 + fr, csub0 = half * 256 + wc * 32 + 8 * fq, jj = 4 * (wc & 1) + fq;
        float lgv[2] = {0.f, 0.f};
        if (TYPE == 3 || TYPE == 4) { lgv[0] = lg2gamma(csub0 >> 6); lgv[1] = lg2gamma((csub0 + 128) >> 6); }
#pragma unroll
        for (int ai = 0; ai < 2; ++ai)
#pragma unroll
            for (int m = 0; m < 4; ++m) {
                const int row = row0 + ai * HALF + m * 16; const float rs = row_rstd(ssq, row);
                f32x4 cv = (f32x4){0.f, 0.f, 0.f, 0.f}, sv = cv; float i1 = 0.f;
                if (TYPE == 3 || TYPE == 4) { const int pos = row & 8191; cv = *(const f32x4*)(cs + pos * 32 + 4 * jj); sv = *(const f32x4*)(cs + 8192 * 32 + pos * 32 + 4 * jj); i1 = (float)((row & 127) + 1); }
#pragma unroll
                for (int bj = 0; bj < 2; ++bj) {
                    f32x4 v0 = acc[ai][bj][m][0] * rs, v1 = acc[ai][bj][m][1] * rs;
                    const int csub = csub0 + bj * 128; bf16_t* dst;
                    if (TYPE == 0) { v0 = v0 * ATT_C2; v1 = v1 * ATT_C2; dst = QO + (size_t)row * 1024 + csub; }
                    else if (TYPE == 1) dst = KK + (size_t)row * 1024 + csub;
                    else if (TYPE == 2) dst = VV + (size_t)row * 1024 + csub;
                    else if (TYPE == 3 || TYPE == 4) {
                        const f32x4 o0 = v0 * cv - v1 * sv, o1 = v0 * sv + v1 * cv;
                        const float lg = lgv[bj];
                        const float f = (TYPE == 3) ? __builtin_amdgcn_exp2f(i1 * lg) : 0.125f * __builtin_amdgcn_exp2f(-i1 * lg);
                        v0 = o0 * f; v1 = o1 * f; dst = (TYPE == 3 ? QO : KK) + (size_t)row * 1024 + 512 + csub;
                    }
                    else if (TYPE == 5) dst = VV + (size_t)row * 1024 + 512 + csub;
                    else {
#pragma unroll
                        for (int i = 0; i < 4; ++i) { v0[i] = v0[i] * sigmoidf_(v0[i]); v1[i] = v1[i] * sigmoidf_(v1[i]); }
                        dst = G + (size_t)row * 512 + csub;
                    }
                    *(u32x4*)dst = pack8(v0, v1);
                }
            }
    }
    __device__ __forceinline__ void operator()(const f32x4 (&acc)[2][2][4][2], const Unit& u, int wr, int wc, int fr, int fq) const {
        switch (u.pn >> 1) { case 0: run<0>(acc, u, wr, wc, fr, fq); break; case 1: run<1>(acc, u, wr, wc, fr, fq); break; case 2: run<2>(acc, u, wr, wc, fr, fq); break; case 3: run<3>(acc, u, wr, wc, fr, fq); break;
            case 4: run<4>(acc, u, wr, wc, fr, fq); break; case 5: run<5>(acc, u, wr, wc, fr, fq); break; default: run<6>(acc, u, wr, wc, fr, fq); break; }
    }
};

template <int MODE> struct EpiRes {
    static constexpr bool PERM = true, AFTER_DRAIN = false;
    const float* base; float* out; bf16_t* hb; float* ssqw; const float* ssqr; const bf16_t* pp;
    __device__ __forceinline__ void operator()(const f32x4 (&acc)[2][2][4][2], const Unit& u, int wr, int wc, int fr, int fq) const {
        const int row0 = u.pm * BM + wr * 64 + fr, col0 = u.pn * BM + wc * 32 + 8 * fq;
#pragma unroll
        for (int ai = 0; ai < 2; ++ai)
#pragma unroll
            for (int m = 0; m < 4; ++m) {
                const int row = row0 + ai * HALF + m * 16; float sq = 0.f; float rs = 1.f; if (MODE == 1) rs = row_rstd(ssqr, row);
#pragma unroll
                for (int bj = 0; bj < 2; ++bj) {
                    const size_t off = (size_t)row * 1024 + col0 + bj * HALF;
                    const f32x4 h0 = *(const f32x4*)(base + off), h1 = *(const f32x4*)(base + off + 4);
                    f32x4 a0 = acc[ai][bj][m][0], a1 = acc[ai][bj][m][1];
                    if (MODE == 1) { f32x4 p0, p1; unpack8(*(const u32x4*)(pp + off), p0, p1);
#pragma unroll
                        for (int i = 0; i < 4; ++i) { a0[i] = sigmoidf_(a0[i] * rs) * p0[i]; a1[i] = sigmoidf_(a1[i] * rs) * p1[i]; } }
                    const f32x4 v0 = h0 + a0, v1 = h1 + a1;
                    *(f32x4*)(out + off) = v0; *(f32x4*)(out + off + 4) = v1; *(u32x4*)(hb + off) = pack8(v0, v1);
                    sq += ((v0[0] * v0[0] + v0[1] * v0[1]) + (v0[2] * v0[2] + v0[3] * v0[3])) + ((v1[0] * v1[0] + v1[1] * v1[1]) + (v1[2] * v1[2] + v1[3] * v1[3]));
                }
                sq += __shfl_xor(sq, 16); sq += __shfl_xor(sq, 32);
                if (fq == 0) ssqw[(size_t)row * 16 + u.pn * 4 + wc] = sq;
            }
    }
};

struct EpiScaleBf16 {
    static constexpr bool PERM = true, AFTER_DRAIN = false;
    bf16_t* O; int ldo; const float* ssq;
    __device__ __forceinline__ void operator()(const f32x4 (&acc)[2][2][4][2], const Unit& u, int wr, int wc, int fr, int fq) const {
        const int row0 = u.pm * BM + wr * 64 + fr, col0 = u.pn * BM + wc * 32 + 8 * fq;
#pragma unroll
        for (int ai = 0; ai < 2; ++ai)
#pragma unroll
            for (int m = 0; m < 4; ++m) {
                const int row = row0 + ai * HALF + m * 16; const float rs = row_rstd(ssq, row);
#pragma unroll
                for (int bj = 0; bj < 2; ++bj) *(u32x4*)(O + (size_t)row * ldo + col0 + bj * HALF) = pack8(acc[ai][bj][m][0] * rs, acc[ai][bj][m][1] * rs);
            }
    }
};

struct EpiGate {
    static constexpr bool PERM = true, AFTER_DRAIN = false;
    const bf16_t* A; bf16_t* O; const float* ssq; const float* cw; const float* cb;
    __device__ __forceinline__ void operator()(const f32x4 (&acc)[2][2][4][2], const Unit& u, int wr, int wc, int fr, int fq) const {
        constexpr int FF = 2816;
        const int row0 = u.pm * BM + wr * 64 + fr, col0 = u.pn * BM + wc * 32 + 8 * fq;
#pragma unroll
        for (int bj = 0; bj < 2; ++bj) {
            const int col = col0 + bj * HALF;
            f32x4 w0[2], w1[2], w2[2], bb[2];
#pragma unroll
            for (int n = 0; n < 2; ++n) { w0[n] = *(const f32x4*)(cw + col + 4 * n); w1[n] = *(const f32x4*)(cw + FF + col + 4 * n); w2[n] = *(const f32x4*)(cw + 2 * FF + col + 4 * n); bb[n] = *(const f32x4*)(cb + col + 4 * n); }
#pragma unroll
            for (int ai = 0; ai < 2; ++ai)
#pragma unroll
                for (int m = 0; m < 4; ++m) {
                    const int row = row0 + ai * HALF + m * 16, pos = row & 8191;
                    const int r1 = pos >= 1 ? row - 1 : row, r2 = pos >= 2 ? row - 2 : row;
                    const float k1 = pos >= 1 ? 1.f : 0.f, k2 = pos >= 2 ? 1.f : 0.f, rs = row_rstd(ssq, row);
                    const u32x4 ac = *(const u32x4*)(A + (size_t)row * FF + col), ap = *(const u32x4*)(A + (size_t)r1 * FF + col), aq = *(const u32x4*)(A + (size_t)r2 * FF + col);
                    f32x4 y0 = bb[0] + w2[0] * (f32x4){bf_lo(ac.x), bf_hi(ac.x), bf_lo(ac.y), bf_hi(ac.y)} + (w1[0] * (f32x4){bf_lo(ap.x), bf_hi(ap.x), bf_lo(ap.y), bf_hi(ap.y)}) * k1 + (w0[0] * (f32x4){bf_lo(aq.x), bf_hi(aq.x), bf_lo(aq.y), bf_hi(aq.y)}) * k2;
                    f32x4 y1 = bb[1] + w2[1] * (f32x4){bf_lo(ac.z), bf_hi(ac.z), bf_lo(ac.w), bf_hi(ac.w)} + (w1[1] * (f32x4){bf_lo(ap.z), bf_hi(ap.z), bf_lo(ap.w), bf_hi(ap.w)}) * k1 + (w0[1] * (f32x4){bf_lo(aq.z), bf_hi(aq.z), bf_lo(aq.w), bf_hi(aq.w)}) * k2;
                    const f32x2 ga = gelu_pk((f32x2){y0[0], y0[1]}), gb = gelu_pk((f32x2){y0[2], y0[3]}), gc = gelu_pk((f32x2){y1[0], y1[1]}), gd = gelu_pk((f32x2){y1[2], y1[3]});
                    const f32x4 g0 = acc[ai][bj][m][0] * rs, g1 = acc[ai][bj][m][1] * rs;
                    const f32x4 o0 = (f32x4){ga.x, ga.y, gb.x, gb.y} * g0, o1 = (f32x4){gc.x, gc.y, gd.x, gd.y} * g1;
                    *(u32x4*)(O + (size_t)row * FF + col) = pack8(o0, o1);
                    asm volatile("" ::: "memory");
                }
        }
    }
};
template <class Epi, class Sched, bool ALIGN_EPI = false, bool SP2 = false>
__device__ __forceinline__ void gemm_phase(PG8_LAS unsigned char* lds, const Gemm g, const Sched& S, const Epi& E) {
    int tid = threadIdx.x; asm volatile("" : "+v"(tid));
    const int wid = __builtin_amdgcn_readfirstlane(tid >> 6), lane = tid & 63, wr = wid >> 2, wc = wid & 3, fr = lane & 15, fq = lane >> 4;
    const int K = g.K, nt = K / BK;
    unsigned voffA[2], voffB[2];
#pragma unroll
    for (int i = 0; i < 2; ++i) { int R, C; stage_rc(tid * 16 + i * 8192, R, C); const int Rb = Epi::PERM ? ((R & ~31) + perm32(R & 31)) : R;
        voffA[i] = (unsigned)(R * K + C) * 2u; voffB[i] = (unsigned)(Rb * K + C) * 2u; }
    const size_t kstep = (size_t)(BK * 2);
    const size_t hstep = (size_t)HALF * K * 2;
    const size_t tstep = 2 * hstep;
    const unsigned ldsw = (unsigned)wid * 1024u;
    const int aoff = lds_byte(wr * 64 + fr, fq * 8), boff = lds_byte(wc * 32 + fr, fq * 8);
#define PG8_SA(b, h) (((b) * 2 + (h)) * HTB)
#define PG8_SB(b, h) ((4 + (b) * 2 + (h)) * HTB)
#define PG8_STAGE(bufoff, gbase, voff) do { _Pragma("unroll") for (int _i = 0; _i < 2; ++_i) \
        __builtin_amdgcn_global_load_lds((const unsigned*)((const char*)(gbase) + (voff)[_i]), (PG8_LAS unsigned*)(lds + (bufoff) + ldsw + _i * 8192), 16, 0, 0); } while (0)
#define PG8_LDA(dst, b, h) do { _Pragma("unroll") for (int m = 0; m < 4; ++m) _Pragma("unroll") for (int k = 0; k < 2; ++k) dst[m][k] = *(const PG8_LAS bf16x8*)(lds + PG8_SA(b, h) + aoff + m * 2048 + k * 1024); } while (0)
#define PG8_LDB(dst, b, h) do { _Pragma("unroll") for (int n = 0; n < 2; ++n) _Pragma("unroll") for (int k = 0; k < 2; ++k) dst[n][k] = *(const PG8_LAS bf16x8*)(lds + PG8_SB(b, h) + boff + n * 2048 + k * 1024); } while (0)
#define PG8_MMA(ai, bj, At, Bt) do { __builtin_amdgcn_s_setprio(1); _Pragma("unroll") for (int m = 0; m < 4; ++m) _Pragma("unroll") for (int n = 0; n < 2; ++n) _Pragma("unroll") for (int k = 0; k < 2; ++k) \
        acc[ai][bj][m][n] = __builtin_amdgcn_mfma_f32_16x16x32_bf16(Bt[n][k], At[m][k], acc[ai][bj][m][n], 0, 0, 0); __builtin_amdgcn_s_setprio(0); } while (0)
#define PG8_WAIT_V(n) asm volatile("s_waitcnt vmcnt(" #n ")" ::: "memory")
#define PG8_WAIT_L(n) asm volatile("s_waitcnt lgkmcnt(" #n ")" ::: "memory")
#define PG8_BAR __builtin_amdgcn_s_barrier()
#define PG8_SCHED __builtin_amdgcn_sched_barrier(0)
    Unit cur, nxt; int ui = 0;
    if (!S.next(0, cur)) return;
    f32x4 acc[2][2][4][2];
#pragma unroll
    for (int a = 0; a < 2; ++a)
#pragma unroll
        for (int b = 0; b < 2; ++b)
#pragma unroll
            for (int m = 0; m < 4; ++m)
#pragma unroll
                for (int n = 0; n < 2; ++n) acc[a][b][m][n] = (f32x4){0.f, 0.f, 0.f, 0.f};
    bf16x8 At[4][2], B0[2][2], B1[2][2];
    const char* cA = (const char*)g.A + (size_t)cur.pm * tstep; const char* cB = (const char*)g.Bt + (size_t)cur.pn * tstep;
    S.a_ready(cur);
    if constexpr (SP2) {
        PG8_STAGE(PG8_SB(0, 0), cB, voffB); PG8_STAGE(PG8_SB(0, 1), cB + hstep, voffB); PG8_STAGE(PG8_SA(0, 0), cA, voffA); PG8_STAGE(PG8_SA(0, 1), cA + hstep, voffA);
        if (wr == 1) PG8_BAR;
        PG8_WAIT_V(2); PG8_BAR;
        PG8_STAGE(PG8_SB(1, 0), cB + kstep, voffB); PG8_STAGE(PG8_SA(1, 0), cA + kstep, voffA); PG8_STAGE(PG8_SB(1, 1), cB + hstep + kstep, voffB);
        PG8_WAIT_V(6); PG8_BAR;
    } else {
        PG8_STAGE(PG8_SB(0, 0), cB, voffB); PG8_STAGE(PG8_SA(0, 0), cA, voffA); PG8_STAGE(PG8_SB(0, 1), cB + hstep, voffB); PG8_STAGE(PG8_SA(0, 1), cA + hstep, voffA);
        if (wr == 1) PG8_BAR;
        PG8_WAIT_V(4); PG8_BAR;
        PG8_STAGE(PG8_SB(1, 0), cB + kstep, voffB); PG8_STAGE(PG8_SA(1, 0), cA + kstep, voffA); PG8_STAGE(PG8_SB(1, 1), cB + hstep + kstep, voffB);
        PG8_WAIT_V(6); PG8_BAR;
    }
    for (;;) {
        const bool has_next = S.next(ui + 1, nxt);
        const char* nA = has_next ? (const char*)g.A + (size_t)nxt.pm * tstep : cA; const char* nB = has_next ? (const char*)g.Bt + (size_t)nxt.pn * tstep : cB;
        for (int t = 0; t < nt; t += 2) {
            const bool last = (t == nt - 2);
            const char* a1 = cA + (size_t)(t + 1) * kstep;
            const char* a2 = last ? nA : cA + (size_t)(t + 2) * kstep; const char* b2 = last ? nB : cB + (size_t)(t + 2) * kstep;
            const char* a3 = a2 + kstep; const char* b3 = b2 + kstep;
            if (last && has_next) S.a_ready(nxt);
            if constexpr (SP2) {
            PG8_LDB(B0, 0, 0); PG8_LDB(B1, 0, 1); PG8_SCHED; PG8_LDA(At, 0, 0); PG8_STAGE(PG8_SA(1, 1), a1 + hstep, voffA);
            PG8_WAIT_V(8); PG8_WAIT_L(0); PG8_BAR; PG8_MMA(0, 0, At, B0); PG8_MMA(0, 1, At, B1); PG8_BAR; PG8_SCHED;
            PG8_LDA(At, 0, 1); PG8_STAGE(PG8_SB(0, 0), b2, voffB); PG8_STAGE(PG8_SB(0, 1), b2 + hstep, voffB); PG8_STAGE(PG8_SA(0, 0), a2, voffA);
            PG8_WAIT_V(8); PG8_WAIT_L(0); PG8_BAR; PG8_MMA(1, 0, At, B0); PG8_MMA(1, 1, At, B1); PG8_BAR; PG8_SCHED;
            PG8_LDB(B0, 1, 0); PG8_LDB(B1, 1, 1); PG8_SCHED; PG8_LDA(At, 1, 0); PG8_STAGE(PG8_SA(0, 1), a2 + hstep, voffA);
            PG8_WAIT_V(8); PG8_WAIT_L(0); PG8_BAR; PG8_MMA(0, 0, At, B0); PG8_MMA(0, 1, At, B1); PG8_BAR; PG8_SCHED;
            PG8_LDA(At, 1, 1); PG8_STAGE(PG8_SB(1, 0), b3, voffB); PG8_STAGE(PG8_SB(1, 1), b3 + hstep, voffB); PG8_STAGE(PG8_SA(1, 0), a3, voffA);
            PG8_WAIT_V(8); PG8_WAIT_L(0); PG8_BAR; PG8_MMA(1, 0, At, B0); PG8_MMA(1, 1, At, B1); PG8_BAR; PG8_SCHED;
            } else {
            PG8_LDB(B0, 0, 0); PG8_SCHED; PG8_LDA(At, 0, 0); PG8_STAGE(PG8_SA(1, 1), a1 + hstep, voffA);
            PG8_WAIT_L(8); PG8_BAR; PG8_WAIT_L(0); PG8_MMA(0, 0, At, B0); PG8_BAR; PG8_SCHED;
            PG8_LDB(B1, 0, 1); PG8_STAGE(PG8_SB(0, 0), b2, voffB);
            PG8_BAR; PG8_WAIT_L(0); PG8_MMA(0, 1, At, B1); PG8_BAR;
            PG8_LDA(At, 0, 1); PG8_STAGE(PG8_SA(0, 0), a2, voffA);
            PG8_BAR; PG8_WAIT_L(0); PG8_MMA(1, 0, At, B0); PG8_BAR; PG8_SCHED;
            PG8_STAGE(PG8_SB(0, 1), b2 + hstep, voffB);
            PG8_WAIT_V(6); PG8_BAR; PG8_MMA(1, 1, At, B1); PG8_BAR;
            PG8_LDB(B0, 1, 0); PG8_SCHED; PG8_LDA(At, 1, 0); PG8_STAGE(PG8_SA(0, 1), a2 + hstep, voffA);
            PG8_WAIT_L(8); PG8_BAR; PG8_WAIT_L(0); PG8_MMA(0, 0, At, B0); PG8_BAR; PG8_SCHED;
            PG8_LDB(B1, 1, 1); PG8_STAGE(PG8_SB(1, 0), b3, voffB);
            PG8_BAR; PG8_WAIT_L(0); PG8_MMA(0, 1, At, B1); PG8_BAR;
            PG8_LDA(At, 1, 1); PG8_STAGE(PG8_SA(1, 0), a3, voffA);
            PG8_BAR; PG8_WAIT_L(0); PG8_MMA(1, 0, At, B0); PG8_BAR; PG8_SCHED;
            PG8_STAGE(PG8_SB(1, 1), b3 + hstep, voffB);
            PG8_WAIT_V(6); PG8_BAR; PG8_MMA(1, 1, At, B1); PG8_BAR;
            }
        }
        if constexpr (ALIGN_EPI) { if (wr == 0) PG8_BAR; }
        if constexpr (!Epi::AFTER_DRAIN) { int t2 = threadIdx.x; asm volatile("" : "+v"(t2));
            E(acc, cur, wr, wc, t2 & 15, (t2 & 63) >> 4); S.done(cur); }
        if (!has_next) break;
#pragma unroll
        for (int a = 0; a < 2; ++a)
#pragma unroll
            for (int b = 0; b < 2; ++b)
#pragma unroll
                for (int m = 0; m < 4; ++m)
#pragma unroll
                    for (int n = 0; n < 2; ++n) acc[a][b][m][n] = (f32x4){0.f, 0.f, 0.f, 0.f};
        cur = nxt; cA = nA; cB = nB; ++ui;
        if constexpr (ALIGN_EPI) { if (wr == 1) PG8_BAR; }
    }
    PG8_WAIT_V(0);
    if constexpr (!ALIGN_EPI) { if (wr == 0) PG8_BAR; }
    PG8_BAR;
    if constexpr (Epi::AFTER_DRAIN) { E.fused(acc, cur, wr, wc, fr, fq, lds, wid, lane); S.done(cur); }
#undef PG8_SA
#undef PG8_SB
#undef PG8_STAGE
#undef PG8_LDA
#undef PG8_LDB
#undef PG8_MMA
#undef PG8_WAIT_V
#undef PG8_WAIT_L
#undef PG8_BAR
#undef PG8_SCHED
}
}

#ifndef PG8_SP2
#define PG8_SP2 true
#endif
#ifndef PG8_ALIGN
#define PG8_ALIGN true
#endif
#include <hip/hip_bf16.h>
#include <cmath>
namespace attn_body {
using bf16=__hip_bfloat16;
using bf16x8=__attribute__((ext_vector_type(8)))short;
using s16x4=__attribute__((ext_vector_type(4)))short;
using f32x16=__attribute__((ext_vector_type(16)))float;
using u32x4=__attribute__((ext_vector_type(4)))unsigned;
constexpr int BATCH=8,NHEAD=16,SEQ=8192,D=64,DM=NHEAD*D;
constexpr int NW=8,QBLK=32,QB=QBLK*NW,KVBLK=64,NQB=SEQ/QB;
constexpr int ATTN_PITCH=DM, ATTN_UNIT_ROWS=QB;
__device__ __forceinline__ int crow(int r,int hi){return (r&3)+8*(r>>2)+4*hi;}
#define SBAR() __builtin_amdgcn_sched_barrier(0)
__device__ __forceinline__ void cmask(f32x16&p0,f32x16&p1,int jb,int qrel,int hi){
  const float NEG=-INFINITY; int kb=64*jb+4*hi;
  #pragma unroll
  for(int r=0;r<16;++r){int kv=kb+(r&3)+8*(r>>2); if(kv>qrel)p0[r]=NEG; if(kv+32>qrel)p1[r]=NEG;}
}

constexpr int NSLOT=3, SLOTB=8192;
constexpr int LDS_K=0, LDS_V=NSLOT*SLOTB, LDS_WS=2*NSLOT*SLOTB, LDS_OST=LDS_WS+NW*64*4, LDS_CB=86016, LDS_BYTES=LDS_CB+SEQ*4;
constexpr float C2=0.125f*1.4426950408889634f;
__device__ __forceinline__ void glds16(const void*gsrc,unsigned lds_dst){unsigned keep;
  asm volatile("s_mov_b32 %0, m0\n\ts_mov_b32 m0, %2\n\ts_nop 0\n\tglobal_load_lds_dwordx4 %1, off\n\ts_mov_b32 m0, %0":"=&s"(keep):"v"(gsrc),"s"(lds_dst):"memory");}
__device__ __forceinline__ float max3f(float a,float b,float c){float r;asm("v_max3_f32 %0, %1, %2, %3":"=v"(r):"v"(a),"v"(b),"v"(c));return r;}
__device__ __forceinline__ float max2f(float a,float b){float r;asm("v_max_f32_e32 %0, %1, %2":"=v"(r):"v"(a),"v"(b));return r;}
__device__ __forceinline__ float fadd_s(float a,float b){float r;asm("v_add_f32_e32 %0, %1, %2":"=v"(r):"v"(a),"v"(b));return r;}
__device__ __forceinline__ float fsub_s(float a,float b){float r;asm("v_sub_f32_e32 %0, %1, %2":"=v"(r):"v"(a),"v"(b));return r;}
typedef float f32x2_t __attribute__((ext_vector_type(2))); typedef __bf16 bf16x2_t __attribute__((ext_vector_type(2)));
__device__ __forceinline__ unsigned cvtpk_s(float lo,float hi){f32x2_t v={lo,hi};bf16x2_t b=__builtin_convertvector(v,bf16x2_t);return __builtin_bit_cast(unsigned,b);}
#define WAIT_BAR(N) asm volatile("s_waitcnt vmcnt(" #N ") lgkmcnt(0)\n\ts_barrier":::"memory")

__device__ __forceinline__ void qkt(f32x16&p0,f32x16&p1,const char*Kslot,const bf16x8*qr,const f32x16&c0in,const f32x16&c1in,int r32,int hi){
  const char*kb=Kslot+hi*1024+r32*16;
  #pragma unroll
  for(int d0=0;d0<4;++d0){
    const bf16x8 b0=*reinterpret_cast<const bf16x8*>(kb+d0*2048);
    const bf16x8 b1=*reinterpret_cast<const bf16x8*>(kb+d0*2048+512);
    if(d0==0){p0=__builtin_amdgcn_mfma_f32_32x32x16_bf16(b0,qr[0],c0in,0,0,0);p1=__builtin_amdgcn_mfma_f32_32x32x16_bf16(b1,qr[0],c1in,0,0,0);}
    else{p0=__builtin_amdgcn_mfma_f32_32x32x16_bf16(b0,qr[d0],p0,0,0,0);p1=__builtin_amdgcn_mfma_f32_32x32x16_bf16(b1,qr[d0],p1,0,0,0);}}
}
typedef __attribute__((address_space(3))) const char* lds_cptr;
typedef short v4i16_t __attribute__((ext_vector_type(4)));
__device__ __forceinline__ void kload8(bf16x8*kf,lds_cptr kp){
  kf[0]=*(const __attribute__((address_space(3))) bf16x8*)(kp);      kf[1]=*(const __attribute__((address_space(3))) bf16x8*)(kp+512);
  kf[2]=*(const __attribute__((address_space(3))) bf16x8*)(kp+2048); kf[3]=*(const __attribute__((address_space(3))) bf16x8*)(kp+2560);
  kf[4]=*(const __attribute__((address_space(3))) bf16x8*)(kp+4096); kf[5]=*(const __attribute__((address_space(3))) bf16x8*)(kp+4608);
  kf[6]=*(const __attribute__((address_space(3))) bf16x8*)(kp+6144); kf[7]=*(const __attribute__((address_space(3))) bf16x8*)(kp+6656);
}
__device__ __forceinline__ void kload2(bf16x8*kf,lds_cptr kp,int j){ kf[2*j]=*(const __attribute__((address_space(3))) bf16x8*)(kp+j*2048); kf[2*j+1]=*(const __attribute__((address_space(3))) bf16x8*)(kp+j*2048+512); }
__device__ __forceinline__ s16x4 vtr(lds_cptr p){ return __builtin_bit_cast(s16x4,__builtin_amdgcn_ds_read_tr16_b64_v4i16((__attribute__((address_space(3))) v4i16_t*)p)); }
__device__ __forceinline__ float rowmax(const f32x16&p0,const f32x16&p1){
  float a=max3f(p0[0],p0[1],p1[0]),b=max3f(p0[2],p0[3],p1[1]);a=max3f(a,p1[2],p1[3]);
  #pragma unroll
  for(int r=4;r<16;r+=4){a=max3f(a,p0[r],p0[r+1]);b=max3f(b,p0[r+2],p0[r+3]);a=max3f(a,p1[r],p1[r+1]);b=max3f(b,p1[r+2],p1[r+3]);}
  const float m=max2f(a,b);
  auto rr=__builtin_amdgcn_permlane32_swap(__float_as_uint(m),__float_as_uint(m),false,false);
  return max2f(__uint_as_float(rr[0]),__uint_as_float(rr[1]));
}
__device__ __forceinline__ void pv(f32x16*o,int vb,bf16x8 pa0,bf16x8 pa1,bf16x8 pa2,bf16x8 pa3){
  #pragma unroll
  for(int d0=0;d0<2;++d0){s16x4 lo[4],hi[4];
    #pragma unroll
    for(int ks=0;ks<4;++ks){
      asm volatile("ds_read_b64_tr_b16 %0,%1 offset:%c2":"=&v"(lo[ks]):"v"(vb),"i"(d0*4096+ks*1024):"memory");
      asm volatile("ds_read_b64_tr_b16 %0,%1 offset:%c2":"=&v"(hi[ks]):"v"(vb),"i"(d0*4096+ks*1024+512):"memory");}
    asm volatile("s_waitcnt lgkmcnt(0)":::"memory");SBAR();
    #define PK(k) (bf16x8){lo[k][0],lo[k][1],lo[k][2],lo[k][3],hi[k][0],hi[k][1],hi[k][2],hi[k][3]}
    o[d0]=__builtin_amdgcn_mfma_f32_32x32x16_bf16(pa0,PK(0),o[d0],0,0,0);
    o[d0]=__builtin_amdgcn_mfma_f32_32x32x16_bf16(pa1,PK(1),o[d0],0,0,0);
    o[d0]=__builtin_amdgcn_mfma_f32_32x32x16_bf16(pa2,PK(2),o[d0],0,0,0);
    o[d0]=__builtin_amdgcn_mfma_f32_32x32x16_bf16(pa3,PK(3),o[d0],0,0,0);
    #undef PK
  }
}

#ifndef ATTN_STORE16
#define ATTN_STORE16(p,v) (*(u32x4*)(p)=(v))
#endif
__device__ __forceinline__ bf16x8 mkkx(float x,int hi){
  const unsigned b0=cvtpk_s(x,0.f)&0xffffu; const float r1=x-__uint_as_float(b0<<16);
  const unsigned b1=cvtpk_s(r1,0.f)&0xffffu; const float r2=r1-__uint_as_float(b1<<16);
  const unsigned b2=cvtpk_s(r2,0.f)&0xffffu;
  u32x4 w; w.x=hi?0u:(b0|(b1<<16)); w.y=hi?0u:(b2|0x3F800000u); w.z=hi?0u:0x3F803F80u; w.w=0u; return __builtin_bit_cast(bf16x8,w);
}
template<int THRL> __device__ __forceinline__ void attn_unit(int b,int h,int qb,int t0,const bf16*Q,const bf16*__restrict__ K,const bf16*__restrict__ V,bf16*O,const float*cbg,char*shm){
  int tid=threadIdx.x; asm volatile("":"+v"(tid));
  const int lane=tid&63,r32=lane&31,hi=lane>>5; const int wid=__builtin_amdgcn_readfirstlane(tid>>6);
  const long rowbase=(long)b*SEQ; const int q0=qb*QB;
  const bf16*Qw=Q+(rowbase+q0+wid*QBLK)*DM+h*D;
  const bf16*Kh=K+(rowbase+(long)t0*KVBLK)*DM+h*D,*Vh=V+(rowbase+(long)t0*KVBLK)*DM+h*D;
  const unsigned lds0=(unsigned)(uintptr_t)shm;
  float*wsf=(float*)(shm+LDS_WS)+wid*64;
  const bf16*ksrc=Kh+(long)lane*DM+wid*8;
  const bf16*vsrc=Vh+(long)(16*(wid&3)+(lane>>2))*DM+(wid>>2)*32+(lane&3)*8;
  const unsigned kdst=lds0+LDS_K+wid*1024, vdst=lds0+LDS_V+wid*1024;
  #define DMA_K(t,slot) glds16(ksrc+(long)(t)*KVBLK*DM,(unsigned)__builtin_amdgcn_readfirstlane(kdst+(slot)))
  #define DMA_V(t,slot) glds16(vsrc+(long)(t)*KVBLK*DM,(unsigned)__builtin_amdgcn_readfirstlane(vdst+(slot)))
  const int vb0=(int)(lds0+LDS_V)+((lane>>4)&1)*32+(lane&3)*8+(4*hi+((lane&15)>>2))*64;
  const char*Kbase=shm+LDS_K; bf16x8 kf[8];
  const lds_cptr shm3=(lds_cptr)shm; const lds_cptr kp0=shm3+LDS_K+hi*1024+r32*16; const lds_cptr vp0=shm3+LDS_V+((lane>>4)&1)*32+(lane&3)*8+(4*hi+((lane&15)>>2))*64;
  const int NT=(q0+QB)/KVBLK-t0;
  { const float*cg=cbg+t0*KVBLK; float*cl=(float*)(shm+LDS_CB); const int n=NT*KVBLK;
    for(int i=tid;i<n;i+=NW*64)cl[i]=cg[i]; }
  const float*cbl=(const float*)(shm+LDS_CB);
  DMA_K(0,0);DMA_V(0,0);DMA_K(1,SLOTB);
  bf16x8 qr[4];
  #pragma unroll
  for(int d0=0;d0<4;++d0)qr[d0]=*reinterpret_cast<const bf16x8*>(&Qw[(long)r32*DM+d0*16+hi*8]);
  float mhat=0.f,l_reg=0.f;f32x16 o[2];o[0]=f32x16{};o[1]=f32x16{};const f32x16 z16=f32x16{};
  const int qrel=wid*QBLK+r32;
  #define CMASK(P0,P1,t) do{int jb_=(t)-(NT-4); if(jb_>=0)cmask(P0,P1,jb_,qrel,hi);}while(0)
  bool resc=false;
  bf16x8 qx;
  #define MKQX() do{ const float nm_=-mhat; const unsigned a0_=cvtpk_s(nm_,0.f)&0xffffu; const float q1_=nm_-__uint_as_float(a0_<<16); const unsigned a1_=cvtpk_s(q1_,0.f)&0xffffu; \
    const float q2_=q1_-__uint_as_float(a1_<<16); const unsigned a2_=cvtpk_s(q2_,0.f)&0xffffu; u32x4 w_; w_.x=hi?0u:0x3F803F80u; w_.y=hi?0u:(0x3F80u|(a0_<<16)); w_.z=hi?0u:(a1_|(a2_<<16)); w_.w=0u; qx=__builtin_bit_cast(bf16x8,w_); }while(0)
  MKQX();
  #define START(P0,P1) do{ const float rm=rowmax(P0,P1); resc=false; \
    { const float dl=rm; mhat=fadd_s(mhat,dl); \
      _Pragma("unroll") for(int r=0;r<16;++r){P0[r]=fsub_s(P0[r],dl);P1[r]=fsub_s(P1[r],dl);} \
      MKQX(); } \
    _Pragma("unroll") for(int r=0;r<16;++r)P0[r]=__builtin_amdgcn_exp2f(P0[r]); }while(0)
  #define RESC() do{ if(resc){ asm volatile("s_waitcnt lgkmcnt(0)":::"memory"); \
      _Pragma("unroll") for(int d_=0;d_<2;++d_) _Pragma("unroll") for(int r=0;r<16;++r)o[d_][r]*=wsf[crow(r,hi)]; } }while(0)
  f32x16 pA0,pA1,pB0,pB1;
  int sl_prev=0,sl_cur=0,sl_next=SLOTB;
  #define ROT() do{sl_prev=sl_cur;sl_cur=sl_next;sl_next=(sl_next==(NSLOT-1)*SLOTB)?0:sl_next+SLOTB;}while(0)
  DMA_K(2,2*SLOTB);
  WAIT_BAR(3);
  const float cref=cbl[q0-t0*KVBLK+wid*QBLK];
  #define KXB(X0,X1,t) do{ X0=mkkx(cref-cbl[(t)*KVBLK+r32],hi); X1=mkkx(cref-cbl[(t)*KVBLK+32+r32],hi); }while(0)
  bf16x8 kx0,kx1; KXB(kx0,kx1,0);
  { const f32x16 i0=__builtin_amdgcn_mfma_f32_32x32x16_bf16(kx0,qx,z16,0,0,0), i1=__builtin_amdgcn_mfma_f32_32x32x16_bf16(kx1,qx,z16,0,0,0);
    qkt(pA0,pA1,Kbase,qr,i0,i1,r32,hi); }
  asm volatile("s_nop 15\n\ts_nop 7":"+v"(pA0),"+v"(pA1));CMASK(pA0,pA1,0);
  START(pA0,pA1);
  _Pragma("unroll") for(int r=0;r<16;++r)pA1[r]=__builtin_amdgcn_exp2f(pA1[r]);
  WAIT_BAR(0);
  DMA_K(3,0);DMA_V(1,SLOTB);
  ROT();
  kload8(kf,kp0+sl_cur);
  WAIT_BAR(2);
  s16x4 vlo[8],vhi[8]; u32x4 pw0,pw1,pw2,pw3;
  #define PKW(P,B) cvtpk_s(P[B],P[B+1])
  #define PAF(k) __builtin_bit_cast(bf16x8,pw##k)
  #define VFR(i) (bf16x8){vlo[i][0],vlo[i][1],vlo[i][2],vlo[i][3],vhi[i][0],vhi[i][1],vhi[i][2],vhi[i][3]}
  #define PIN(x) asm volatile("":"+v"(x))
  #define MX3(a,b,c) __builtin_fmaxf(__builtin_fmaxf((a),(b)),(c))
  #define GAPA(MF,A0,A1,A2,A3,W0,W1,PW) do{ MF; sacc+=A0; sacc+=A1; sacc+=A2; sacc+=A3; PIN(sacc); W0; W1; PIN(PW); SBAR(); }while(0)
  #define EX(v) __builtin_amdgcn_exp2f(v)
  #define GAPB(MF,X,B) do{ MF; X[B]=EX(X[B]); X[B+1]=EX(X[B+1]); X[B+2]=EX(X[B+2]); X[B+3]=EX(X[B+3]); PIN(X); SBAR(); }while(0)
  #define VRD(i) do{ vlo[i]=vtr(vp_+(((i)>>2)*4096+((i)&3)*1024)); vhi[i]=vtr(vp_+(((i)>>2)*4096+((i)&3)*1024+512)); }while(0)
  #define KRD(G,j) do{ if(G){ kload2(kf,kp0+sl_next,j); SBAR(); } }while(0)
  #define STEP(C0,C1,P0,P1,t,GK,GV,GL) do{ KXB(kx0,kx1,t); SBAR(); \
    C0=__builtin_amdgcn_mfma_f32_32x32x16_bf16(kx0,qx,z16,0,0,0); C1=__builtin_amdgcn_mfma_f32_32x32x16_bf16(kx1,qx,z16,0,0,0); SBAR(); \
    const lds_cptr vp_=vp0+sl_prev; \
    VRD(0); SBAR(); float sacc=(P0[0]+P0[1]); \
    GAPA(C0=__builtin_amdgcn_mfma_f32_32x32x16_bf16(kf[0],qr[0],C0,0,0,0), P0[2],P0[3],P0[4],P0[5],     pw0[0]=PKW(P0,0), pw0[1]=PKW(P0,2), pw0); \
    VRD(4); SBAR(); GAPA(C1=__builtin_amdgcn_mfma_f32_32x32x16_bf16(kf[1],qr[0],C1,0,0,0), P0[6],P0[7],P0[8],P0[9],     pw0[2]=PKW(P0,4), pw0[3]=PKW(P0,6), pw0); \
    VRD(1); SBAR(); GAPA(C0=__builtin_amdgcn_mfma_f32_32x32x16_bf16(kf[2],qr[1],C0,0,0,0),   P0[10],P0[11],P0[12],P0[13], pw1[0]=PKW(P0,8), pw1[1]=PKW(P0,10), pw1); \
    VRD(5); SBAR(); GAPA(C1=__builtin_amdgcn_mfma_f32_32x32x16_bf16(kf[3],qr[1],C1,0,0,0),   P0[14],P0[15],P1[0],P1[1],   pw1[2]=PKW(P0,12),pw1[3]=PKW(P0,14), pw1); \
    VRD(2); SBAR(); GAPA(C0=__builtin_amdgcn_mfma_f32_32x32x16_bf16(kf[4],qr[2],C0,0,0,0),   P1[2],P1[3],P1[4],P1[5],     pw2[0]=PKW(P1,0), pw2[1]=PKW(P1,2), pw2); \
    VRD(6); SBAR(); GAPA(C1=__builtin_amdgcn_mfma_f32_32x32x16_bf16(kf[5],qr[2],C1,0,0,0),   P1[6],P1[7],P1[8],P1[9],     pw2[2]=PKW(P1,4), pw2[3]=PKW(P1,6), pw2); \
    VRD(3); SBAR(); GAPA(C0=__builtin_amdgcn_mfma_f32_32x32x16_bf16(kf[6],qr[3],C0,0,0,0),   P1[10],P1[11],P1[12],P1[13], pw3[0]=PKW(P1,8), pw3[1]=PKW(P1,10), pw3); \
    VRD(7); SBAR(); GAPA(C1=__builtin_amdgcn_mfma_f32_32x32x16_bf16(kf[7],qr[3],C1,0,0,0),   P1[14],P1[15],0.f,0.f,       pw3[2]=PKW(P1,12),pw3[3]=PKW(P1,14), pw3); \
    l_reg+=sacc; \
    if(GK){DMA_K((t)+3,sl_cur);} if(GV){DMA_V((t)+1,sl_next);} \
    CMASK(C0,C1,t); \
    { float a=MX3(C0[0],C0[1],C1[0]),b=MX3(C0[2],C0[3],C1[1]); a=MX3(a,C1[2],C1[3]); \
      _Pragma("unroll") for(int r=4;r<16;r+=4){a=MX3(a,C0[r],C0[r+1]);b=MX3(b,C0[r+2],C0[r+3]);a=MX3(a,C1[r],C1[r+1]);b=MX3(b,C1[r+2],C1[r+3]);} \
      float rm=__builtin_fmaxf(a,b); { auto rr=__builtin_amdgcn_permlane32_swap(__float_as_uint(rm),__float_as_uint(rm),false,false); rm=__builtin_fmaxf(__uint_as_float(rr[0]),__uint_as_float(rr[1])); } \
      resc=false; \
      if(__builtin_expect(__any(rm>(float)THRL),0)){ const float dl=__builtin_fmaxf(rm,0.f); mhat+=dl; \
        _Pragma("unroll") for(int r=0;r<16;++r){C0[r]-=dl;C1[r]-=dl;} \
        MKQX(); \
        const float f=__builtin_amdgcn_exp2f(-dl); l_reg*=f; if(hi==0)wsf[r32]=f; resc=true; } } \
    SBAR(); \
    GAPB(o[0]=__builtin_amdgcn_mfma_f32_32x32x16_bf16(PAF(0),VFR(0),o[0],0,0,0), C0,0); \
    GAPB(o[1]=__builtin_amdgcn_mfma_f32_32x32x16_bf16(PAF(0),VFR(4),o[1],0,0,0), C0,4); \
    KRD(GL,0); GAPB(o[0]=__builtin_amdgcn_mfma_f32_32x32x16_bf16(PAF(1),VFR(1),o[0],0,0,0), C0,8); \
    KRD(GL,1); GAPB(o[1]=__builtin_amdgcn_mfma_f32_32x32x16_bf16(PAF(1),VFR(5),o[1],0,0,0), C0,12); \
    KRD(GL,2); GAPB(o[0]=__builtin_amdgcn_mfma_f32_32x32x16_bf16(PAF(2),VFR(2),o[0],0,0,0), C1,0); \
    KRD(GL,3); GAPB(o[1]=__builtin_amdgcn_mfma_f32_32x32x16_bf16(PAF(2),VFR(6),o[1],0,0,0), C1,4); \
    GAPB(o[0]=__builtin_amdgcn_mfma_f32_32x32x16_bf16(PAF(3),VFR(3),o[0],0,0,0), C1,8); \
    GAPB(o[1]=__builtin_amdgcn_mfma_f32_32x32x16_bf16(PAF(3),VFR(7),o[1],0,0,0), C1,12); \
    }while(0)
  int t=1;
  #undef CMASK
  #define CMASK(P0,P1,t) do{}while(0)
  for(;t+5<NT;t+=2){
    STEP(pB0,pB1,pA0,pA1,t,true,true,true);     WAIT_BAR(2); RESC(); ROT();
    STEP(pA0,pA1,pB0,pB1,t+1,true,true,true);   WAIT_BAR(2); RESC(); ROT();
  }
  #undef CMASK
  #define CMASK(P0,P1,t) do{int jb_=(t)-(NT-4); if(jb_>=0)cmask(P0,P1,jb_,qrel,hi);}while(0)
  #define ENDW(tt) do{ if((tt)+3<NT){WAIT_BAR(2);} else if((tt)+2<NT){WAIT_BAR(1);} else {WAIT_BAR(0);} }while(0)
  for(;t+1<NT;t+=2){
    STEP(pB0,pB1,pA0,pA1,t,(t+3<NT),(t+1<NT),(t+1<NT));       ENDW(t);   RESC(); ROT();
    STEP(pA0,pA1,pB0,pB1,t+1,(t+4<NT),(t+2<NT),(t+2<NT));     ENDW(t+1); RESC(); ROT();
  }
  STEP(pB0,pB1,pA0,pA1,NT-1,false,false,false); RESC();
  { float sacc=pB0[0]+pB0[1]; _Pragma("unroll") for(int r=2;r<16;++r)sacc+=pB0[r]; _Pragma("unroll") for(int r=0;r<16;++r)sacc+=pB1[r]; l_reg+=sacc;
    pw0=(u32x4){PKW(pB0,0),PKW(pB0,2),PKW(pB0,4),PKW(pB0,6)};pw1=(u32x4){PKW(pB0,8),PKW(pB0,10),PKW(pB0,12),PKW(pB0,14)};pw2=(u32x4){PKW(pB1,0),PKW(pB1,2),PKW(pB1,4),PKW(pB1,6)};pw3=(u32x4){PKW(pB1,8),PKW(pB1,10),PKW(pB1,12),PKW(pB1,14)};
    SBAR(); pv(o,vb0+sl_cur,PAF(0),PAF(1),PAF(2),PAF(3)); }
  #undef PKW
  #undef PAF
  #undef VFR
  #undef PIN
  #undef MX3
  #undef GAPA
  #undef GAPB
  #undef EX
  #undef VRD
  #undef KRD
  #undef STEP
  #undef ENDW
  #undef KXB
  #undef MKQX
  {auto rr=__builtin_amdgcn_permlane32_swap(__float_as_uint(l_reg),__float_as_uint(l_reg),false,false);l_reg=__uint_as_float(rr[0])+__uint_as_float(rr[1]);}
  if(hi==0)wsf[32+r32]=l_reg;asm volatile("s_waitcnt lgkmcnt(0)":::"memory");
  float rli[16];
  #pragma unroll
  for(int r=0;r<16;++r)rli[r]=__builtin_amdgcn_rcpf(wsf[32+crow(r,hi)]);
  bf16*Ow=O+(rowbase+q0+wid*QBLK)*DM+h*D;
  { bf16*stg=(bf16*)(shm+LDS_OST)+wid*2048;
    #pragma unroll
    for(int r=0;r<16;++r){const int orow=crow(r,hi);
      #pragma unroll
      for(int d0=0;d0<2;++d0)stg[orow*64+d0*32+r32]=__float2bfloat16(o[d0][r]*rli[r]);}
    asm volatile("s_waitcnt lgkmcnt(0)":::"memory");
    #pragma unroll
    for(int i=0;i<4;++i){const int row=i*8+(lane>>3),ch=lane&7; const u32x4 v=*(const u32x4*)(stg+row*64+ch*8); ATTN_STORE16(Ow+(long)row*DM+ch*8,v);} }
  asm volatile("s_waitcnt lgkmcnt(0)\n\ts_barrier":::"memory");
  #undef DMA_K
  #undef DMA_V
  #undef CMASK
  #undef START
  #undef RESC
  #undef ROT
}
constexpr int ATTN_LDS_BYTES=LDS_BYTES;
struct AttnTensors { const bf16* Q; const bf16* K; const bf16* V; bf16* O; };
struct AttnUnit { int bh; int qb; int t0; };
struct StaticOrder {
  int vcu;
  __device__ __forceinline__ explicit StaticOrder(int grid,int block):vcu((block%8)*(grid/8)+block/8){}
  __device__ __forceinline__ bool next(int i,AttnUnit&u)const{ if(i>=8)return false; const int s=vcu&7,k=i&3; u.bh=2*(vcu>>3)+(i>>2); u.qb=(k==0)?s:(k==1)?15-s:(k==2)?16+s:31-s; u.t0=0; return true; }
};
template<class Sched,int THRL=8> __device__ __forceinline__ void attn_phase(char*lds,const AttnTensors&T,const float*cb,const Sched&S){
  AttnUnit u;
  for(int i=0;S.next(i,u);++i){ attn_unit<THRL>(u.bh>>3,u.bh&7,u.qb,u.t0,T.Q,T.K,T.V,T.O,cb+(size_t)u.bh*SEQ,lds); }
}
#undef SBAR
#undef WAIT_BAR
}
#define GAS __attribute__((address_space(1)))
#define LAS __attribute__((address_space(3)))
typedef unsigned short bf16;
typedef unsigned v4u __attribute__((ext_vector_type(4)));
typedef float f32x4 __attribute__((ext_vector_type(4)));
typedef short bf16x8 __attribute__((ext_vector_type(8)));
typedef GAS unsigned gu32;
typedef GAS unsigned long long gu64;
#define RLX_AGENT __ATOMIC_RELAXED, __HIP_MEMORY_SCOPE_AGENT
#define LDS_WAIT() asm volatile("s_waitcnt lgkmcnt(0)" ::: "memory")
#define VM_WAIT() asm volatile("s_waitcnt vmcnt(0)" ::: "memory")
__device__ __forceinline__ unsigned long long rt() { return __builtin_amdgcn_s_memrealtime(); }
__device__ __forceinline__ unsigned f2bf(float f) { unsigned u = __builtin_bit_cast(unsigned, f); return (u + 0x7fffu + ((u >> 16) & 1u)) >> 16; }
__device__ __forceinline__ unsigned pk2(float lo, float hi) { return f2bf(lo) | (f2bf(hi) << 16); }

#define XB_TMO      128
#define XB_XCNT(j)  (256  + 64 * (j))
#define XB_XSUB(j)  (1280 + 64 * (j))
#define XB_XGEN(j)  (2304 + 64 * (j))
#define XB_TOP      3328
#define XB_TOPGEN   3392
#define XCD_BAR_WORDS 3456
#define XB_SPIN_CAP (1u << 18)

__device__ __forceinline__ unsigned xb_ld(unsigned* p)              { return __hip_atomic_load(p, __ATOMIC_RELAXED, __HIP_MEMORY_SCOPE_AGENT); }
__device__ __forceinline__ unsigned xb_add(unsigned* p, unsigned v) { return __hip_atomic_fetch_add(p, v, __ATOMIC_RELAXED, __HIP_MEMORY_SCOPE_AGENT); }
__device__ __forceinline__ unsigned xb_xcc_id() { return (unsigned)__builtin_amdgcn_s_getreg((3 << 11) | 20) & 0xFu; }
#define XB_SPIN(cond, bar) do { unsigned _sp = 0; while (cond) { __builtin_amdgcn_s_sleep(1); \
    if ((++_sp & 255u) == 0u) { if (xb_ld(&(bar)[XB_TMO])) break; if (_sp > XB_SPIN_CAP) { atomicAdd(&(bar)[XB_TMO], 1u); break; } } } } while (0)

struct XcdBarrier {
    unsigned* bar; unsigned x;
    volatile LAS unsigned* st;
};

__device__ __forceinline__ XcdBarrier xcd_barrier_post(unsigned* bar, volatile LAS unsigned* st) {
    XcdBarrier b; b.bar = bar; b.x = xb_xcc_id(); b.st = st;
    if (threadIdx.x == 0) (void)xb_add(&bar[XB_XCNT(b.x)], 1u);
    return b;
}
__device__ __forceinline__ void xcd_barrier_complete(unsigned* bar, unsigned x, unsigned& nloc, unsigned& nx) {
    const unsigned G = gridDim.x * gridDim.y * gridDim.z;
    unsigned sum, cnt, mine, sp = 0u;
    for (;;) {
        sum = 0u; cnt = 0u; mine = 0u;
#pragma unroll
        for (unsigned j = 0; j < 16; ++j) { const unsigned c = xb_ld(&bar[XB_XCNT(j)]); sum += c; cnt += (c > 0u) ? 1u : 0u; mine = (j == x) ? c : mine; }
        if (sum == G) break;
        __builtin_amdgcn_s_sleep(1);
        if ((++sp & 255u) == 0u) { if (xb_ld(&bar[XB_TMO])) break; if (sp > XB_SPIN_CAP) { atomicAdd(&bar[XB_TMO], 1u); break; } }
    }
    nloc = mine > 0u ? mine : 1u; nx = cnt > 0u ? cnt : 1u;
}

__device__ __forceinline__ void xcd_barrier(const XcdBarrier& b) {
    asm volatile("s_waitcnt vmcnt(0)" ::: "memory");
    __syncthreads();
    if (threadIdx.x == 0) {
        unsigned* bar = b.bar;
        __builtin_amdgcn_s_waitcnt(0);
        unsigned nloc = b.st[0], nx = b.st[1];
        if (nloc == 0u) { xcd_barrier_complete(bar, b.x, nloc, nx); b.st[0] = nloc; b.st[1] = nx; }
        const unsigned old = xb_add(&bar[XB_XSUB(b.x)], 1u);
        const unsigned gen = old / nloc;
        if (old + 1u == (gen + 1u) * nloc) {
            __builtin_amdgcn_fence(__ATOMIC_RELEASE, "agent");
            asm volatile("s_waitcnt vmcnt(0)" ::: "memory");
            const unsigned og = xb_add(&bar[XB_TOP], 1u);
            const unsigned tg = og / nx;
            if (og + 1u == (tg + 1u) * nx) xb_add(&bar[XB_TOPGEN], 1u);
            else XB_SPIN(xb_ld(&bar[XB_TOPGEN]) == tg, bar);
            __builtin_amdgcn_fence(__ATOMIC_ACQUIRE, "agent");
            xb_add(&bar[XB_XGEN(b.x)], 1u);
            asm volatile("s_waitcnt vmcnt(0)" ::: "memory");
        } else {
            XB_SPIN(xb_ld(&bar[XB_XGEN(b.x)]) == gen, bar);
            __builtin_amdgcn_fence(__ATOMIC_ACQUIRE, "agent");
            asm volatile("s_waitcnt vmcnt(0)" ::: "memory");
        }
    }
    __syncthreads();
}

constexpr int NWAVES = 8;
#ifndef MK_ONE_LAUNCH
#define MK_ONE_LAUNCH 0
#endif
constexpr int BATCH = 8, SEQ = 8192, DM = 1024, DEPTH = 4, M = BATCH * SEQ;
constexpr int NIN = 3584, INW = 3592, FF = 2816, PLE = 256, NFH = 8, NCHK = SEQ / 128;
constexpr int NPH = 2 + 9 * DEPTH;
constexpr float LOG2E = 1.4426950408889634f;
constexpr size_t MiB = 1u << 20;
constexpr size_t WS_CTL = 0, CTL_ZERO_BYTES = 1 * MiB;
constexpr size_t WS_WFB = 1 * MiB;
constexpr size_t WS_CS = 2 * MiB;
constexpr size_t WS_LF = 4 * MiB;
constexpr size_t WS_CB = 6 * MiB;
constexpr size_t WS_SSQ0 = 9 * MiB, WS_SSQ1 = 13 * MiB;
constexpr size_t WS_W = 17 * MiB, W_LAYER = 28 * MiB;
constexpr size_t WO_IN = 0, WO_OUT = 7 * MiB, WO_A = 9 * MiB, WO_G = 14 * MiB + MiB / 2, WO_DOWN = 20 * MiB, WO_GATE = 25 * MiB + MiB / 2, WO_PROJ = 27 * MiB + MiB / 2;
constexpr size_t WS_HB = 129 * MiB;
constexpr size_t WS_PB = 257 * MiB;
constexpr size_t WS_X = 289 * MiB;
constexpr size_t WS_QO = WS_X, WS_KK = WS_X + 128 * MiB, WS_VV = WS_X + 256 * MiB, WS_G = WS_X + 384 * MiB, WS_U = WS_X + 448 * MiB, WS_S = WS_X + 512 * MiB;
constexpr size_t WS_A = WS_X, WS_ACT = WS_X + 352 * MiB, WS_PP = WS_X;
constexpr size_t WS_HBT = WS_X + 576 * MiB;
constexpr size_t WS_END = 993 * MiB;
static_assert(WS_W + DEPTH * W_LAYER == WS_HB && WS_S + 32 * MiB <= WS_HBT && WS_HBT + 128 * MiB == WS_END && WS_ACT + 352 * MiB == WS_END, "d_ws map");
constexpr int CW_BAR = 4096;

constexpr int RING_BYTES = 131072, LDSCTL_OFF = RING_BYTES, MISC_OFF = LDSCTL_OFF + 320, LDS_BYTES = 147456;

typedef float f32x16 __attribute__((ext_vector_type(16)));
typedef short s16x4 __attribute__((ext_vector_type(4)));
typedef float f32x2_ __attribute__((ext_vector_type(2)));
typedef __bf16 bf16x2_ __attribute__((ext_vector_type(2)));
__device__ __forceinline__ unsigned cvtpk(float lo, float hi) { f32x2_ v = {lo, hi}; bf16x2_ b = __builtin_convertvector(v, bf16x2_); return __builtin_bit_cast(unsigned, b); }
__device__ __forceinline__ int crow16(int r, int hi) { return (r & 3) + 8 * (r >> 2) + 4 * hi; }
__device__ __forceinline__ float wave_sum(float v) {
#pragma unroll
    for (int o = 1; o < 64; o <<= 1) v += __shfl_xor(v, o);
    return v;
}
__device__ __forceinline__ s16x4 trd(LAS unsigned char* p) { typedef short v4i16_t __attribute__((ext_vector_type(4))); return __builtin_bit_cast(s16x4, __builtin_amdgcn_ds_read_tr16_b64_v4i16((LAS v4i16_t*)p)); }
__device__ __forceinline__ bf16x8 cat8(s16x4 lo, s16x4 hi) { return (bf16x8){lo[0], lo[1], lo[2], lo[3], hi[0], hi[1], hi[2], hi[3]}; }
#define MFMA32(a, b, c) __builtin_amdgcn_mfma_f32_32x32x16_bf16((a), (b), (c), 0, 0, 0)

__device__ __forceinline__ void tr_item(const float* W, int ldw, int c0, const float* kscale, int K, bf16* WT, int dst_row0, bool rot, LAS float* scr, int item, int nblk, int lane) {
    const int kb = item / nblk, nb = item % nblk, k0 = 64 * kb, n0 = 32 * nb;
#pragma unroll 8
    for (int i = 0; i < 32; ++i) { const int kk = 2 * i + (lane >> 5); float v = W[(size_t)(k0 + kk) * ldw + c0 + n0 + (lane & 31)]; if (kscale) v *= kscale[k0 + kk]; scr[kk * 33 + (lane & 31)] = v; }
    LDS_WAIT(); asm volatile("" ::: "memory");
    const int c = lane & 7;
#pragma unroll
    for (int j = 0; j < 4; ++j) { const int n = (lane >> 3) + 8 * j, nn = n0 + n; const LAS float* s = scr + (8 * c) * 33 + n;
        int drow = nn; if (rot) { const int d = nn & 63; drow = (nn & ~63) + ((d < 32) ? (8 * (d >> 2) + (d & 3)) : (8 * ((d - 32) >> 2) + 4 + (d & 3))); }
        v4u o; o.x = cvtpk(s[0 * 33], s[1 * 33]); o.y = cvtpk(s[2 * 33], s[3 * 33]); o.z = cvtpk(s[4 * 33], s[5 * 33]); o.w = cvtpk(s[6 * 33], s[7 * 33]);
        *(GAS v4u*)(WT + (size_t)(dst_row0 + drow) * K + k0 + 8 * c) = o; }
    LDS_WAIT(); asm volatile("" ::: "memory");
}
constexpr int IT_IN = 7 * 256, IT_OUT = 512, IT_UP = 1408, IT_DOWN = 1408, IT_GATE = 512, IT_PROJ = 128, IT_LAYER = IT_IN + IT_OUT + 2 * IT_UP + IT_DOWN + IT_GATE + IT_PROJ;

struct Args { const float* in[15]; float* out; unsigned char* ws; int ph_lo, ph_hi; };

__device__ __forceinline__ void prologue(const Args& a, unsigned char* ws, LAS unsigned char* ldsl, int gw, int NGW, int wave, int lane, int gtid, int GT) {
    LAS float* scr = (LAS float*)(ldsl + wave * 16384);
    for (int it = gw; it < DEPTH * IT_LAYER; it += NGW) {
        const int l = it / IT_LAYER; int r = it % IT_LAYER;
        unsigned char* wl = ws + WS_W + (size_t)l * W_LAYER;
        const float* w_in = a.in[3] + (size_t)l * DM * INW; const float* w_up = a.in[7] + (size_t)l * DM * 2 * FF;
        if (r < IT_IN) { const int seg = r >> 8; tr_item(w_in, INW, seg * 512 + (seg >= 3 ? 8 : 0), a.in[2] + l * DM, DM, (bf16*)(wl + WO_IN), seg * 512, seg == 3 || seg == 4, scr, r & 255, 16, lane); continue; } r -= IT_IN;
        if (r < IT_OUT) { tr_item(a.in[5] + (size_t)l * DM * DM, DM, 0, nullptr, DM, (bf16*)(wl + WO_OUT), 0, false, scr, r, 32, lane); continue; } r -= IT_OUT;
        if (r < IT_UP) { tr_item(w_up, 2 * FF, 0, a.in[6] + l * DM, DM, (bf16*)(wl + WO_A), 0, false, scr, r, 88, lane); continue; } r -= IT_UP;
        if (r < IT_UP) { tr_item(w_up, 2 * FF, FF, a.in[6] + l * DM, DM, (bf16*)(wl + WO_G), 0, false, scr, r, 88, lane); continue; } r -= IT_UP;
        if (r < IT_DOWN) { tr_item(a.in[10] + (size_t)l * FF * DM, DM, 0, nullptr, FF, (bf16*)(wl + WO_DOWN), 0, false, scr, r, 32, lane); continue; } r -= IT_DOWN;
        if (r < IT_GATE) { tr_item(a.in[12] + (size_t)l * DM * DM, DM, 0, a.in[11] + l * DM, DM, (bf16*)(wl + WO_GATE), 0, false, scr, r, 32, lane); continue; } r -= IT_GATE;
        tr_item(a.in[13] + (size_t)l * PLE * DM, DM, 0, nullptr, PLE, (bf16*)(wl + WO_PROJ), 0, false, scr, r, 32, lane);
    }
    { bf16* wfb = (bf16*)(ws + WS_WFB);
      for (int i = gtid; i < DEPTH * 8 * DM; i += GT) { const int l = i / (8 * DM), j = (i / DM) & 7, k = i % DM;
          wfb[i] = (bf16)(cvtpk(a.in[2][l * DM + k] * a.in[3][(size_t)l * DM * INW + (size_t)k * INW + 1536 + j], 0.f) & 0xffffu); } }
    { float* cs = (float*)(ws + WS_CS);
      for (int i = gtid; i < SEQ * 32; i += GT) { const int pos = i >> 5, d = i & 31; const float inv = powf(10000.0f, -(float)(2 * d) / 64.0f), ang = (float)pos * inv; float sn, cn; sincosf(ang, &sn, &cn); cs[i] = cn; cs[SEQ * 32 + i] = sn; } }
    { bf16* hb = (bf16*)(ws + WS_HB); float* ssq = (float*)(ws + WS_SSQ0);
      for (int m = gw; m < M; m += NGW) { const float* xr = a.in[0] + (size_t)m * DM; float s = 0.f;
#pragma unroll
          for (int j = 0; j < 2; ++j) { const f32x4 v0 = *(const f32x4*)(xr + j * 512 + lane * 8), v1 = *(const f32x4*)(xr + j * 512 + lane * 8 + 4);
              s += ((v0[0] * v0[0] + v0[1] * v0[1]) + (v0[2] * v0[2] + v0[3] * v0[3])) + ((v1[0] * v1[0] + v1[1] * v1[1]) + (v1[2] * v1[2] + v1[3] * v1[3]));
              v4u o; o.x = cvtpk(v0[0], v0[1]); o.y = cvtpk(v0[2], v0[3]); o.z = cvtpk(v1[0], v1[1]); o.w = cvtpk(v1[2], v1[3]); *(v4u*)(hb + (size_t)m * DM + j * 512 + lane * 8) = o; }
          s = wave_sum(s); if (lane < 16) ssq[(size_t)m * 16 + lane] = s * (1.0f / 16.0f); } }
}

__device__ __forceinline__ void flogit_task(const bf16* hb, const bf16* wfb, const float* ssq, const float* fbias, float* lf, int G, int bx, int wave, int lane) {
    const int r32 = lane & 31, hi = lane >> 5;
    for (int blk = bx; blk < M / 256; blk += G) {
        const int row0 = blk * 256 + wave * 32;
        const bf16* ap = hb + (size_t)(row0 + r32) * DM + 8 * hi; const bf16* bp = wfb + (r32 & 7) * DM + 8 * hi;
        f32x16 acc; for (int i = 0; i < 16; ++i) acc[i] = 0.f;
#pragma unroll 8
        for (int ks = 0; ks < DM / 16; ++ks) acc = MFMA32(*(const bf16x8*)(ap + 16 * ks), *(const bf16x8*)(bp + 16 * ks), acc);
        if (r32 < 8) { const float fb = fbias[r32];
#pragma unroll
            for (int r = 0; r < 16; ++r) { const int row = row0 + crow16(r, hi); const float x = acc[r] * pg8::row_rstd(ssq, row) + fb;
                lf[(size_t)row * 8 + r32] = fminf(x, 0.f) - __logf(1.0f + __expf(-fabsf(x))); } }
    }
}
__device__ __forceinline__ void pb_task(const float* p, bf16* pb, int gtid, int GT) {
    for (int i = gtid; i < M * PLE / 8; i += GT) { const f32x4 v0 = *(const f32x4*)(p + (size_t)i * 8), v1 = *(const f32x4*)(p + (size_t)i * 8 + 4);
        v4u o; o.x = cvtpk(v0[0], v0[1]); o.y = cvtpk(v0[2], v0[3]); o.z = cvtpk(v1[0], v1[1]); o.w = cvtpk(v1[2], v1[3]); *(v4u*)(pb + (size_t)i * 8) = o; }
}

__device__ __forceinline__ void cumsum_task(const float* lf, float* cb, LAS float* tot, int G, int bx, int tid) {
    for (int bh = bx; bh < BATCH * NFH; bh += G) {
        const int b = bh >> 3, h = bh & 7; float v[16]; float s = 0.f;
#pragma unroll
        for (int i = 0; i < 16; ++i) { s += lf[((size_t)b * SEQ + tid * 16 + i) * 8 + h]; v[i] = s; }
        tot[tid] = s; __syncthreads();
        float off = 0.f; for (int t = 0; t < tid; ++t) off += tot[t];
#pragma unroll
        for (int i = 0; i < 16; ++i) cb[(size_t)bh * SEQ + tid * 16 + i] = (off + v[i]) * LOG2E;
        __syncthreads();
    }
}
__device__ __forceinline__ void fill_img(LAS unsigned char* img, const bf16* g, int t256) {
#pragma unroll
    for (int i = 0; i < 4; ++i) { const int idx = t256 + 256 * i, row = idx >> 3, ch = idx & 7;
        *(LAS v4u*)(img + (ch >> 2) * 8192 + row * 64 + (ch & 3) * 16) = *(const v4u*)(g + (size_t)row * DM + ch * 8); }
}
__device__ __forceinline__ void ret_state_phase(LAS unsigned char* ldsl, const bf16* KK, const bf16* VV, float* U, int G, int bx, int tid) {
    const int lane = tid & 63, wave = __builtin_amdgcn_readfirstlane(tid >> 6), h2 = wave >> 2, w4 = wave & 3, t256 = tid & 255;
    const int r32 = lane & 31, hi = lane >> 5, g1 = (lane >> 4) & 1, q = (lane & 15) >> 2, p = lane & 3;
    LAS unsigned char* base = ldsl + h2 * 32768;
    for (int it = 0; (it * G + bx) * 2 < BATCH * NFH * NCHK; ++it) {
        const int cid = (it * G + bx) * 2 + h2, bh = cid >> 6, c = cid & 63, b = bh >> 3, h = bh & 7;
        const size_t goff = ((size_t)b * SEQ + c * 128) * DM + 512 + h * 64;
        fill_img(base, KK + goff, t256); fill_img(base + 16384, VV + goff, t256);
        __syncthreads();
        const int eb = w4 & 1, db = w4 >> 1;
        LAS unsigned char* va = base + 16384 + eb * 8192 + (8 * hi + q) * 64 + g1 * 32 + p * 8;
        LAS unsigned char* ka = base + db * 8192 + (8 * hi + q) * 64 + g1 * 32 + p * 8;
        f32x16 acc; for (int i = 0; i < 16; ++i) acc[i] = 0.f;
#pragma unroll
        for (int s = 0; s < 8; ++s) acc = MFMA32(cat8(trd(va + s * 1024), trd(va + s * 1024 + 256)), cat8(trd(ka + s * 1024), trd(ka + s * 1024 + 256)), acc);
        const float g128 = __builtin_amdgcn_exp2f(128.0f * pg8::lg2gamma(h));
        float* up = U + (size_t)cid * 4096 + 32 * db + r32;
#pragma unroll
        for (int r = 0; r < 16; ++r) up[(32 * eb + crow16(r, hi)) * 64] = acc[r] * g128;
        __syncthreads();
    }
}
__device__ __forceinline__ void ret_scan_task(const float* U, bf16* S, int gtid, int GT) {
    for (int pi = gtid; pi < BATCH * NFH * 2048; pi += GT) {
        const int bh = pi >> 11, ed = (pi & 2047) * 2, h = bh & 7; const float g128 = __builtin_amdgcn_exp2f(128.0f * pg8::lg2gamma(h));
        float s0 = 0.f, s1 = 0.f;
#pragma unroll 8
        for (int c = 0; c < NCHK; ++c) { const size_t idx = ((size_t)bh * NCHK + c) * 4096 + ed;
            *(unsigned*)(S + idx) = cvtpk(s0, s1); const f32x2_ u = *(const f32x2_*)(U + idx); s0 = g128 * s0 + u.x; s1 = g128 * s1 + u.y; }
    }
}
__device__ __forceinline__ void ret_out_phase(LAS unsigned char* ldsl, bf16* QO, const bf16* KK, const bf16* VV, const bf16* Gt, const bf16* S, int G, int bx, int tid) {
    const int lane = tid & 63, wave = __builtin_amdgcn_readfirstlane(tid >> 6), h2 = wave >> 2, qb = wave & 3, t256 = tid & 255;
    const int r32 = lane & 31, hi = lane >> 5, g1 = (lane >> 4) & 1, q = (lane & 15) >> 2, p = lane & 3;
    LAS unsigned char* base = ldsl + h2 * 40960;
    LAS unsigned char* stg = base + 16384 + qb * 4608;
    for (int it = 0; (it * G + bx) * 2 < BATCH * NFH * NCHK; ++it) {
        const int cid = (it * G + bx) * 2 + h2, bh = cid >> 6, c = cid & 63, b = bh >> 3, h = bh & 7;
        const size_t grow0 = (size_t)b * SEQ + c * 128; const int colh = 512 + h * 64;
        fill_img(base, VV + grow0 * DM + colh, t256);
        bf16x8 qf[4];
#pragma unroll
        for (int ks = 0; ks < 4; ++ks) qf[ks] = *(const bf16x8*)(QO + (grow0 + 32 * qb + r32) * DM + colh + 16 * ks + 8 * hi);
        __syncthreads();
        f32x16 o0, o1; for (int i = 0; i < 16; ++i) { o0[i] = 0.f; o1[i] = 0.f; }
        LAS unsigned char* vb = base + (4 * hi + q) * 64 + g1 * 32 + p * 8;
#pragma unroll
        for (int kb = 0; kb < 4; ++kb) if (kb <= qb) {
            f32x16 st; for (int i = 0; i < 16; ++i) st[i] = 0.f;
#pragma unroll
            for (int ks = 0; ks < 4; ++ks) st = MFMA32(*(const bf16x8*)(KK + (grow0 + 32 * kb + r32) * DM + colh + 16 * ks + 8 * hi), qf[ks], st);
            if (kb == qb) {
#pragma unroll
                for (int r = 0; r < 16; ++r) if (crow16(r, hi) > r32) st[r] = 0.f;
            }
#pragma unroll
            for (int s = 0; s < 2; ++s) { v4u w; w.x = cvtpk(st[8 * s], st[8 * s + 1]); w.y = cvtpk(st[8 * s + 2], st[8 * s + 3]); w.z = cvtpk(st[8 * s + 4], st[8 * s + 5]); w.w = cvtpk(st[8 * s + 6], st[8 * s + 7]);
                const bf16x8 pk = __builtin_bit_cast(bf16x8, w); LAS unsigned char* vr = vb + (32 * kb + 16 * s) * 64;
                o0 = MFMA32(cat8(trd(vr), trd(vr + 512)), pk, o0); o1 = MFMA32(cat8(trd(vr + 8192), trd(vr + 8192 + 512)), pk, o1); }
        }
        { const bf16* sp = S + (size_t)cid * 4096 + r32 * 64 + 8 * hi;
#pragma unroll
          for (int ks = 0; ks < 4; ++ks) { o0 = MFMA32(*(const bf16x8*)(sp + 16 * ks), qf[ks], o0); o1 = MFMA32(*(const bf16x8*)(sp + 32 * 64 + 16 * ks), qf[ks], o1); } }
        float sm = 0.f;
#pragma unroll
        for (int r = 0; r < 16; ++r) sm += o0[r] + o1[r];
        sm += __shfl_xor(sm, 32); const float mu = sm * (1.0f / 64.0f); float vs = 0.f;
#pragma unroll
        for (int r = 0; r < 16; ++r) { const float d0 = o0[r] - mu, d1 = o1[r] - mu; vs += d0 * d0 + d1 * d1; }
        vs += __shfl_xor(vs, 32); const float rstd = __builtin_amdgcn_rsqf(vs * (1.0f / 64.0f) + 1e-5f);
#pragma unroll
        for (int g = 0; g < 4; ++g) { typedef unsigned u32x2_ __attribute__((ext_vector_type(2)));
            u32x2_ w0, w1; w0.x = cvtpk((o0[4 * g] - mu) * rstd, (o0[4 * g + 1] - mu) * rstd); w0.y = cvtpk((o0[4 * g + 2] - mu) * rstd, (o0[4 * g + 3] - mu) * rstd);
            w1.x = cvtpk((o1[4 * g] - mu) * rstd, (o1[4 * g + 1] - mu) * rstd); w1.y = cvtpk((o1[4 * g + 2] - mu) * rstd, (o1[4 * g + 3] - mu) * rstd);
            *(LAS u32x2_*)(stg + r32 * 136 + (8 * g + 4 * hi) * 2) = w0; *(LAS u32x2_*)(stg + r32 * 136 + (32 + 8 * g + 4 * hi) * 2) = w1; }
        LDS_WAIT(); asm volatile("" ::: "memory");
#pragma unroll
        for (int i = 0; i < 4; ++i) { typedef unsigned u32x2_ __attribute__((ext_vector_type(2)));
            const int row = i * 8 + (lane >> 3), ch = lane & 7; const u32x2_ a = *(LAS u32x2_*)(stg + row * 136 + ch * 16), bq = *(LAS u32x2_*)(stg + row * 136 + ch * 16 + 8);
            const v4u y = (v4u){a.x, a.y, bq.x, bq.y}; const v4u gv = *(const v4u*)(Gt + (grow0 + 32 * qb + row) * 512 + h * 64 + ch * 8);
            pg8::f32x4 y0, y1, g0, g1_; pg8::unpack8(y, y0, y1); pg8::unpack8(gv, g0, g1_);
            *(v4u*)(QO + (grow0 + 32 * qb + row) * DM + colh + ch * 8) = pg8::pack8(y0 * g0, y1 * g1_); }
        __syncthreads();
    }
}
__device__ __forceinline__ void final_task(float* out, const float* ssq, const float* wf, int gw, int NGW, int lane) {
    f32x4 w[4];
#pragma unroll
    for (int j = 0; j < 4; ++j) w[j] = *(const f32x4*)(wf + j * 256 + lane * 4);
    for (int m = gw; m < M; m += NGW) { const float rs = pg8::row_rstd(ssq, m); float* o = out + (size_t)m * DM;
#pragma unroll
        for (int j = 0; j < 4; ++j) { f32x4 v = *(const f32x4*)(o + j * 256 + lane * 4); v = v * rs * w[j]; *(f32x4*)(o + j * 256 + lane * 4) = v; } }
}

#define PH_BEGIN() int tq = threadIdx.x; asm volatile("" : "+v"(tq)); GAS unsigned char* wsg_ = (GAS unsigned char*)args.ws; asm volatile("" : "+s"(wsg_)); unsigned char* ws = (unsigned char*)wsg_;     \
    const int lq = tq & 63, wq = __builtin_amdgcn_readfirstlane(tq >> 6), gtq = bx * (NWAVES * 64) + tq, gw = vcu * NWAVES + wq; (void)lq; (void)wq; (void)gtq; (void)gw
#define SSQB(n) ((float*)(ws + (((n) & 1) ? WS_SSQ1 : WS_SSQ0)))
__global__ void __launch_bounds__(NWAVES * 64, 2) fwd(Args args) {
    extern __shared__ __attribute__((aligned(16))) unsigned char lds[];
    LAS unsigned char* ldsl = (LAS unsigned char*)lds;
    volatile LAS unsigned* MISC = (volatile LAS unsigned*)(ldsl + MISC_OFF);
    const int G = gridDim.x, bx = blockIdx.x, vcu = (G % 8 == 0) ? (bx % 8) * (G / 8) + bx / 8 : bx;
    const int NGW = G * NWAVES, GT = G * NWAVES * 64;
    for (int u = threadIdx.x; u < (LDS_BYTES - LDSCTL_OFF) / 4; u += NWAVES * 64) ((LAS unsigned*)(ldsl + LDSCTL_OFF))[u] = 0u;
    __syncthreads();
    const int lo = args.ph_lo, hi = args.ph_hi;
    XcdBarrier bar; bar.bar = (unsigned*)(args.ws + WS_CTL) + CW_BAR; bar.x = 0; bar.st = nullptr;
    if (hi - lo > 1) bar = xcd_barrier_post((unsigned*)(args.ws + WS_CTL) + CW_BAR, MISC + 8);
#define IN(k) (lo <= (k) && (k) < hi)
#define SEAM(k) do { if (IN(k) && IN((k) + 1)) xcd_barrier(bar); } while (0)

    if (IN(0)) { PH_BEGIN(); prologue(args, ws, ldsl, gw, NGW, wq, lq, gtq, GT); }
    SEAM(0);

    for (int L = 0; L < DEPTH; ++L) {
        const int p0 = 1 + 9 * L;
        if (IN(p0)) {
            PH_BEGIN();
            const bf16* hin = (const bf16*)(ws + ((L == 0) ? WS_HB : WS_HBT));
            flogit_task(hin, (const bf16*)(ws + WS_WFB) + (size_t)L * 8 * DM, SSQB(3 * L), args.in[4] + L * NFH, (float*)(ws + WS_LF), G, bx, wq, lq);
            pb_task(args.in[1] + (size_t)L * M * PLE, (bf16*)(ws + WS_PB), gtq, GT);
            pg8::Gemm g{hin, (const bf16*)(ws + WS_W + (size_t)L * W_LAYER + WO_IN), M, NIN, DM}; pg8::StaticOrder S; S.init(M, NIN, G, bx);
            pg8::EpiIn E{(bf16*)(ws + WS_QO), (bf16*)(ws + WS_KK), (bf16*)(ws + WS_VV), (bf16*)(ws + WS_G), SSQB(3 * L), (const float*)(ws + WS_CS)};
            pg8::gemm_phase<pg8::EpiIn, pg8::StaticOrder, PG8_ALIGN, PG8_SP2>(ldsl, g, S, E);
        }
        SEAM(p0);
        if (IN(p0 + 1)) {
            PH_BEGIN();
            cumsum_task((const float*)(ws + WS_LF), (float*)(ws + WS_CB), (LAS float*)ldsl, G, bx, tq);
            ret_state_phase(ldsl, (const bf16*)(ws + WS_KK), (const bf16*)(ws + WS_VV), (float*)(ws + WS_U), G, bx, tq);
        }
        SEAM(p0 + 1);
        if (IN(p0 + 2)) {
            PH_BEGIN();
            ret_scan_task((const float*)(ws + WS_U), (bf16*)(ws + WS_S), gtq, GT);
            const attn_body::AttnTensors AT{(const attn_body::bf16*)(ws + WS_QO), (const attn_body::bf16*)(ws + WS_KK), (const attn_body::bf16*)(ws + WS_VV), (attn_body::bf16*)(ws + WS_QO)};
            const attn_body::StaticOrder S(G, bx);
            attn_body::attn_phase<attn_body::StaticOrder>((char*)lds, AT, (const float*)(ws + WS_CB), S);
        }
        SEAM(p0 + 2);
        if (IN(p0 + 3)) { PH_BEGIN(); ret_out_phase(ldsl, (bf16*)(ws + WS_QO), (const bf16*)(ws + WS_KK), (const bf16*)(ws + WS_VV), (const bf16*)(ws + WS_G), (const bf16*)(ws + WS_S), G, bx, tq); }
        SEAM(p0 + 3);
        if (IN(p0 + 4)) {
            PH_BEGIN();
            pg8::Gemm g{(const bf16*)(ws + WS_QO), (const bf16*)(ws + WS_W + (size_t)L * W_LAYER + WO_OUT), M, DM, DM}; pg8::StaticOrder S; S.init(M, DM, G, bx);
            pg8::EpiRes<0> E{(L == 0) ? args.in[0] : args.out, args.out, (bf16*)(ws + WS_HB), SSQB(3 * L + 1), nullptr, nullptr};
            pg8::gemm_phase<pg8::EpiRes<0>, pg8::StaticOrder, PG8_ALIGN, PG8_SP2>(ldsl, g, S, E);
        }
        SEAM(p0 + 4);
        if (IN(p0 + 5)) {
            PH_BEGIN();
            pg8::Gemm g{(const bf16*)(ws + WS_HB), (const bf16*)(ws + WS_W + (size_t)L * W_LAYER + WO_A), M, FF, DM}; pg8::StaticOrder S; S.init(M, FF, G, bx);
            pg8::EpiScaleBf16 E{(bf16*)(ws + WS_A), FF, SSQB(3 * L + 1)};
            pg8::gemm_phase<pg8::EpiScaleBf16, pg8::StaticOrder, PG8_ALIGN, PG8_SP2>(ldsl, g, S, E);
        }
        SEAM(p0 + 5);
        if (IN(p0 + 6)) {
            PH_BEGIN();
            pg8::Gemm g{(const bf16*)(ws + WS_HB), (const bf16*)(ws + WS_W + (size_t)L * W_LAYER + WO_G), M, FF, DM}; pg8::StaticOrder S; S.init(M, FF, G, bx);
            pg8::EpiGate E{(const bf16*)(ws + WS_A), (bf16*)(ws + WS_ACT), SSQB(3 * L + 1), args.in[8] + (size_t)L * 3 * FF, args.in[9] + (size_t)L * FF};
            pg8::gemm_phase<pg8::EpiGate, pg8::StaticOrder, PG8_ALIGN, PG8_SP2>(ldsl, g, S, E);
        }
        SEAM(p0 + 6);
        if (IN(p0 + 7)) {
            { PH_BEGIN();
              pg8::Gemm g{(const bf16*)(ws + WS_PB), (const bf16*)(ws + WS_W + (size_t)L * W_LAYER + WO_PROJ), M, DM, PLE}; pg8::StaticOrder S; S.init(M, DM, G, bx);
              pg8::EpiBf16<0> E{(bf16*)(ws + WS_PP), DM, nullptr, 0, 0, 1.f};
              pg8::gemm_phase<pg8::EpiBf16<0>, pg8::StaticOrder, PG8_ALIGN, PG8_SP2>(ldsl, g, S, E); }
            { PH_BEGIN();
              pg8::Gemm g{(const bf16*)(ws + WS_ACT), (const bf16*)(ws + WS_W + (size_t)L * W_LAYER + WO_DOWN), M, DM, FF}; pg8::StaticOrder S; S.init(M, DM, G, bx);
              pg8::EpiRes<0> E{args.out, args.out, (bf16*)(ws + WS_HB), SSQB(3 * L + 2), nullptr, nullptr};
              pg8::gemm_phase<pg8::EpiRes<0>, pg8::StaticOrder, PG8_ALIGN, PG8_SP2>(ldsl, g, S, E); }
        }
        SEAM(p0 + 7);
        if (IN(p0 + 8)) {
            PH_BEGIN();
            pg8::Gemm g{(const bf16*)(ws + WS_HB), (const bf16*)(ws + WS_W + (size_t)L * W_LAYER + WO_GATE), M, DM, DM}; pg8::StaticOrder S; S.init(M, DM, G, bx);
            pg8::EpiRes<1> E{args.out, args.out, (bf16*)(ws + WS_HBT), SSQB(3 * L + 3), SSQB(3 * L + 2), (const bf16*)(ws + WS_PP)};
            pg8::gemm_phase<pg8::EpiRes<1>, pg8::StaticOrder, PG8_ALIGN, PG8_SP2>(ldsl, g, S, E);
        }
        SEAM(p0 + 8);
    }
    if (IN(NPH - 1)) { PH_BEGIN(); final_task(args.out, SSQB(3 * DEPTH), args.in[14], gw, NGW, lq); }
#undef IN
#undef SEAM
}

extern "C" void kernel_launch(void* const* d_in, const int* in_sizes, int n_in, void* d_out, int out_size, void* d_ws, size_t ws_size, hipStream_t stream) {
    static int grid = 0;
    if (grid == 0) {
        if (n_in != 15 || out_size != M * DM || ws_size < WS_END) { fprintf(stderr, "kernel_launch: unexpected sizes (n_in %d, out %d, ws %zu)\n", n_in, out_size, ws_size); grid = -1; return; }
        if (hipFuncSetAttribute((const void*)fwd, hipFuncAttributeMaxDynamicSharedMemorySize, LDS_BYTES) != hipSuccess) { fprintf(stderr, "kernel_launch: hipFuncSetAttribute failed\n"); grid = -1; return; }
        int dev = 0, cus = 0, per_cu = 0;
        (void)hipGetDevice(&dev); (void)hipDeviceGetAttribute(&cus, hipDeviceAttributeMultiprocessorCount, dev);
        if (hipOccupancyMaxActiveBlocksPerMultiprocessor(&per_cu, (const void*)fwd, NWAVES * 64, LDS_BYTES) != hipSuccess || per_cu < 1) fprintf(stderr, "kernel_launch: occupancy query says %d\n", per_cu);
        (void)hipGetLastError();
        grid = 256;
        if (cus != 256) fprintf(stderr, "kernel_launch: device has %d CUs; this kernel's unit maps are built for 256\n", cus);
    }
    if (grid < 0) return;
    (void)hipMemsetAsync((char*)d_ws + WS_CTL, 0, CTL_ZERO_BYTES, stream);
    Args a{};
    for (int i = 0; i < 15; ++i) a.in[i] = (const float*)d_in[i];
    a.out = (float*)d_out; a.ws = (unsigned char*)d_ws;
#if MK_ONE_LAUNCH
    a.ph_lo = 0; a.ph_hi = NPH;
    hipLaunchKernelGGL(fwd, dim3(grid), dim3(NWAVES * 64), LDS_BYTES, stream, a);
#else
    for (int ph = 0; ph < NPH; ++ph) { a.ph_lo = ph; a.ph_hi = ph + 1; hipLaunchKernelGGL(fwd, dim3(grid), dim3(NWAVES * 64), LDS_BYTES, stream, a); }
#endif
}
```

```cpp
#include <hip/hip_runtime.h>
#include <cstdio>
#include <cstdint>
__device__ __forceinline__ int tid_now(int wv) { unsigned m1 = ~0u; asm volatile("" : "+s"(m1)); return (wv << 6) | (int)__builtin_amdgcn_mbcnt_hi(m1, __builtin_amdgcn_mbcnt_lo(m1, 0u)); }
namespace pg8 {
#define PG8_LAS __attribute__((address_space(3)))
typedef unsigned short bf16_t;
typedef short bf16x8 __attribute__((ext_vector_type(8)));
typedef float f32x4 __attribute__((ext_vector_type(4)));
typedef unsigned u32x4 __attribute__((ext_vector_type(4)));
constexpr int BM = 256, BK = 64, HALF = 128, HTB = HALF * BK * 2  , STAGE_BYTES = 8 * HTB, NXCD = 8, WGM = 8;

__host__ __device__ __forceinline__ int lds_byte(int r, int c) { const int st = (r >> 4) * 2 + (c >> 5), rr = r & 15, cc = c & 31, ob = rr * 64 + cc * 2; return st * 1024 + (ob ^ (((ob >> 9) & 1) << 5)); }
__host__ __device__ __forceinline__ void stage_rc(int b, int& R, int& C) { const int st = b / 1024, sb = b % 1024, swz = sb ^ (((sb >> 9) & 1) << 5); R = (st >> 1) * 16 + swz / 64; C = (st & 1) * 32 + (swz % 64) / 2; }
__host__ __device__ __forceinline__ int perm32(int rho) { const int n = rho >> 4, i = rho & 15; return 8 * (i >> 2) + 4 * n + (i & 3); }

struct Unit { int pm, pn; };
struct Gemm { const bf16_t* A; const bf16_t* Bt; int M, N, K; };

struct StaticOrder {
    int nM, nN, nwg, G, c, rev;
    __host__ __device__ void init(int M, int N, int G_, int c_, int rev_ = 0) { nM = M / BM; nN = N / BM; nwg = nM * nN; G = G_; c = c_; rev = rev_; }
    __host__ __device__ bool next(int i, Unit& u) const {
        const int nr = (nwg + G - 1) / G; if (i >= nr) return false;
        const long L = (long)(rev ? nr - 1 - i : i) * G + c; if (L >= nwg) return false;
        int wgid = (int)L; { const int q = nwg / NXCD, r = nwg % NXCD, xcd = wgid % NXCD, off = wgid / NXCD; wgid = (xcd < r ? xcd * (q + 1) : r * (q + 1) + (xcd - r) * q) + off; }
        const int nig = WGM * nN, gid = wgid / nig, fm = gid * WGM, gsz = (nM - fm) < WGM ? (nM - fm) : WGM;
        u.pm = fm + ((wgid % nig) % gsz); u.pn = (wgid % nig) / gsz; return true;
    }
    __device__ __forceinline__ void a_ready(const Unit&) const {}
    __device__ __forceinline__ void done(const Unit&) const {}
};

__device__ __forceinline__ unsigned cvt_pk_bf16(float lo, float hi) { unsigned r; asm volatile("v_cvt_pk_bf16_f32 %0, %1, %2" : "=v"(r) : "v"(lo), "v"(hi)); return r; }
typedef float f32x2 __attribute__((ext_vector_type(2)));
__device__ __forceinline__ f32x2 gelu_pk(f32x2 v) {
    f32x2 vc; vc.x = __builtin_amdgcn_fmed3f(v.x, -5.656854249f, 5.656854249f); vc.y = __builtin_amdgcn_fmed3f(v.y, -5.656854249f, 5.656854249f);
    const f32x2 v2 = vc * vc;
    f32x2 p = v2 * (-1.505995060e-12f) + 3.061199413e-10f; p = p * v2 + (-4.642651039e-08f); p = p * v2 + (-2.515756171e-06f); p = p * v2 + (-6.496460735e-05f); p = p * v2 + (-5.223043901e-04f); p = p * v2 + (-5.690807158e-03f);
    f32x2 q = v2 * (-9.103794904e-07f) + (-2.667175691e-05f); q = q * v2 + (-4.207067436e-04f); q = q * v2 + (-3.686664584e-03f); q = q * v2 + (-1.426473905e-02f);
    f32x2 r; r.x = __builtin_amdgcn_rcpf(q.x); r.y = __builtin_amdgcn_rcpf(q.y);
    const f32x2 t = (vc * p) * r + 0.5f;
    return v * t;
}

template <int ACT  > struct EpiBf16 {
    static constexpr bool PERM = true, AFTER_DRAIN = false; static_assert(ACT == 0 || ACT == 1, "EpiBf16: ACT is 0 (none) or 1 (gelu_pk)");
    bf16_t* O; int ldc; const float* bias; int split_cols; size_t split_stride; float scale0;
    __device__ __forceinline__ void operator()(const f32x4 (&acc)[2][2][4][2], const Unit& u, int wr, int wc, int fr, int fq) const {
        const int row0 = u.pm * BM + wr * 64 + fr; int colt = u.pn * BM; bf16_t* base = O;
        float sc = 1.f; if (split_cols) { const int t = colt / split_cols; base += (size_t)t * split_stride; colt -= t * split_cols; if (t == 0) sc = scale0; }
        const int col0 = colt + wc * 32 + 8 * fq, bcol0 = u.pn * BM + wc * 32 + 8 * fq;
        f32x4 bv[2][2];
#pragma unroll
        for (int bj = 0; bj < 2; ++bj)
#pragma unroll
            for (int n = 0; n < 2; ++n) bv[bj][n] = bias ? *(const f32x4*)(bias + bcol0 + bj * HALF + 4 * n) : (f32x4){0.f, 0.f, 0.f, 0.f};
#pragma unroll
        for (int ai = 0; ai < 2; ++ai)
#pragma unroll
            for (int m = 0; m < 4; ++m) { bf16_t* rowp = base + (size_t)(row0 + ai * HALF + m * 16) * ldc + col0;
#pragma unroll
                for (int bj = 0; bj < 2; ++bj) { f32x4 v0 = acc[ai][bj][m][0] + bv[bj][0], v1 = acc[ai][bj][m][1] + bv[bj][1];
                    if (ACT == 1) { f32x2 a = gelu_pk((f32x2){v0[0], v0[1]}), b = gelu_pk((f32x2){v0[2], v0[3]}), c = gelu_pk((f32x2){v1[0], v1[1]}), d = gelu_pk((f32x2){v1[2], v1[3]});
                        v0 = (f32x4){a.x, a.y, b.x, b.y}; v1 = (f32x4){c.x, c.y, d.x, d.y}; }
                    v0 = v0 * sc; v1 = v1 * sc; u32x4 w; w.x = cvt_pk_bf16(v0[0], v0[1]); w.y = cvt_pk_bf16(v0[2], v0[3]); w.z = cvt_pk_bf16(v1[0], v1[1]); w.w = cvt_pk_bf16(v1[2], v1[3]);
                    *(u32x4*)(rowp + bj * HALF) = w; } }
    }
};
constexpr float ATT_C2 = 0.125f * 1.4426950408889634f;
constexpr float RMS_EPS = 1e-6f;
__device__ __forceinline__ float lg2gamma(int h) { const float x = __builtin_amdgcn_exp2f(-5.0f - (float)h);
    return -x * (1.0f + x * (0.5f + x * (0.33333334f + x * (0.25f + x * (0.2f + x * 0.16666667f))))) * 1.4426950408889634f; }
__device__ __forceinline__ float xor16f(float v) { return __int_as_float(__builtin_amdgcn_ds_swizzle(__float_as_int(v), 0x401F)); }
__device__ __forceinline__ float halves_sum(float v) { const auto rr = __builtin_amdgcn_permlane32_swap(__float_as_uint(v), __float_as_uint(v), false, false); return __uint_as_float(rr[0]) + __uint_as_float(rr[1]); }
__device__ __forceinline__ float row_rstd(const float* ssq16, int row) {
    const f32x4* p = (const f32x4*)(ssq16 + (size_t)row * 16);
    const f32x4 a = p[0], b = p[1], c = p[2], d = p[3];
    const float s = (((a[0] + a[1]) + (a[2] + a[3])) + ((b[0] + b[1]) + (b[2] + b[3]))) + (((c[0] + c[1]) + (c[2] + c[3])) + ((d[0] + d[1]) + (d[2] + d[3])));
    return __builtin_amdgcn_rsqf(s * (1.0f / 1024.0f) + RMS_EPS);
}
__device__ __forceinline__ float row_rstd4(const float* ssq16, int row, int fq) {
    const f32x4 a = *(const f32x4*)(ssq16 + (unsigned)(row * 16 + 4 * fq));
    float s = (a[0] + a[1]) + (a[2] + a[3]); s += xor16f(s); s = halves_sum(s);
    return __builtin_amdgcn_rsqf(s * (1.0f / 1024.0f) + RMS_EPS);
}
__device__ __forceinline__ u32x4 pack8(const f32x4& v0, const f32x4& v1) { u32x4 w; w.x = cvt_pk_bf16(v0[0], v0[1]); w.y = cvt_pk_bf16(v0[2], v0[3]); w.z = cvt_pk_bf16(v1[0], v1[1]); w.w = cvt_pk_bf16(v1[2], v1[3]); return w; }
__device__ __forceinline__ float bf_lo(unsigned w) { return __uint_as_float(w << 16); }
__device__ __forceinline__ float bf_hi(unsigned w) { return __uint_as_float(w & 0xffff0000u); }
__device__ __forceinline__ void unpack8(const u32x4& w, f32x4& v0, f32x4& v1) { v0 = (f32x4){bf_lo(w.x), bf_hi(w.x), bf_lo(w.y), bf_hi(w.y)}; v1 = (f32x4){bf_lo(w.z), bf_hi(w.z), bf_lo(w.w), bf_hi(w.w)}; }
__device__ __forceinline__ float sigmoidf_(float x) { return __builtin_amdgcn_rcpf(1.0f + __expf(-x)); }

struct EpiIn {
    static constexpr bool PERM = true, AFTER_DRAIN = false;
    bf16_t *QO, *KK, *VV, *G; const float* ssq; const float* cs; float* nrm;
    template <int TYPE> __device__ __forceinline__ void run(const f32x4 (&acc)[2][2][4][2], const Unit& u, int wr, int wc, int fr, int fq) const {
        const int half = u.pn & 1, row0 = u.pm * BM + wr * 64 + fr, csub0 = half * 256 + wc * 32 + 8 * fq, jj = 4 * (wc & 1) + fq;
        float lgv[2] = {0.f, 0.f};
        if (TYPE == 3 || TYPE == 4) { lgv[0] = lg2gamma(csub0 >> 6); lgv[1] = lg2gamma((csub0 + 128) >> 6); }
        float rsa[2][4]; f32x4 cva[2][4], sva[2][4];
#pragma unroll
        for (int ai = 0; ai < 2; ++ai)
#pragma unroll
            for (int m = 0; m < 4; ++m) { const int row = row0 + ai * HALF + m * 16; rsa[ai][m] = row_rstd4(ssq, row, fq);
                if (TYPE == 3 || TYPE == 4) { const int pos = row & 8191; cva[ai][m] = *(const f32x4*)(cs + pos * 32 + 4 * jj); sva[ai][m] = *(const f32x4*)(cs + 8192 * 32 + pos * 32 + 4 * jj); } }
#pragma unroll
        for (int ai = 0; ai < 2; ++ai)
#pragma unroll
            for (int m = 0; m < 4; ++m) {
                const int row = row0 + ai * HALF + m * 16; const float rs = rsa[ai][m];
                f32x4 cv = (f32x4){0.f, 0.f, 0.f, 0.f}, sv = cv; float i1 = 0.f;
                if (TYPE == 3 || TYPE == 4) { cv = cva[ai][m]; sv = sva[ai][m]; i1 = (float)((row & 127) + 1); }
#pragma unroll
                for (int bj = 0; bj < 2; ++bj) {
                    f32x4 v0 = acc[ai][bj][m][0] * rs, v1 = acc[ai][bj][m][1] * rs;
                    const int csub = csub0 + bj * 128; bf16_t* dst;
                    if (TYPE == 0) { v0 = v0 * ATT_C2; v1 = v1 * ATT_C2; dst = QO + (unsigned)(row * 1024 + csub); }
                    else if (TYPE == 1) dst = KK + (unsigned)(row * 1024 + csub);
                    if (TYPE == 0 || TYPE == 1) { float s = ((v0[0] * v0[0] + v0[1] * v0[1]) + (v0[2] * v0[2] + v0[3] * v0[3])) + ((v1[0] * v1[0] + v1[1] * v1[1]) + (v1[2] * v1[2] + v1[3] * v1[3]));
                        s += xor16f(s); s = halves_sum(s); if (fq == 0) nrm[(unsigned)(TYPE * (65536 * 16) + row * 16 + (csub >> 6) * 2 + (wc & 1))] = s; }
                    else if (TYPE == 2) dst = VV + (unsigned)(row * 1024 + csub);
                    else if (TYPE == 3 || TYPE == 4) {
                        const f32x4 o0 = v0 * cv - v1 * sv, o1 = v0 * sv + v1 * cv;
                        const float lg = lgv[bj];
                        const float f = (TYPE == 3) ? __builtin_amdgcn_exp2f(i1 * lg) : 0.125f * __builtin_amdgcn_exp2f(-i1 * lg);
                        v0 = o0 * f; v1 = o1 * f; dst = (TYPE == 3 ? QO : KK) + (unsigned)(row * 1024 + 512 + csub);
                    }
                    else if (TYPE == 5) dst = VV + (unsigned)(row * 1024 + 512 + csub);
                    else {
#pragma unroll
                        for (int i = 0; i < 4; ++i) { v0[i] = v0[i] * sigmoidf_(v0[i]); v1[i] = v1[i] * sigmoidf_(v1[i]); }
                        dst = G + (unsigned)(row * 512 + csub);
                    }
                    *(u32x4*)dst = pack8(v0, v1);
                }
            }
    }
    __device__ __forceinline__ void operator()(const f32x4 (&acc)[2][2][4][2], const Unit& u, int wr, int wc, int fr, int fq) const {
        switch (u.pn >> 1) { case 0: run<0>(acc, u, wr, wc, fr, fq); break; case 1: run<1>(acc, u, wr, wc, fr, fq); break; case 2: run<2>(acc, u, wr, wc, fr, fq); break; case 3: run<3>(acc, u, wr, wc, fr, fq); break;
            case 4: run<4>(acc, u, wr, wc, fr, fq); break; case 5: run<5>(acc, u, wr, wc, fr, fq); break; default: run<6>(acc, u, wr, wc, fr, fq); break; }
    }
};

template <int MODE> struct EpiRes {
    static constexpr bool PERM = true, AFTER_DRAIN = false;
    const bf16_t* hin; bf16_t* hout; float* ssqw; const float* ssqr; const bf16_t* pp;
    __device__ __forceinline__ void operator()(const f32x4 (&acc)[2][2][4][2], const Unit& u, int wr, int wc, int fr, int fq) const {
        const int row0 = u.pm * BM + wr * 64 + fr, col0 = u.pn * BM + wc * 32 + 8 * fq;
#define ER_OFF(ai, m, bj) ((unsigned)((row0 + (ai) * HALF + (m) * 16) * 1024 + col0 + (bj) * HALF))
#define ER_DO(ai, m, HV, PV, RS) do { float sq = 0.f; \
            _Pragma("unroll") for (int bj = 0; bj < 2; ++bj) { f32x4 h0, h1; unpack8(HV[bj], h0, h1); f32x4 a0 = acc[ai][bj][m][0], a1 = acc[ai][bj][m][1]; \
                if (MODE == 1) { f32x4 p0, p1; unpack8(PV[bj], p0, p1); _Pragma("unroll") for (int i = 0; i < 4; ++i) { a0[i] = sigmoidf_(a0[i] * (RS)) * p0[i]; a1[i] = sigmoidf_(a1[i] * (RS)) * p1[i]; } } \
                const f32x4 v0 = h0 + a0, v1 = h1 + a1; *(u32x4*)(hout + ER_OFF(ai, m, bj)) = pack8(v0, v1); \
                sq += ((v0[0] * v0[0] + v0[1] * v0[1]) + (v0[2] * v0[2] + v0[3] * v0[3])) + ((v1[0] * v1[0] + v1[1] * v1[1]) + (v1[2] * v1[2] + v1[3] * v1[3])); } \
            sq += xor16f(sq); sq = halves_sum(sq); if (fq == 0) ssqw[(unsigned)((row0 + (ai) * HALF + (m) * 16) * 16 + u.pn * 4 + wc)] = sq; } while (0)
        float rs[2][4];
#pragma unroll
        for (int ai = 0; ai < 2; ++ai)
#pragma unroll
            for (int m = 0; m < 4; ++m) rs[ai][m] = (MODE == 1) ? row_rstd4(ssqr, row0 + ai * HALF + m * 16, fq) : 1.f;
        constexpr int NS = (MODE == 1) ? 4 : 8;
        u32x4 hv[NS][2], pv[(MODE == 1) ? NS : 1][2];
#define ER_LD(g, s) do { _Pragma("unroll") for (int bj = 0; bj < 2; ++bj) { hv[s][bj] = *(const u32x4*)(hin + ER_OFF((g) >> 2, (g) & 3, bj)); if (MODE == 1) pv[s][bj] = *(const u32x4*)(pp + ER_OFF((g) >> 2, (g) & 3, bj)); } } while (0)
#define ER_B(g, s) ER_DO((g) >> 2, (g) & 3, hv[s], pv[(MODE == 1) ? (s) : 0], rs[(g) >> 2][(g) & 3])
#pragma unroll
        for (int g = 0; g < NS; ++g) ER_LD(g, g);
#pragma unroll
        for (int g = 0; g < 8; ++g) { ER_B(g, g % NS); if (g + NS < 8) ER_LD(g + NS, g % NS); }
#undef ER_LD
#undef ER_B
#undef ER_OFF
#undef ER_DO
    }
};

template <bool SCALE> struct EpiScaleBf16 {
    static constexpr bool PERM = true, AFTER_DRAIN = false;
    bf16_t* O; int ldo; const float* ssq;
    __device__ __forceinline__ void operator()(const f32x4 (&acc)[2][2][4][2], const Unit& u, int wr, int wc, int fr, int fq) const {
        const int row0 = u.pm * BM + wr * 64 + fr, col0 = u.pn * BM + wc * 32 + 8 * fq;
#pragma unroll
        for (int ai = 0; ai < 2; ++ai)
#pragma unroll
            for (int m = 0; m < 4; ++m) {
                const int row = row0 + ai * HALF + m * 16; const float rs = SCALE ? row_rstd4(ssq, row, fq) : 1.f;
#pragma unroll
                for (int bj = 0; bj < 2; ++bj) *(u32x4*)(O + (unsigned)(row * ldo + col0 + bj * HALF)) = pack8(acc[ai][bj][m][0] * rs, acc[ai][bj][m][1] * rs);
            }
    }
};

__device__ __forceinline__ unsigned dpp_sh1(unsigned prev, unsigned cur) {
    const unsigned t = (unsigned)__builtin_amdgcn_update_dpp(0, (int)prev, 0x121  , 0xF, 0xF, false);
    return (unsigned)__builtin_amdgcn_update_dpp((int)t, (int)cur, 0x111  , 0xF, 0xF, false); }
__device__ __forceinline__ unsigned dpp_sh2(unsigned prev, unsigned cur) {
    const unsigned t = (unsigned)__builtin_amdgcn_update_dpp(0, (int)prev, 0x122  , 0xF, 0xF, false);
    return (unsigned)__builtin_amdgcn_update_dpp((int)t, (int)cur, 0x112  , 0xF, 0xF, false); }
__device__ __forceinline__ float dppf_ror1(float v) { return __uint_as_float((unsigned)__builtin_amdgcn_mov_dpp((int)__float_as_uint(v), 0x121  , 0xF, 0xF, false)); }
__device__ __forceinline__ float dppf_ror2(float v) { return __uint_as_float((unsigned)__builtin_amdgcn_mov_dpp((int)__float_as_uint(v), 0x122  , 0xF, 0xF, false)); }
__device__ __forceinline__ float dppf_shr1_keep(float old, float cur) { return __uint_as_float((unsigned)__builtin_amdgcn_update_dpp((int)__float_as_uint(old), (int)__float_as_uint(cur), 0x111  , 0xF, 0xF, false)); }
__device__ __forceinline__ float dppf_shr2_keep(float old, float cur) { return __uint_as_float((unsigned)__builtin_amdgcn_update_dpp((int)__float_as_uint(old), (int)__float_as_uint(cur), 0x112  , 0xF, 0xF, false)); }
__device__ __forceinline__ float dppf_sh1(float prev, float cur) { return __uint_as_float(dpp_sh1(__float_as_uint(prev), __float_as_uint(cur))); }
__device__ __forceinline__ float dppf_sh2(float prev, float cur) { return __uint_as_float(dpp_sh2(__float_as_uint(prev), __float_as_uint(cur))); }
struct EpiFfnUp {
    static constexpr bool PERM = true, AFTER_DRAIN = false;
    bf16_t* O; const float* ssq; const float* cw; const float* cb; float* FIX; float* HAL; PG8_LAS float* xch;
    __device__ __forceinline__ void operator()(const f32x4 (&acc)[2][2][4][2], const Unit& u, int wr, int wc, int fr, int fq) const {
        constexpr int FF = 2816;
        const int grow = u.pm * BM + wr * 64, row0 = grow + fr, colL = wc * 32 + 8 * fq, col0 = u.pn * 128 + colL, unit = u.pm * 22 + u.pn;
        float rs[2][4];
#pragma unroll
        for (int ai = 0; ai < 2; ++ai)
#pragma unroll
            for (int m = 0; m < 4; ++m) rs[ai][m] = row_rstd4(ssq, row0 + ai * HALF + m * 16, fq);
        if (fr >= 14) {
#pragma unroll
            for (int ai = 0; ai < 2; ++ai) { const f32x4 v0 = acc[ai][0][3][0] * rs[ai][3], v1 = acc[ai][0][3][1] * rs[ai][3];
                PG8_LAS float* x = xch + ((((ai * 2 + wr) * 4 + wc) * 2 + (fr - 14)) * 4 + fq) * 8; *(PG8_LAS f32x4*)x = v0; *(PG8_LAS f32x4*)(x + 4) = v1;
                if (ai == 1 && wr == 1) { float* h = HAL + ((size_t)unit * 2 + (fr - 14)) * 128 + colL; *(f32x4*)h = v0; *(f32x4*)(h + 4) = v1; } }
        }
        asm volatile("s_waitcnt lgkmcnt(0)" ::: "memory"); __builtin_amdgcn_s_barrier(); asm volatile("" ::: "memory");
        const bool partial = (u.pm & 31) != 0;
#pragma unroll
        for (int n = 0; n < 2; ++n) {
            const int col = col0 + 4 * n;
            const f32x4 w0 = *(const f32x4*)(cw + col), w1 = *(const f32x4*)(cw + FF + col), w2 = *(const f32x4*)(cw + 2 * FF + col), bb = *(const f32x4*)(cb + col);
#pragma unroll
            for (int ai = 0; ai < 2; ++ai) {
                f32x4 prev = (f32x4){0.f, 0.f, 0.f, 0.f};
                if (!(ai == 0 && wr == 0) && fr >= 14) { const int pai = (ai == 1 && wr == 1) ? 1 : 0, pwr = wr ^ 1;
                    prev = *(const PG8_LAS f32x4*)(xch + ((((pai * 2 + pwr) * 4 + wc) * 2 + (fr - 14)) * 4 + fq) * 8 + 4 * n); }
                f32x4 r1, r2;
#pragma unroll
                for (int j = 0; j < 4; ++j) { r1[j] = dppf_ror1(prev[j]); r2[j] = dppf_ror2(prev[j]); }
#pragma unroll
                for (int m = 0; m < 4; ++m) {
                    const f32x4 cur = acc[ai][0][m][n] * rs[ai][m];
                    f32x4 s1, s2;
#pragma unroll
                    for (int j = 0; j < 4; ++j) { s1[j] = dppf_shr1_keep(r1[j], cur[j]); s2[j] = dppf_shr2_keep(r2[j], cur[j]); }
                    if (m < 3) {
#pragma unroll
                        for (int j = 0; j < 4; ++j) { r1[j] = dppf_ror1(cur[j]); r2[j] = dppf_ror2(cur[j]); } }
                    const f32x4 y0 = bb + w2 * cur + w1 * s1 + w0 * s2;
                    const f32x2 ga = gelu_pk((f32x2){y0[0], y0[1]}), gb = gelu_pk((f32x2){y0[2], y0[3]});
                    const f32x4 g0 = acc[ai][1][m][n] * rs[ai][m];
                    typedef unsigned u32x2_t __attribute__((ext_vector_type(2)));
                    const f32x2 pa = ga * (f32x2){g0[0], g0[1]}, pb = gb * (f32x2){g0[2], g0[3]};
                    u32x2_t ov; ov.x = cvt_pk_bf16(pa.x, pa.y); ov.y = cvt_pk_bf16(pb.x, pb.y);
                    *(u32x2_t*)(O + (unsigned)((row0 + ai * HALF + m * 16) * FF + col)) = ov;
                    if (ai == 0 && m == 0 && wr == 0 && partial && fr < 2) {
                        const f32x4 yp = (fr == 1) ? bb + w2 * cur + w1 * s1 : bb + w2 * cur;
                        float* fx = FIX + (((size_t)unit * 2 + fr) * 128 + colL + 4 * n) * 2;
                        *(f32x4*)fx = (f32x4){yp[0], g0[0], yp[1], g0[1]}; *(f32x4*)(fx + 4) = (f32x4){yp[2], g0[2], yp[3], g0[3]}; }
                }
            }
        }
    }
};
#ifndef PROBE_KDUP
#define PROBE_KDUP 0
#endif
#define PG8_UI(i) (KDUP ? ((i) >> 1) : (i))
template <class Epi, class Sched, bool ALIGN_EPI = false, bool SP2 = false, bool KDUP = false, bool EDUP = false, bool KROT = false>
__device__ __forceinline__ void gemm_phase(PG8_LAS unsigned char* lds, const Gemm g, const Sched& S, const Epi& E, const int wv  ) {
    static_assert(!KROT || SP2, "KROT is written for the SP2 loop");
    int tid = tid_now(wv); asm volatile("" : "+v"(tid));
    const int wid = __builtin_amdgcn_readfirstlane(tid >> 6), lane = tid & 63, wr = wid >> 2, wc = wid & 3, fr = lane & 15, fq = lane >> 4;
    const int K = g.K, nt = K / BK;
    unsigned voffA[2], voffB[2];
#pragma unroll
    for (int i = 0; i < 2; ++i) { int R, C; stage_rc(tid * 16 + i * 8192, R, C); const int Rb = Epi::PERM ? ((R & ~31) + perm32(R & 31)) : R;
        voffA[i] = (unsigned)(R * K + C) * 2u; voffB[i] = (unsigned)(Rb * K + C) * 2u; }
    const size_t kstep = (size_t)(BK * 2);
    const size_t hstep = (size_t)HALF * K * 2;
    const size_t tstep = 2 * hstep;
    const unsigned ldsw = (unsigned)wid * 1024u;
    const int aoff = lds_byte(wr * 64 + fr, fq * 8), boff = lds_byte(wc * 32 + fr, fq * 8);
#define PG8_SA(b, h) (((b) * 2 + (h)) * HTB)
#define PG8_SB(b, h) ((4 + (b) * 2 + (h)) * HTB)
#define PG8_STAGE(bufoff, gbase, voff) do { _Pragma("unroll") for (int _i = 0; _i < 2; ++_i) \
        __builtin_amdgcn_global_load_lds((const unsigned*)((const char*)(gbase) + (voff)[_i]), (PG8_LAS unsigned*)(lds + (bufoff) + ldsw + _i * 8192), 16, 0, 0); } while (0)
#define PG8_LDA(dst, b, h) do { _Pragma("unroll") for (int m = 0; m < 4; ++m) _Pragma("unroll") for (int k = 0; k < 2; ++k) dst[m][k] = *(const PG8_LAS bf16x8*)(lds + PG8_SA(b, h) + aoff + m * 2048 + k * 1024); } while (0)
#define PG8_LDB(dst, b, h) do { _Pragma("unroll") for (int n = 0; n < 2; ++n) _Pragma("unroll") for (int k = 0; k < 2; ++k) dst[n][k] = *(const PG8_LAS bf16x8*)(lds + PG8_SB(b, h) + boff + n * 2048 + k * 1024); } while (0)
#define PG8_MMA(ai, bj, At, Bt) do { __builtin_amdgcn_s_setprio(1); _Pragma("unroll") for (int m = 0; m < 4; ++m) _Pragma("unroll") for (int n = 0; n < 2; ++n) _Pragma("unroll") for (int k = 0; k < 2; ++k) \
        acc[ai][bj][m][n] = __builtin_amdgcn_mfma_f32_16x16x32_bf16(Bt[n][k], At[m][k], acc[ai][bj][m][n], 0, 0, 0); __builtin_amdgcn_s_setprio(0); } while (0)
#define PG8_WAIT_V(n) asm volatile("s_waitcnt vmcnt(" #n ")" ::: "memory")
#define PG8_WAIT_L(n) asm volatile("s_waitcnt lgkmcnt(" #n ")" ::: "memory")
#define PG8_BAR __builtin_amdgcn_s_barrier()
#define PG8_SCHED __builtin_amdgcn_sched_barrier(0)
    Unit cur, nxt; int ui = 0;
    if (!S.next(PG8_UI(0), cur)) return;
    f32x4 acc[2][2][4][2];
#pragma unroll
    for (int a = 0; a < 2; ++a)
#pragma unroll
        for (int b = 0; b < 2; ++b)
#pragma unroll
            for (int m = 0; m < 4; ++m)
#pragma unroll
                for (int n = 0; n < 2; ++n) acc[a][b][m][n] = (f32x4){0.f, 0.f, 0.f, 0.f};
    bf16x8 At[4][2], B0[2][2], B1[2][2];
    const char* cA = (const char*)g.A + (size_t)cur.pm * tstep; const char* cB = (const char*)g.Bt + (size_t)cur.pn * tstep;
#define PG8_ROT(u) (KROT ? ((4 * ((u).pn + 1)) & (nt - 1)) : 0)
    int kr = PG8_ROT(cur);
    S.a_ready(cur);
    if constexpr (SP2) {
        const char* pA = cA + (size_t)kr * kstep; const char* pB = cB + (size_t)kr * kstep;
        PG8_STAGE(PG8_SB(0, 0), pB, voffB); PG8_STAGE(PG8_SB(0, 1), pB + hstep, voffB); PG8_STAGE(PG8_SA(0, 0), pA, voffA); PG8_STAGE(PG8_SA(0, 1), pA + hstep, voffA);
        if (wr == 1) PG8_BAR;
        PG8_WAIT_V(2); PG8_BAR;
        PG8_STAGE(PG8_SB(1, 0), pB + kstep, voffB); PG8_STAGE(PG8_SA(1, 0), pA + kstep, voffA); PG8_STAGE(PG8_SB(1, 1), pB + hstep + kstep, voffB);
        PG8_WAIT_V(6); PG8_BAR;
    } else {
        PG8_STAGE(PG8_SB(0, 0), cB, voffB); PG8_STAGE(PG8_SA(0, 0), cA, voffA); PG8_STAGE(PG8_SB(0, 1), cB + hstep, voffB); PG8_STAGE(PG8_SA(0, 1), cA + hstep, voffA);
        if (wr == 1) PG8_BAR;
        PG8_WAIT_V(4); PG8_BAR;
        PG8_STAGE(PG8_SB(1, 0), cB + kstep, voffB); PG8_STAGE(PG8_SA(1, 0), cA + kstep, voffA); PG8_STAGE(PG8_SB(1, 1), cB + hstep + kstep, voffB);
        PG8_WAIT_V(6); PG8_BAR;
    }
    for (;;) {
        const bool has_next = S.next(PG8_UI(ui + 1), nxt);
        const bool firstpass = KDUP && !(ui & 1);
        const char* nA = has_next ? (const char*)g.A + (size_t)nxt.pm * tstep : cA; const char* nB = has_next ? (const char*)g.Bt + (size_t)nxt.pn * tstep : cB;
        const int nkr = has_next ? PG8_ROT(nxt) : kr;
        for (int t = 0; t < nt; t += 2) {
            const bool last = (t == nt - 2);
            const int k1 = KROT ? ((t + 1 + kr) & (nt - 1)) : t + 1, k2 = last ? nkr : (KROT ? ((t + 2 + kr) & (nt - 1)) : t + 2);
            const char* a1 = cA + (size_t)k1 * kstep;
            const char* a2 = (last ? nA : cA) + (size_t)k2 * kstep; const char* b2 = (last ? nB : cB) + (size_t)k2 * kstep;
            const char* a3 = a2 + kstep; const char* b3 = b2 + kstep;
            if (last && has_next) S.a_ready(nxt);
            if constexpr (SP2) {
            PG8_LDB(B0, 0, 0); PG8_LDB(B1, 0, 1); PG8_SCHED; PG8_LDA(At, 0, 0); PG8_STAGE(PG8_SA(1, 1), a1 + hstep, voffA);
            PG8_WAIT_V(8); PG8_WAIT_L(0); PG8_BAR; PG8_MMA(0, 0, At, B0); PG8_MMA(0, 1, At, B1); PG8_BAR; PG8_SCHED;
            PG8_LDA(At, 0, 1); PG8_STAGE(PG8_SB(0, 0), b2, voffB); PG8_STAGE(PG8_SB(0, 1), b2 + hstep, voffB); PG8_STAGE(PG8_SA(0, 0), a2, voffA);
            PG8_WAIT_V(8); PG8_WAIT_L(0); PG8_BAR; PG8_MMA(1, 0, At, B0); PG8_MMA(1, 1, At, B1); PG8_BAR; PG8_SCHED;
            PG8_LDB(B0, 1, 0); PG8_LDB(B1, 1, 1); PG8_SCHED; PG8_LDA(At, 1, 0); PG8_STAGE(PG8_SA(0, 1), a2 + hstep, voffA);
            PG8_WAIT_V(8); PG8_WAIT_L(0); PG8_BAR; PG8_MMA(0, 0, At, B0); PG8_MMA(0, 1, At, B1); PG8_BAR; PG8_SCHED;
            PG8_LDA(At, 1, 1); PG8_STAGE(PG8_SB(1, 0), b3, voffB); PG8_STAGE(PG8_SB(1, 1), b3 + hstep, voffB); PG8_STAGE(PG8_SA(1, 0), a3, voffA);
            PG8_WAIT_V(8); PG8_WAIT_L(0); PG8_BAR; PG8_MMA(1, 0, At, B0); PG8_MMA(1, 1, At, B1); PG8_BAR; PG8_SCHED;
            } else {
            PG8_LDB(B0, 0, 0); PG8_SCHED; PG8_LDA(At, 0, 0); PG8_STAGE(PG8_SA(1, 1), a1 + hstep, voffA);
            PG8_WAIT_L(8); PG8_BAR; PG8_WAIT_L(0); PG8_MMA(0, 0, At, B0); PG8_BAR; PG8_SCHED;
            PG8_LDB(B1, 0, 1); PG8_STAGE(PG8_SB(0, 0), b2, voffB);
            PG8_BAR; PG8_WAIT_L(0); PG8_MMA(0, 1, At, B1); PG8_BAR;
            PG8_LDA(At, 0, 1); PG8_STAGE(PG8_SA(0, 0), a2, voffA);
            PG8_BAR; PG8_WAIT_L(0); PG8_MMA(1, 0, At, B0); PG8_BAR; PG8_SCHED;
            PG8_STAGE(PG8_SB(0, 1), b2 + hstep, voffB);
            PG8_WAIT_V(6); PG8_BAR; PG8_MMA(1, 1, At, B1); PG8_BAR;
            PG8_LDB(B0, 1, 0); PG8_SCHED; PG8_LDA(At, 1, 0); PG8_STAGE(PG8_SA(0, 1), a2 + hstep, voffA);
            PG8_WAIT_L(8); PG8_BAR; PG8_WAIT_L(0); PG8_MMA(0, 0, At, B0); PG8_BAR; PG8_SCHED;
            PG8_LDB(B1, 1, 1); PG8_STAGE(PG8_SB(1, 0), b3, voffB);
            PG8_BAR; PG8_WAIT_L(0); PG8_MMA(0, 1, At, B1); PG8_BAR;
            PG8_LDA(At, 1, 1); PG8_STAGE(PG8_SA(1, 0), a3, voffA);
            PG8_BAR; PG8_WAIT_L(0); PG8_MMA(1, 0, At, B0); PG8_BAR; PG8_SCHED;
            PG8_STAGE(PG8_SB(1, 1), b3 + hstep, voffB);
            PG8_WAIT_V(6); PG8_BAR; PG8_MMA(1, 1, At, B1); PG8_BAR;
            }
        }
        if constexpr (ALIGN_EPI) { if (wr == 0) PG8_BAR; }
        if (KDUP && !firstpass) {
#pragma unroll
            for (int a = 0; a < 2; ++a)
#pragma unroll
                for (int b = 0; b < 2; ++b)
#pragma unroll
                    for (int m = 0; m < 4; ++m)
#pragma unroll
                        for (int n = 0; n < 2; ++n) acc[a][b][m][n] = acc[a][b][m][n] * 0.5f; }
        if constexpr (!Epi::AFTER_DRAIN) if (!firstpass) { int t2 = tid_now(wv); asm volatile("" : "+v"(t2));
            E(acc, cur, wr, wc, t2 & 15, (t2 & 63) >> 4); if (EDUP) { asm volatile("" : "+v"(t2)); E(acc, cur, wr, wc, t2 & 15, (t2 & 63) >> 4); } S.done(cur); }
        if (!has_next) break;
        if (!firstpass)
#pragma unroll
        for (int a = 0; a < 2; ++a)
#pragma unroll
            for (int b = 0; b < 2; ++b)
#pragma unroll
                for (int m = 0; m < 4; ++m)
#pragma unroll
                    for (int n = 0; n < 2; ++n) acc[a][b][m][n] = (f32x4){0.f, 0.f, 0.f, 0.f};
        cur = nxt; cA = nA; cB = nB; kr = nkr; ++ui;
        if constexpr (ALIGN_EPI) { if (wr == 1) PG8_BAR; }
    }
    PG8_WAIT_V(0);
    if constexpr (!ALIGN_EPI) { if (wr == 0) PG8_BAR; }
    PG8_BAR;
    if constexpr (Epi::AFTER_DRAIN) { E.fused(acc, cur, wr, wc, fr, fq, lds, wid, lane); S.done(cur); }
#undef PG8_ROT
#undef PG8_SA
#undef PG8_SB
#undef PG8_STAGE
#undef PG8_LDA
#undef PG8_LDB
#undef PG8_MMA
#undef PG8_WAIT_V
#undef PG8_WAIT_L
#undef PG8_BAR
#undef PG8_SCHED
}
}

#ifndef PG8_SP2
#define PG8_SP2 true
#endif
#ifndef PG8_ALIGN
#define PG8_ALIGN true
#endif
#include <hip/hip_bf16.h>
#include <cmath>
namespace attn_body {
using bf16=__hip_bfloat16;
using bf16x8=__attribute__((ext_vector_type(8)))short;
using s16x4=__attribute__((ext_vector_type(4)))short;
using f32x16=__attribute__((ext_vector_type(16)))float;
using u32x4=__attribute__((ext_vector_type(4)))unsigned;
constexpr int BATCH=8,NHEAD=16,SEQ=8192,D=64,DM=NHEAD*D;
constexpr int NW=8,QBLK=32,QB=QBLK*NW,KVBLK=64,NQB=SEQ/QB;
constexpr int ATTN_PITCH=DM, ATTN_UNIT_ROWS=QB;
__device__ __forceinline__ int crow(int r,int hi){return (r&3)+8*(r>>2)+4*hi;}
#define SBAR() __builtin_amdgcn_sched_barrier(0)
__device__ __forceinline__ void cmask(f32x16&p0,f32x16&p1,int jb,int qrel,int hi){
  const float NEG=-INFINITY; int kb=64*jb+4*hi;
  #pragma unroll
  for(int r=0;r<16;++r){int kv=kb+(r&3)+8*(r>>2); if(kv>qrel)p0[r]=NEG; if(kv+32>qrel)p1[r]=NEG;}
}

constexpr int NSLOT=3, SLOTB=8192;
constexpr int LDS_K=0, LDS_V=NSLOT*SLOTB, LDS_WS=2*NSLOT*SLOTB, LDS_OST=LDS_WS+NW*64*4, LDS_T0=84992, LDS_CB=86016, LDS_BYTES=LDS_CB+SEQ*4;
constexpr float C2=0.125f*1.4426950408889634f;
__device__ __forceinline__ void glds16(const void*gsrc,unsigned lds_dst){unsigned keep;
  asm volatile("s_mov_b32 %0, m0\n\ts_mov_b32 m0, %2\n\ts_nop 0\n\tglobal_load_lds_dwordx4 %1, off\n\ts_mov_b32 m0, %0":"=&s"(keep):"v"(gsrc),"s"(lds_dst):"memory");}
__device__ __forceinline__ float max3f(float a,float b,float c){float r;asm("v_max3_f32 %0, %1, %2, %3":"=v"(r):"v"(a),"v"(b),"v"(c));return r;}
__device__ __forceinline__ float max2f(float a,float b){float r;asm("v_max_f32_e32 %0, %1, %2":"=v"(r):"v"(a),"v"(b));return r;}
__device__ __forceinline__ float fadd_s(float a,float b){float r;asm("v_add_f32_e32 %0, %1, %2":"=v"(r):"v"(a),"v"(b));return r;}
__device__ __forceinline__ float fsub_s(float a,float b){float r;asm("v_sub_f32_e32 %0, %1, %2":"=v"(r):"v"(a),"v"(b));return r;}
typedef float f32x2_t __attribute__((ext_vector_type(2))); typedef __bf16 bf16x2_t __attribute__((ext_vector_type(2)));
__device__ __forceinline__ unsigned cvtpk_s(float lo,float hi){f32x2_t v={lo,hi};bf16x2_t b=__builtin_convertvector(v,bf16x2_t);return __builtin_bit_cast(unsigned,b);}
#define WAIT_BAR(N) asm volatile("s_waitcnt vmcnt(" #N ") lgkmcnt(0)\n\ts_barrier":::"memory")

__device__ __forceinline__ void qkt(f32x16&p0,f32x16&p1,const char*Kslot,const bf16x8*qr,const f32x16&c0in,const f32x16&c1in,int r32,int hi){
  const char*kb=Kslot+hi*1024+r32*16;
  #pragma unroll
  for(int d0=0;d0<4;++d0){
    const bf16x8 b0=*reinterpret_cast<const bf16x8*>(kb+d0*2048);
    const bf16x8 b1=*reinterpret_cast<const bf16x8*>(kb+d0*2048+512);
    if(d0==0){p0=__builtin_amdgcn_mfma_f32_32x32x16_bf16(b0,qr[0],c0in,0,0,0);p1=__builtin_amdgcn_mfma_f32_32x32x16_bf16(b1,qr[0],c1in,0,0,0);}
    else{p0=__builtin_amdgcn_mfma_f32_32x32x16_bf16(b0,qr[d0],p0,0,0,0);p1=__builtin_amdgcn_mfma_f32_32x32x16_bf16(b1,qr[d0],p1,0,0,0);}}
}
typedef __attribute__((address_space(3))) const char* lds_cptr;
typedef short v4i16_t __attribute__((ext_vector_type(4)));
__device__ __forceinline__ void kload8(bf16x8*kf,lds_cptr kp){
  kf[0]=*(const __attribute__((address_space(3))) bf16x8*)(kp);      kf[1]=*(const __attribute__((address_space(3))) bf16x8*)(kp+512);
  kf[2]=*(const __attribute__((address_space(3))) bf16x8*)(kp+2048); kf[3]=*(const __attribute__((address_space(3))) bf16x8*)(kp+2560);
  kf[4]=*(const __attribute__((address_space(3))) bf16x8*)(kp+4096); kf[5]=*(const __attribute__((address_space(3))) bf16x8*)(kp+4608);
  kf[6]=*(const __attribute__((address_space(3))) bf16x8*)(kp+6144); kf[7]=*(const __attribute__((address_space(3))) bf16x8*)(kp+6656);
}
__device__ __forceinline__ void kload2(bf16x8*kf,lds_cptr kp,int j){ kf[2*j]=*(const __attribute__((address_space(3))) bf16x8*)(kp+j*2048); kf[2*j+1]=*(const __attribute__((address_space(3))) bf16x8*)(kp+j*2048+512); }
__device__ __forceinline__ s16x4 vtr(lds_cptr p){ return __builtin_bit_cast(s16x4,__builtin_amdgcn_ds_read_tr16_b64_v4i16((__attribute__((address_space(3))) v4i16_t*)p)); }
__device__ __forceinline__ float rowmax(const f32x16&p0,const f32x16&p1){
  float a=max3f(p0[0],p0[1],p1[0]),b=max3f(p0[2],p0[3],p1[1]);a=max3f(a,p1[2],p1[3]);
  #pragma unroll
  for(int r=4;r<16;r+=4){a=max3f(a,p0[r],p0[r+1]);b=max3f(b,p0[r+2],p0[r+3]);a=max3f(a,p1[r],p1[r+1]);b=max3f(b,p1[r+2],p1[r+3]);}
  const float m=max2f(a,b);
  auto rr=__builtin_amdgcn_permlane32_swap(__float_as_uint(m),__float_as_uint(m),false,false);
  return max2f(__uint_as_float(rr[0]),__uint_as_float(rr[1]));
}
__device__ __forceinline__ void pv(f32x16*o,int vb,bf16x8 pa0,bf16x8 pa1,bf16x8 pa2,bf16x8 pa3){
  #pragma unroll
  for(int d0=0;d0<2;++d0){s16x4 lo[4],hi[4];
    #pragma unroll
    for(int ks=0;ks<4;++ks){
      asm volatile("ds_read_b64_tr_b16 %0,%1 offset:%c2":"=&v"(lo[ks]):"v"(vb),"i"(d0*4096+ks*1024):"memory");
      asm volatile("ds_read_b64_tr_b16 %0,%1 offset:%c2":"=&v"(hi[ks]):"v"(vb),"i"(d0*4096+ks*1024+512):"memory");}
    asm volatile("s_waitcnt lgkmcnt(0)":::"memory");SBAR();
    #define PK(k) (bf16x8){lo[k][0],lo[k][1],lo[k][2],lo[k][3],hi[k][0],hi[k][1],hi[k][2],hi[k][3]}
    o[d0]=__builtin_amdgcn_mfma_f32_32x32x16_bf16(pa0,PK(0),o[d0],0,0,0);
    o[d0]=__builtin_amdgcn_mfma_f32_32x32x16_bf16(pa1,PK(1),o[d0],0,0,0);
    o[d0]=__builtin_amdgcn_mfma_f32_32x32x16_bf16(pa2,PK(2),o[d0],0,0,0);
    o[d0]=__builtin_amdgcn_mfma_f32_32x32x16_bf16(pa3,PK(3),o[d0],0,0,0);
    #undef PK
  }
}

#ifndef ATTN_STORE16
#define ATTN_STORE16(p,v) (*(u32x4*)(p)=(v))
#endif
__device__ __forceinline__ bf16x8 mkkx(float x,int hi){
  const unsigned b0=cvtpk_s(x,0.f)&0xffffu; const float r1=x-__uint_as_float(b0<<16);
  const unsigned b1=cvtpk_s(r1,0.f)&0xffffu; const float r2=r1-__uint_as_float(b1<<16);
  const unsigned b2=cvtpk_s(r2,0.f)&0xffffu;
  u32x4 w; w.x=hi?0u:(b0|(b1<<16)); w.y=hi?0u:(b2|0x3F800000u); w.z=hi?0u:0x3F803F80u; w.w=0u; return __builtin_bit_cast(bf16x8,w);
}
template<int THRL> __device__ __forceinline__ void attn_unit(int b,int h,int qb,int t0,const bf16*Q,const bf16*__restrict__ K,const bf16*__restrict__ V,bf16*O,const float*cbg,char*shm,const int wv){
  int tid=tid_now(wv); asm volatile("":"+v"(tid));
  const int lane=tid&63,r32=lane&31,hi=lane>>5; const int wid=__builtin_amdgcn_readfirstlane(tid>>6);
  const long rowbase=(long)b*SEQ; const int q0=qb*QB;
  const bf16*Qw=Q+(rowbase+q0+wid*QBLK)*DM+h*D;
  const bf16*Kh=K+(rowbase+(long)t0*KVBLK)*DM+h*D,*Vh=V+(rowbase+(long)t0*KVBLK)*DM+h*D;
  const unsigned lds0=(unsigned)(uintptr_t)shm;
  float*wsf=(float*)(shm+LDS_WS)+wid*64;
  const bf16*ksrc=Kh+(long)lane*DM+wid*8;
  const bf16*vsrc=Vh+(long)(16*(wid&3)+(lane>>2))*DM+(wid>>2)*32+(lane&3)*8;
  const unsigned kdst=lds0+LDS_K+wid*1024, vdst=lds0+LDS_V+wid*1024;
  #define DMA_K(t,slot) glds16(ksrc+(long)(t)*KVBLK*DM,(unsigned)__builtin_amdgcn_readfirstlane(kdst+(slot)))
  #define DMA_V(t,slot) glds16(vsrc+(long)(t)*KVBLK*DM,(unsigned)__builtin_amdgcn_readfirstlane(vdst+(slot)))
  const int vb0=(int)(lds0+LDS_V)+((lane>>4)&1)*32+(lane&3)*8+(4*hi+((lane&15)>>2))*64;
  const char*Kbase=shm+LDS_K; bf16x8 kf[8];
  const lds_cptr shm3=(lds_cptr)shm; const lds_cptr kp0=shm3+LDS_K+hi*1024+r32*16; const lds_cptr vp0=shm3+LDS_V+((lane>>4)&1)*32+(lane&3)*8+(4*hi+((lane&15)>>2))*64;
  const int NT=(q0+QB)/KVBLK-t0;
  const float*cbl=(const float*)(shm+LDS_CB);
  DMA_K(0,0);DMA_V(0,0);DMA_K(1,SLOTB);
  { const float*cg=cbg+t0*KVBLK; float*cl=(float*)(shm+LDS_CB); const int n=NT*KVBLK;
    for(int i=tid;i<n;i+=NW*64)cl[i]=cg[i]; }
  bf16x8 qr[4];
  #pragma unroll
  for(int d0=0;d0<4;++d0)qr[d0]=*reinterpret_cast<const bf16x8*>(&Qw[(long)r32*DM+d0*16+hi*8]);
  float mhat=0.f,l_reg=0.f;f32x16 o[2];o[0]=f32x16{};o[1]=f32x16{};const f32x16 z16=f32x16{};
  const int qrel=wid*QBLK+r32;
  #define CMASK(P0,P1,t) do{int jb_=(t)-(NT-4); if(jb_>=0)cmask(P0,P1,jb_,qrel,hi);}while(0)
  bool resc=false;
  bf16x8 qx;
  #define MKQX() do{ const float nm_=-mhat; const unsigned a0_=cvtpk_s(nm_,0.f)&0xffffu; const float q1_=nm_-__uint_as_float(a0_<<16); const unsigned a1_=cvtpk_s(q1_,0.f)&0xffffu; \
    const float q2_=q1_-__uint_as_float(a1_<<16); const unsigned a2_=cvtpk_s(q2_,0.f)&0xffffu; u32x4 w_; w_.x=hi?0u:0x3F803F80u; w_.y=hi?0u:(0x3F80u|(a0_<<16)); w_.z=hi?0u:(a1_|(a2_<<16)); w_.w=0u; qx=__builtin_bit_cast(bf16x8,w_); }while(0)
  MKQX();
  #define START(P0,P1) do{ const float rm=rowmax(P0,P1); resc=false; \
    { const float dl=rm; mhat=fadd_s(mhat,dl); \
      _Pragma("unroll") for(int r=0;r<16;++r){P0[r]=fsub_s(P0[r],dl);P1[r]=fsub_s(P1[r],dl);} \
      MKQX(); } \
    _Pragma("unroll") for(int r=0;r<16;++r)P0[r]=__builtin_amdgcn_exp2f(P0[r]); }while(0)
  #define RESC() do{ if(resc){ asm volatile("s_waitcnt lgkmcnt(0)":::"memory"); \
      _Pragma("unroll") for(int d_=0;d_<2;++d_) _Pragma("unroll") for(int r=0;r<16;++r)o[d_][r]*=wsf[crow(r,hi)]; } }while(0)
  f32x16 pA0,pA1,pB0,pB1;
  int sl_prev=0,sl_cur=0,sl_next=SLOTB;
  #define ROT() do{sl_prev=sl_cur;sl_cur=sl_next;sl_next=(sl_next==(NSLOT-1)*SLOTB)?0:sl_next+SLOTB;}while(0)
  DMA_K(2,2*SLOTB);
  WAIT_BAR(3);
  const float cref=cbl[q0-t0*KVBLK+wid*QBLK];
  #define KXB(X0,X1,t) do{ X0=mkkx(cref-cbl[(t)*KVBLK+r32],hi); X1=mkkx(cref-cbl[(t)*KVBLK+32+r32],hi); }while(0)
  bf16x8 kx0,kx1; KXB(kx0,kx1,0);
  { const f32x16 i0=__builtin_amdgcn_mfma_f32_32x32x16_bf16(kx0,qx,z16,0,0,0), i1=__builtin_amdgcn_mfma_f32_32x32x16_bf16(kx1,qx,z16,0,0,0);
    qkt(pA0,pA1,Kbase,qr,i0,i1,r32,hi); }
  asm volatile("s_nop 15\n\ts_nop 7":"+v"(pA0),"+v"(pA1));CMASK(pA0,pA1,0);
  START(pA0,pA1);
  _Pragma("unroll") for(int r=0;r<16;++r)pA1[r]=__builtin_amdgcn_exp2f(pA1[r]);
  WAIT_BAR(0);
  DMA_K(3,0);DMA_V(1,SLOTB);
  ROT();
  kload8(kf,kp0+sl_cur);
  WAIT_BAR(2);
  s16x4 vlo[8],vhi[8]; u32x4 pw0,pw1,pw2,pw3;
  #define PKW(P,B) cvtpk_s(P[B],P[B+1])
  #define PAF(k) __builtin_bit_cast(bf16x8,pw##k)
  #define VFR(i) (bf16x8){vlo[i][0],vlo[i][1],vlo[i][2],vlo[i][3],vhi[i][0],vhi[i][1],vhi[i][2],vhi[i][3]}
  #define PIN(x) asm volatile("":"+v"(x))
  #define MX3(a,b,c) __builtin_fmaxf(__builtin_fmaxf((a),(b)),(c))
  #define GAPA(MF,A0,A1,A2,A3,W0,W1,PW) do{ MF; sacc+=A0; sacc+=A1; sacc+=A2; sacc+=A3; PIN(sacc); W0; W1; PIN(PW); SBAR(); }while(0)
  #define EX(v) __builtin_amdgcn_exp2f(v)
  #define GAPB(MF,X,B) do{ MF; X[B]=EX(X[B]); X[B+1]=EX(X[B+1]); X[B+2]=EX(X[B+2]); X[B+3]=EX(X[B+3]); PIN(X); SBAR(); }while(0)
  #define VRD(i) do{ vlo[i]=vtr(vp_+(((i)>>2)*4096+((i)&3)*1024)); vhi[i]=vtr(vp_+(((i)>>2)*4096+((i)&3)*1024+512)); }while(0)
  #define KRD(G,j) do{ if(G){ kload2(kf,kp0+sl_next,j); SBAR(); } }while(0)
  #define STEP(C0,C1,P0,P1,t,GK,GV,GL) do{ KXB(kx0,kx1,t); SBAR(); \
    C0=__builtin_amdgcn_mfma_f32_32x32x16_bf16(kx0,qx,z16,0,0,0); C1=__builtin_amdgcn_mfma_f32_32x32x16_bf16(kx1,qx,z16,0,0,0); SBAR(); \
    const lds_cptr vp_=vp0+sl_prev; \
    VRD(0); SBAR(); float sacc=(P0[0]+P0[1]); \
    GAPA(C0=__builtin_amdgcn_mfma_f32_32x32x16_bf16(kf[0],qr[0],C0,0,0,0), P0[2],P0[3],P0[4],P0[5],     pw0[0]=PKW(P0,0), pw0[1]=PKW(P0,2), pw0); \
    VRD(4); SBAR(); GAPA(C1=__builtin_amdgcn_mfma_f32_32x32x16_bf16(kf[1],qr[0],C1,0,0,0), P0[6],P0[7],P0[8],P0[9],     pw0[2]=PKW(P0,4), pw0[3]=PKW(P0,6), pw0); \
    VRD(1); SBAR(); GAPA(C0=__builtin_amdgcn_mfma_f32_32x32x16_bf16(kf[2],qr[1],C0,0,0,0),   P0[10],P0[11],P0[12],P0[13], pw1[0]=PKW(P0,8), pw1[1]=PKW(P0,10), pw1); \
    VRD(5); SBAR(); GAPA(C1=__builtin_amdgcn_mfma_f32_32x32x16_bf16(kf[3],qr[1],C1,0,0,0),   P0[14],P0[15],P1[0],P1[1],   pw1[2]=PKW(P0,12),pw1[3]=PKW(P0,14), pw1); \
    VRD(2); SBAR(); GAPA(C0=__builtin_amdgcn_mfma_f32_32x32x16_bf16(kf[4],qr[2],C0,0,0,0),   P1[2],P1[3],P1[4],P1[5],     pw2[0]=PKW(P1,0), pw2[1]=PKW(P1,2), pw2); \
    VRD(6); SBAR(); GAPA(C1=__builtin_amdgcn_mfma_f32_32x32x16_bf16(kf[5],qr[2],C1,0,0,0),   P1[6],P1[7],P1[8],P1[9],     pw2[2]=PKW(P1,4), pw2[3]=PKW(P1,6), pw2); \
    VRD(3); SBAR(); GAPA(C0=__builtin_amdgcn_mfma_f32_32x32x16_bf16(kf[6],qr[3],C0,0,0,0),   P1[10],P1[11],P1[12],P1[13], pw3[0]=PKW(P1,8), pw3[1]=PKW(P1,10), pw3); \
    VRD(7); SBAR(); GAPA(C1=__builtin_amdgcn_mfma_f32_32x32x16_bf16(kf[7],qr[3],C1,0,0,0),   P1[14],P1[15],0.f,0.f,       pw3[2]=PKW(P1,12),pw3[3]=PKW(P1,14), pw3); \
    l_reg+=sacc; \
    if(GK){DMA_K((t)+3,sl_cur);} if(GV){DMA_V((t)+1,sl_next);} \
    CMASK(C0,C1,t); \
    { float a=MX3(C0[0],C0[1],C1[0]),b=MX3(C0[2],C0[3],C1[1]); a=MX3(a,C1[2],C1[3]); \
      _Pragma("unroll") for(int r=4;r<16;r+=4){a=MX3(a,C0[r],C0[r+1]);b=MX3(b,C0[r+2],C0[r+3]);a=MX3(a,C1[r],C1[r+1]);b=MX3(b,C1[r+2],C1[r+3]);} \
      float rm=__builtin_fmaxf(a,b); { auto rr=__builtin_amdgcn_permlane32_swap(__float_as_uint(rm),__float_as_uint(rm),false,false); rm=__builtin_fmaxf(__uint_as_float(rr[0]),__uint_as_float(rr[1])); } \
      resc=false; \
      if(__builtin_expect(__any(rm>(float)THRL),0)){ const float dl=__builtin_fmaxf(rm,0.f); mhat+=dl; \
        _Pragma("unroll") for(int r=0;r<16;++r){C0[r]-=dl;C1[r]-=dl;} \
        MKQX(); \
        const float f=__builtin_amdgcn_exp2f(-dl); l_reg*=f; if(hi==0)wsf[r32]=f; resc=true; } } \
    SBAR(); \
    GAPB(o[0]=__builtin_amdgcn_mfma_f32_32x32x16_bf16(PAF(0),VFR(0),o[0],0,0,0), C0,0); \
    GAPB(o[1]=__builtin_amdgcn_mfma_f32_32x32x16_bf16(PAF(0),VFR(4),o[1],0,0,0), C0,4); \
    KRD(GL,0); GAPB(o[0]=__builtin_amdgcn_mfma_f32_32x32x16_bf16(PAF(1),VFR(1),o[0],0,0,0), C0,8); \
    KRD(GL,1); GAPB(o[1]=__builtin_amdgcn_mfma_f32_32x32x16_bf16(PAF(1),VFR(5),o[1],0,0,0), C0,12); \
    KRD(GL,2); GAPB(o[0]=__builtin_amdgcn_mfma_f32_32x32x16_bf16(PAF(2),VFR(2),o[0],0,0,0), C1,0); \
    KRD(GL,3); GAPB(o[1]=__builtin_amdgcn_mfma_f32_32x32x16_bf16(PAF(2),VFR(6),o[1],0,0,0), C1,4); \
    GAPB(o[0]=__builtin_amdgcn_mfma_f32_32x32x16_bf16(PAF(3),VFR(3),o[0],0,0,0), C1,8); \
    GAPB(o[1]=__builtin_amdgcn_mfma_f32_32x32x16_bf16(PAF(3),VFR(7),o[1],0,0,0), C1,12); \
    }while(0)
  int t=1;
  #undef CMASK
  #define CMASK(P0,P1,t) do{}while(0)
  for(;t+5<NT;t+=2){
    STEP(pB0,pB1,pA0,pA1,t,true,true,true);     WAIT_BAR(2); RESC(); ROT();
    STEP(pA0,pA1,pB0,pB1,t+1,true,true,true);   WAIT_BAR(2); RESC(); ROT();
  }
  #undef CMASK
  #define CMASK(P0,P1,t) do{int jb_=(t)-(NT-4); if(jb_>=0)cmask(P0,P1,jb_,qrel,hi);}while(0)
  #define ENDW(tt) do{ if((tt)+3<NT){WAIT_BAR(2);} else if((tt)+2<NT){WAIT_BAR(1);} else {WAIT_BAR(0);} }while(0)
  for(;t+1<NT;t+=2){
    STEP(pB0,pB1,pA0,pA1,t,(t+3<NT),(t+1<NT),(t+1<NT));       ENDW(t);   RESC(); ROT();
    STEP(pA0,pA1,pB0,pB1,t+1,(t+4<NT),(t+2<NT),(t+2<NT));     ENDW(t+1); RESC(); ROT();
  }
  STEP(pB0,pB1,pA0,pA1,NT-1,false,false,false); RESC();
  { float sacc=pB0[0]+pB0[1]; _Pragma("unroll") for(int r=2;r<16;++r)sacc+=pB0[r]; _Pragma("unroll") for(int r=0;r<16;++r)sacc+=pB1[r]; l_reg+=sacc;
    pw0=(u32x4){PKW(pB0,0),PKW(pB0,2),PKW(pB0,4),PKW(pB0,6)};pw1=(u32x4){PKW(pB0,8),PKW(pB0,10),PKW(pB0,12),PKW(pB0,14)};pw2=(u32x4){PKW(pB1,0),PKW(pB1,2),PKW(pB1,4),PKW(pB1,6)};pw3=(u32x4){PKW(pB1,8),PKW(pB1,10),PKW(pB1,12),PKW(pB1,14)};
    SBAR(); pv(o,vb0+sl_cur,PAF(0),PAF(1),PAF(2),PAF(3)); }
  #undef PKW
  #undef PAF
  #undef VFR
  #undef PIN
  #undef MX3
  #undef GAPA
  #undef GAPB
  #undef EX
  #undef VRD
  #undef KRD
  #undef STEP
  #undef ENDW
  #undef KXB
  #undef MKQX
  {auto rr=__builtin_amdgcn_permlane32_swap(__float_as_uint(l_reg),__float_as_uint(l_reg),false,false);l_reg=__uint_as_float(rr[0])+__uint_as_float(rr[1]);}
  if(hi==0)wsf[32+r32]=l_reg;asm volatile("s_waitcnt lgkmcnt(0)":::"memory");
  float rli[16];
  #pragma unroll
  for(int r=0;r<16;++r)rli[r]=__builtin_amdgcn_rcpf(wsf[32+crow(r,hi)]);
  bf16*Ow=O+(rowbase+q0+wid*QBLK)*DM+h*D;
  { bf16*stg=(bf16*)(shm+LDS_OST)+wid*2048;
    #pragma unroll
    for(int r=0;r<16;++r){const int orow=crow(r,hi);
      #pragma unroll
      for(int d0=0;d0<2;++d0)stg[orow*64+d0*32+r32]=__float2bfloat16(o[d0][r]*rli[r]);}
    asm volatile("s_waitcnt lgkmcnt(0)":::"memory");
    #pragma unroll
    for(int i=0;i<4;++i){const int row=i*8+(lane>>3),ch=lane&7; const u32x4 v=*(const u32x4*)(stg+row*64+ch*8); ATTN_STORE16(Ow+(long)row*DM+ch*8,v);} }
  asm volatile("s_waitcnt lgkmcnt(0)\n\ts_barrier":::"memory");
  #undef DMA_K
  #undef DMA_V
  #undef CMASK
  #undef START
  #undef RESC
  #undef ROT
}
constexpr int ATTN_LDS_BYTES=LDS_BYTES;
struct AttnTensors { const bf16* Q; const bf16* K; const bf16* V; bf16* O; };
struct AttnUnit { int bh; int qb; int t0; };
struct StaticOrder {
  int vcu;
  __device__ __forceinline__ explicit StaticOrder(int grid,int block):vcu((block%8)*(grid/8)+block/8){}
  __device__ __forceinline__ bool next(int i,AttnUnit&u)const{ if(i>=8)return false; const int s=vcu&7,k=i&3; u.bh=2*(vcu>>3)+(i>>2); u.qb=(k==0)?s:(k==1)?15-s:(k==2)?16+s:31-s; u.t0=0; return true; }
};
constexpr float PRUNE_MARGIN=40.f;
template<class Sched,int THRL=32> __device__ __forceinline__ void attn_phase(char*lds,const AttnTensors&T,const float*cb,const float*qk,const Sched&S,const int wv){
  { int tid=tid_now(wv); asm volatile("":"+v"(tid)); const int lane=tid&63,wid=__builtin_amdgcn_readfirstlane(tid>>6);
    AttnUnit u; S.next(wid,u);
    const float thr=2.02f*qk[2*u.bh]*qk[2*u.bh+1]+PRUNE_MARGIN; const float*c=cb+(size_t)u.bh*SEQ; const float cq=c[u.qb*QB];
    const bool p0=(c[64*lane+63]-cq>=thr), p1=(c[64*(lane+64)+63]-cq>=thr);
    int cnt=__builtin_popcountll(__ballot(p0))+__builtin_popcountll(__ballot(p1)); cnt&=~1; if(cnt>4*u.qb)cnt=4*u.qb;
    if(lane==0)((int*)(lds+LDS_T0))[wid]=cnt;
    __syncthreads(); }
  AttnUnit u;
  for(int i=0;S.next(i,u);++i){ const int t0=__builtin_amdgcn_readfirstlane(((const int*)(lds+LDS_T0))[i]); attn_unit<THRL>(u.bh>>3,u.bh&7,u.qb,t0,T.Q,T.K,T.V,T.O,cb+(size_t)u.bh*SEQ,lds,wv); }
}
#undef SBAR
#undef WAIT_BAR
}
#define GAS __attribute__((address_space(1)))
#define LAS __attribute__((address_space(3)))
typedef unsigned short bf16;
typedef unsigned v4u __attribute__((ext_vector_type(4)));
typedef float f32x4 __attribute__((ext_vector_type(4)));
typedef short bf16x8 __attribute__((ext_vector_type(8)));
typedef GAS unsigned gu32;
typedef GAS unsigned long long gu64;
#define RLX_AGENT __ATOMIC_RELAXED, __HIP_MEMORY_SCOPE_AGENT
#define LDS_WAIT() asm volatile("s_waitcnt lgkmcnt(0)" ::: "memory")
#define VM_WAIT() asm volatile("s_waitcnt vmcnt(0)" ::: "memory")
__device__ __forceinline__ unsigned long long rt() { return __builtin_amdgcn_s_memrealtime(); }
__device__ __forceinline__ unsigned f2bf(float f) { unsigned u = __builtin_bit_cast(unsigned, f); return (u + 0x7fffu + ((u >> 16) & 1u)) >> 16; }
__device__ __forceinline__ unsigned pk2(float lo, float hi) { return f2bf(lo) | (f2bf(hi) << 16); }

#define XB_TMO      128
#define XB_XCNT(j)  (256  + 64 * (j))
#define XB_XSUB(j)  (1280 + 64 * (j))
#define XB_XGEN(j)  (2304 + 64 * (j))
#define XB_TOP      3328
#define XB_TOPGEN   3392
#define XCD_BAR_WORDS 3456
#define XB_SPIN_CAP (1u << 18)

__device__ __forceinline__ unsigned xb_ld(unsigned* p)              { return __hip_atomic_load(p, __ATOMIC_RELAXED, __HIP_MEMORY_SCOPE_AGENT); }
__device__ __forceinline__ unsigned xb_add(unsigned* p, unsigned v) { return __hip_atomic_fetch_add(p, v, __ATOMIC_RELAXED, __HIP_MEMORY_SCOPE_AGENT); }
__device__ __forceinline__ unsigned xb_xcc_id() { return (unsigned)__builtin_amdgcn_s_getreg((3 << 11) | 20) & 0xFu; }
#define XB_SPIN(cond, bar) do { unsigned _sp = 0; while (cond) { __builtin_amdgcn_s_sleep(1); \
    if ((++_sp & 255u) == 0u) { if (xb_ld(&(bar)[XB_TMO])) break; if (_sp > XB_SPIN_CAP) { atomicAdd(&(bar)[XB_TMO], 1u); break; } } } } while (0)

struct XcdBarrier {
    unsigned* bar; unsigned x;
    volatile LAS unsigned* st;
};

__device__ __forceinline__ XcdBarrier xcd_barrier_post(unsigned* bar, volatile LAS unsigned* st) {
    XcdBarrier b; b.bar = bar; b.x = xb_xcc_id(); b.st = st;
    if (threadIdx.x == 0) { st[4] = xb_add(&bar[XB_XCNT(b.x)], 1u); st[3] = blockIdx.x; }
    return b;
}
__device__ __forceinline__ void xcd_barrier_complete(unsigned* bar, unsigned x, unsigned& nloc, unsigned& nx, unsigned& reg) {
    const unsigned G = gridDim.x * gridDim.y * gridDim.z;
    unsigned sum, cnt, mine, bad, sp = 0u;
    for (;;) {
        sum = 0u; cnt = 0u; bad = 0u;
#pragma unroll
        for (unsigned j = 0; j < 16; ++j) { const unsigned c = xb_ld(&bar[XB_XCNT(j)]); sum += c; cnt += (c > 0u) ? 1u : 0u; bad |= (j < 8u) ? (c ^ 32u) : c; }
        if (sum == G) break;
        __builtin_amdgcn_s_sleep(1);
        if ((++sp & 255u) == 0u) { if (xb_ld(&bar[XB_TMO])) { bad = 1u; break; } if (sp > XB_SPIN_CAP) { atomicAdd(&bar[XB_TMO], 1u); bad = 1u; break; } }
    }
#ifdef PROBE_FORCE_IRREGULAR
    bad = 1u;
#endif
    reg = (bad == 0u && G == 256u) ? 1u : 0u;
    mine = xb_ld(&bar[XB_XCNT(x)]);
    nloc = mine > 0u ? mine : 1u; nx = cnt > 0u ? cnt : 1u;
}

__device__ __forceinline__ void xcd_barrier(const XcdBarrier& b, const bool glob, const int wv  ) {
    asm volatile("s_waitcnt vmcnt(0)" ::: "memory");
    __syncthreads();
    if (tid_now(wv) == 0) {
        GAS unsigned* barg_ = (GAS unsigned*)b.bar; unsigned xq_ = b.x; asm volatile("" : "+s"(barg_), "+s"(xq_));
        unsigned* bar = (unsigned*)barg_;
        __builtin_amdgcn_s_waitcnt(0);
        unsigned nloc = b.st[0], nx = b.st[1];
        if (nloc == 0u) { unsigned reg; xcd_barrier_complete(bar, xq_, nloc, nx, reg); b.st[0] = nloc; b.st[1] = nx; b.st[2] = reg; if (reg) b.st[3] = b.st[4] * 8u + xq_; }
        const bool loc = !glob && b.st[2] != 0u;
        const unsigned old = xb_add(&bar[XB_XSUB(xq_)], 1u);
        const unsigned gen = old / nloc;
        if (old + 1u == (gen + 1u) * nloc) {
            if (!loc) {
            __builtin_amdgcn_fence(__ATOMIC_RELEASE, "agent");
            asm volatile("s_waitcnt vmcnt(0)" ::: "memory");
            const unsigned og = xb_add(&bar[XB_TOP], 1u);
            const unsigned tg = og / nx;
            if (og + 1u == (tg + 1u) * nx) xb_add(&bar[XB_TOPGEN], 1u);
            else XB_SPIN(xb_ld(&bar[XB_TOPGEN]) == tg, bar);
            }
            __builtin_amdgcn_fence(__ATOMIC_ACQUIRE, "agent");
            xb_add(&bar[XB_XGEN(xq_)], 1u);
            asm volatile("s_waitcnt vmcnt(0)" ::: "memory");
        } else {
            XB_SPIN(xb_ld(&bar[XB_XGEN(xq_)]) == gen, bar);
            __builtin_amdgcn_fence(__ATOMIC_ACQUIRE, "agent");
            asm volatile("s_waitcnt vmcnt(0)" ::: "memory");
        }
    }
    __syncthreads();
}

constexpr int NWAVES = 8;
#ifndef PROBE_DUP
#define PROBE_DUP 0
#endif
#define NREP(k) ((PROBE_DUP == (k)) ? 2 : 1)
#ifndef PROBE_RG
#define PROBE_RG 0
#endif
#ifndef PROBE_EDUP
#define PROBE_EDUP 0
#endif
#ifndef MK_ONE_LAUNCH
#define MK_ONE_LAUNCH 1
#endif
constexpr int BATCH = 8, SEQ = 8192, DM = 1024, DEPTH = 4, M = BATCH * SEQ;
constexpr int NIN = 3584, INW = 3592, FF = 2816, PLE = 256, NFH = 8, NCHK = SEQ / 128;
constexpr int NPH = 2 + 9 * DEPTH;
constexpr float LOG2E = 1.4426950408889634f;
constexpr size_t MiB = 1u << 20;
constexpr size_t WS_CTL = 0, CTL_ZERO_BYTES = 1 * MiB;
constexpr size_t WS_WFB = 1 * MiB;
constexpr size_t WS_CS = 2 * MiB;
constexpr size_t WS_LF = 4 * MiB;
constexpr size_t WS_CB = 6 * MiB;
constexpr size_t WS_SSQ0 = 9 * MiB, WS_SSQ1 = 13 * MiB;
constexpr size_t WS_W = 17 * MiB, W_LAYER = 28 * MiB;
constexpr size_t WO_IN = 0, WO_OUT = 7 * MiB, WO_A = 9 * MiB, WO_G = 14 * MiB + MiB / 2, WO_DOWN = 20 * MiB, WO_GATE = 25 * MiB + MiB / 2, WO_PROJ = 27 * MiB + MiB / 2;
constexpr size_t WS_HB = 129 * MiB;
constexpr size_t WS_PB = 257 * MiB;
constexpr size_t WS_X = 289 * MiB, XR = 81 * MiB;
#define XBUF(off, per_batch_bytes) (WS_X + (size_t)(off) + (size_t)(bx & 7) * (XR - (size_t)(per_batch_bytes)))
#define WS_QO  XBUF(0, 16 * MiB)
#define PP_BASE ((bf16*)(ws + WS_HBT))
#define WS_KK  XBUF(16 * MiB, 16 * MiB)
#define WS_VV  XBUF(32 * MiB, 16 * MiB)
#define WS_G   XBUF(48 * MiB, 8 * MiB)
#define WS_U   XBUF(56 * MiB, 1 * MiB)
#define WS_NRM XBUF(57 * MiB, MiB / 2)
#define WS_ACT XBUF(16 * MiB, 44 * MiB)
#define WS_FIX XBUF(62 * MiB, 704 * 2048)
#define WS_HAL XBUF(63 * MiB + MiB / 2, 704 * 1024)
#define WS_HBT XBUF(65 * MiB, 16 * MiB)
constexpr size_t WS_END = WS_X + 8 * XR;
static_assert(WS_W + DEPTH * W_LAYER == WS_HB && WS_END <= 1024 * MiB, "d_ws map");
constexpr int CW_QK = 65536;
constexpr int CW_TAB = 131072;
constexpr int CW_BAR = 4096;

constexpr int RING_BYTES = 131072, LDSCTL_OFF = RING_BYTES, MISC_OFF = LDSCTL_OFF + 320, LDS_BYTES = 147456;

typedef float f32x16 __attribute__((ext_vector_type(16)));
typedef short s16x4 __attribute__((ext_vector_type(4)));
typedef float f32x2_ __attribute__((ext_vector_type(2)));
typedef __bf16 bf16x2_ __attribute__((ext_vector_type(2)));
__device__ __forceinline__ unsigned cvtpk(float lo, float hi) { f32x2_ v = {lo, hi}; bf16x2_ b = __builtin_convertvector(v, bf16x2_); return __builtin_bit_cast(unsigned, b); }
__device__ __forceinline__ int crow16(int r, int hi) { return (r & 3) + 8 * (r >> 2) + 4 * hi; }
__device__ __forceinline__ float bpx(float v, int lane, int mask) { return __int_as_float(__builtin_amdgcn_ds_bpermute((lane ^ mask) << 2, __float_as_int(v))); }
__device__ __forceinline__ float wave_sum(float v, int lane) {
#pragma unroll
    for (int o = 1; o < 32; o <<= 1) v += bpx(v, lane, o);
    return pg8::halves_sum(v);
}
__device__ __forceinline__ s16x4 trd(LAS unsigned char* p) { typedef short v4i16_t __attribute__((ext_vector_type(4))); return __builtin_bit_cast(s16x4, __builtin_amdgcn_ds_read_tr16_b64_v4i16((LAS v4i16_t*)p)); }
__device__ __forceinline__ bf16x8 cat8(s16x4 lo, s16x4 hi) { return (bf16x8){lo[0], lo[1], lo[2], lo[3], hi[0], hi[1], hi[2], hi[3]}; }
#define MFMA32(a, b, c) __builtin_amdgcn_mfma_f32_32x32x16_bf16((a), (b), (c), 0, 0, 0)

__device__ __forceinline__ void tr_item(const float* W, int ldw, int c0, const float* kscale, int K, bf16* WT, int dst_row0, int mode, LAS float* scr, int item, int nblk, int lane) {
    const int kb = item / nblk, nb = item % nblk, k0 = 64 * kb, n0 = 32 * nb;
    { pg8::f32x4 v[8]; float sc[8];
#pragma unroll
      for (int p = 0; p < 8; ++p) { const int kk = 8 * p + (lane >> 3); v[p] = __builtin_nontemporal_load((const pg8::f32x4*)(W + (size_t)(k0 + kk) * ldw + c0 + n0 + 4 * (lane & 7))); sc[p] = kscale ? kscale[k0 + kk] : 1.f; }
#pragma unroll
      for (int p = 0; p < 8; ++p) { const int kk = 8 * p + (lane >> 3); LAS float* d = scr + kk * 33 + 4 * (lane & 7); d[0] = v[p][0] * sc[p]; d[1] = v[p][1] * sc[p]; d[2] = v[p][2] * sc[p]; d[3] = v[p][3] * sc[p]; } }
    LDS_WAIT(); asm volatile("" ::: "memory");
    const int c = lane & 7;
#pragma unroll
    for (int j = 0; j < 4; ++j) { const int n = (lane >> 3) + 8 * j, nn = n0 + n; const LAS float* s = scr + (8 * c) * 33 + n;
        int drow = nn; if (mode == 1) { const int d = nn & 63; drow = (nn & ~63) + ((d < 32) ? (8 * (d >> 2) + (d & 3)) : (8 * ((d - 32) >> 2) + 4 + (d & 3))); }
        if (mode == 2) drow = (nn >> 7) * 256 + (nn & 127);
        v4u o; o.x = cvtpk(s[0 * 33], s[1 * 33]); o.y = cvtpk(s[2 * 33], s[3 * 33]); o.z = cvtpk(s[4 * 33], s[5 * 33]); o.w = cvtpk(s[6 * 33], s[7 * 33]);
        *(GAS v4u*)(WT + (size_t)(dst_row0 + drow) * K + k0 + 8 * c) = o; }
    LDS_WAIT(); asm volatile("" ::: "memory");
}
constexpr int IT_IN = 7 * 256, IT_OUT = 512, IT_UP = 1408, IT_DOWN = 1408, IT_GATE = 512, IT_PROJ = 128, IT_LAYER = IT_IN + IT_OUT + 2 * IT_UP + IT_DOWN + IT_GATE + IT_PROJ;

struct Args { const float* in[15]; float* out; unsigned char* ws; int ph_lo, ph_hi; };
__device__ __forceinline__ const float* inp_ptr(const unsigned char* ws, int k, int zq) {
    const unsigned* t = (const unsigned*)(ws + WS_CTL) + CW_TAB + 2 * k + zq; const unsigned lo = t[0], hi = t[1];
    const GAS float* g = (const GAS float*)(((unsigned long long)(unsigned)__builtin_amdgcn_readfirstlane((int)hi) << 32) | (unsigned)__builtin_amdgcn_readfirstlane((int)lo));
    return (const float*)g;
}
#define INP(k) inp_ptr(ws, (k), zq)

__device__ __forceinline__ void convert_layer(unsigned char* ws, int zq, LAS unsigned char* ldsl, int l, int gw, int NGW, int wave, int lane) {
    LAS float* scr = (LAS float*)(ldsl + wave * 16384);
    unsigned char* wl = ws + WS_W + (size_t)l * W_LAYER;
    const float* w_in = INP(3) + (size_t)l * DM * INW; const float* w_up = INP(7) + (size_t)l * DM * 2 * FF;
    const float* nw_attn = INP(2) + l * DM; const float* nw_ffn = INP(6) + l * DM; const float* nw_ple = INP(11) + l * DM;
    const float* w_out = INP(5) + (size_t)l * DM * DM; const float* w_down = INP(10) + (size_t)l * FF * DM; const float* w_gate = INP(12) + (size_t)l * DM * DM; const float* w_proj = INP(13) + (size_t)l * PLE * DM;
    for (int it = gw; it < IT_LAYER; it += NGW) {
        int r = it;
        if (r < IT_IN) { const int seg = r >> 8; tr_item(w_in, INW, seg * 512 + (seg >= 3 ? 8 : 0), nw_attn, DM, (bf16*)(wl + WO_IN), seg * 512, (seg == 3 || seg == 4) ? 1 : 0, scr, r & 255, 16, lane); continue; } r -= IT_IN;
        if (r < IT_OUT) { tr_item(w_out, DM, 0, nullptr, DM, (bf16*)(wl + WO_OUT), 0, 0, scr, r, 32, lane); continue; } r -= IT_OUT;
        if (r < IT_UP) { tr_item(w_up, 2 * FF, 0, nw_ffn, DM, (bf16*)(wl + WO_A), 0, 2, scr, r, 88, lane); continue; } r -= IT_UP;
        if (r < IT_UP) { tr_item(w_up, 2 * FF, FF, nw_ffn, DM, (bf16*)(wl + WO_A), 128, 2, scr, r, 88, lane); continue; } r -= IT_UP;
        if (r < IT_DOWN) { tr_item(w_down, DM, 0, nullptr, FF, (bf16*)(wl + WO_DOWN), 0, 0, scr, r, 32, lane); continue; } r -= IT_DOWN;
        if (r < IT_GATE) { tr_item(w_gate, DM, 0, nw_ple, DM, (bf16*)(wl + WO_GATE), 0, 0, scr, r, 32, lane); continue; } r -= IT_GATE;
        tr_item(w_proj, DM, 0, nullptr, PLE, (bf16*)(wl + WO_PROJ), 0, 0, scr, r, 32, lane);
    }
}
__device__ __forceinline__ void prologue(unsigned char* ws, int zq, LAS unsigned char* ldsl, int gw, int NGW, int wave, int lane, int gtid, int GT) {
    convert_layer(ws, zq, ldsl, 0, gw, NGW, wave, lane);
    { bf16* wfb = (bf16*)(ws + WS_WFB); const float* nwa = INP(2); const float* win = INP(3);
      for (int i = gtid; i < DEPTH * 8 * DM; i += GT) { const int l = i / (8 * DM), j = (i / DM) & 7, k = i % DM;
          wfb[i] = (bf16)(cvtpk(nwa[l * DM + k] * win[(size_t)l * DM * INW + (size_t)k * INW + 1536 + j], 0.f) & 0xffffu); } }
    { float* cs = (float*)(ws + WS_CS);
      for (int i = gtid; i < SEQ * 32; i += GT) { const int pos = i >> 5, d = i & 31; const float inv = powf(10000.0f, -(float)(2 * d) / 64.0f), ang = (float)pos * inv; float sn, cn; sincosf(ang, &sn, &cn); cs[i] = cn; cs[SEQ * 32 + i] = sn; } }
    { bf16* hb = (bf16*)(ws + WS_HB); float* ssq = (float*)(ws + WS_SSQ0); const float* xin = INP(0);
      for (int m0 = gw; m0 < M; m0 += 4 * NGW) {
          f32x4 v[4][4];
#pragma unroll
          for (int k = 0; k < 4; ++k) { const float* xr = xin + (size_t)(m0 + k * NGW) * DM;
#pragma unroll
              for (int j = 0; j < 2; ++j) { v[k][2 * j] = __builtin_nontemporal_load((const f32x4*)(xr + j * 512 + lane * 8)); v[k][2 * j + 1] = __builtin_nontemporal_load((const f32x4*)(xr + j * 512 + lane * 8 + 4)); } }
#pragma unroll
          for (int k = 0; k < 4; ++k) { const int m = m0 + k * NGW; float s = 0.f;
#pragma unroll
              for (int j = 0; j < 2; ++j) { const f32x4 v0 = v[k][2 * j], v1 = v[k][2 * j + 1];
                  s += ((v0[0] * v0[0] + v0[1] * v0[1]) + (v0[2] * v0[2] + v0[3] * v0[3])) + ((v1[0] * v1[0] + v1[1] * v1[1]) + (v1[2] * v1[2] + v1[3] * v1[3]));
                  v4u o; o.x = cvtpk(v0[0], v0[1]); o.y = cvtpk(v0[2], v0[3]); o.z = cvtpk(v1[0], v1[1]); o.w = cvtpk(v1[2], v1[3]); *(v4u*)(hb + (size_t)m * DM + j * 512 + lane * 8) = o; }
              s = wave_sum(s, lane); if (lane < 16) ssq[(size_t)m * 16 + lane] = s * (1.0f / 16.0f); } } }
}

__device__ __forceinline__ void flogit_pb_task(const bf16* hb, const bf16* wfb, const float* ssq, const float* fbias, float* lf, const float* p, bf16* pb, int vcu, int wave, int lane) {
    const int r32 = lane & 31, hi = lane >> 5;
    const int row0 = vcu * 256 + wave * 32;
    const bf16* ap = hb + (size_t)(row0 + r32) * DM + 8 * hi; const bf16* bp = wfb + (r32 & 7) * DM + 8 * hi;
    const size_t i0 = (size_t)(vcu >> 5) * (SEQ * PLE / 8) + (size_t)(vcu & 31) * (NWAVES * 64) + wave * 64 + lane;
    f32x16 acc; for (int i = 0; i < 16; ++i) acc[i] = 0.f;
#pragma unroll 1
    for (int kb = 0; kb < 8; ++kb) {
        f32x4 pv[2][2];
#pragma unroll
        for (int j = 0; j < 2; ++j) { const float* s = p + (i0 + (size_t)(2 * kb + j) * (32 * NWAVES * 64)) * 8; pv[j][0] = __builtin_nontemporal_load((const f32x4*)s); pv[j][1] = __builtin_nontemporal_load((const f32x4*)(s + 4)); }
#pragma unroll
        for (int ks = 0; ks < 8; ++ks) acc = MFMA32(*(const bf16x8*)(ap + 16 * (8 * kb + ks)), *(const bf16x8*)(bp + 16 * (8 * kb + ks)), acc);
#pragma unroll
        for (int j = 0; j < 2; ++j) { v4u o; o.x = cvtpk(pv[j][0][0], pv[j][0][1]); o.y = cvtpk(pv[j][0][2], pv[j][0][3]); o.z = cvtpk(pv[j][1][0], pv[j][1][1]); o.w = cvtpk(pv[j][1][2], pv[j][1][3]);
            *(v4u*)(pb + (i0 + (size_t)(2 * kb + j) * (32 * NWAVES * 64)) * 8) = o; }
    }
    if (r32 < 8) { const float fb = fbias[r32];
#pragma unroll
        for (int r = 0; r < 16; ++r) { const int row = row0 + crow16(r, hi); const float x = acc[r] * pg8::row_rstd(ssq, row) + fb;
            lf[(size_t)row * 8 + r32] = fminf(x, 0.f) - __logf(1.0f + __expf(-fabsf(x))); } }
}

__device__ __forceinline__ void flogit_task(const bf16* hb, const bf16* wfb, const float* ssq, const float* fbias, float* lf, int G, int bx, int wave, int lane) {
    const int r32 = lane & 31, hi = lane >> 5;
    for (int blk = bx; blk < M / 256; blk += G) {
        const int row0 = blk * 256 + wave * 32;
        const bf16* ap = hb + (size_t)(row0 + r32) * DM + 8 * hi; const bf16* bp = wfb + (r32 & 7) * DM + 8 * hi;
        f32x16 acc; for (int i = 0; i < 16; ++i) acc[i] = 0.f;
#pragma unroll 8
        for (int ks = 0; ks < DM / 16; ++ks) acc = MFMA32(*(const bf16x8*)(ap + 16 * ks), *(const bf16x8*)(bp + 16 * ks), acc);
        if (r32 < 8) { const float fb = fbias[r32];
#pragma unroll
            for (int r = 0; r < 16; ++r) { const int row = row0 + crow16(r, hi); const float x = acc[r] * pg8::row_rstd(ssq, row) + fb;
                lf[(size_t)row * 8 + r32] = fminf(x, 0.f) - __logf(1.0f + __expf(-fabsf(x))); } }
    }
}
__device__ __forceinline__ void pb_task(const float* p, bf16* pb, int vcu, int tid) {
    const int i0 = (vcu >> 5) * (SEQ * PLE / 8);
    for (int j = (vcu & 31) * (NWAVES * 64) + tid; j < SEQ * PLE / 8; j += 32 * NWAVES * 64) { const int i = i0 + j; const f32x4 v0 = __builtin_nontemporal_load((const f32x4*)(p + (size_t)i * 8)), v1 = __builtin_nontemporal_load((const f32x4*)(p + (size_t)i * 8 + 4));
        v4u o; o.x = cvtpk(v0[0], v0[1]); o.y = cvtpk(v0[2], v0[3]); o.z = cvtpk(v1[0], v1[1]); o.w = cvtpk(v1[2], v1[3]); *(v4u*)(pb + (size_t)i * 8) = o; }
}

__device__ __forceinline__ float lane_up(float v, int lane, int o) { return __int_as_float(__builtin_amdgcn_ds_bpermute((lane - o) << 2, __float_as_int(v))); }
__device__ __forceinline__ void cumsum_task(const float* lf, float* cb, LAS float* red, int vcu, int tid) {
    const int b = vcu >> 5, r = vcu & 31, h = r & 7, qd = r >> 3, lane = tid & 63, wave = tid >> 6;
    const float* src = lf + ((size_t)b * SEQ) * 8 + h;
    float pre = 0.f, v[4];
    { float pv[3][4];
#pragma unroll
      for (int q = 0; q < 3; ++q)
#pragma unroll
          for (int i = 0; i < 4; ++i) pv[q][i] = (q < qd) ? src[(size_t)(q * 2048 + tid * 4 + i) * 8] : 0.f;
#pragma unroll
      for (int i = 0; i < 4; ++i) v[i] = src[(size_t)(qd * 2048 + tid * 4 + i) * 8];
#pragma unroll
      for (int q = 0; q < 3; ++q) pre += (pv[q][0] + pv[q][1]) + (pv[q][2] + pv[q][3]); }
    v[1] += v[0]; v[2] += v[1]; v[3] += v[2];
    float x = v[3];
#pragma unroll
    for (int o = 1; o < 64; o <<= 1) { const float y = lane_up(x, lane, o); if (lane >= o) x += y; }
    pre = wave_sum(pre, lane);
    if (lane == 63) red[wave] = x;
    if (lane == 0) red[8 + wave] = pre;
    __syncthreads();
    float off = 0.f;
#pragma unroll
    for (int w = 0; w < 8; ++w) { off += red[8 + w]; if (w < wave) off += red[w]; }
    off += x - v[3];
    *(f32x4*)(cb + (size_t)(b * 8 + h) * SEQ + qd * 2048 + tid * 4) = (f32x4){(off + v[0]) * LOG2E, (off + v[1]) * LOG2E, (off + v[2]) * LOG2E, (off + v[3]) * LOG2E};
    __syncthreads();
}
__device__ __forceinline__ void fill_img(LAS unsigned char* img, const bf16* g, int t256) {
#pragma unroll
    for (int i = 0; i < 4; ++i) { const int idx = t256 + 256 * i, row = idx >> 3, ch = idx & 7;
        *(LAS v4u*)(img + (ch >> 2) * 8192 + row * 64 + (ch & 3) * 16) = *(const v4u*)(g + (size_t)row * DM + ch * 8); }
}
#define RG_PREF(KR, VR, goff) do { _Pragma("unroll") for (int i_ = 0; i_ < 4; ++i_) { const int idx_ = t256 + 256 * i_, row_ = idx_ >> 3, ch_ = idx_ & 7; \
        KR[i_] = *(const v4u*)(KK + (goff) + (size_t)row_ * DM + ch_ * 8); VR[i_] = *(const v4u*)(VV + (goff) + (size_t)row_ * DM + ch_ * 8); } } while (0)
#define RG_PUT(KR, VR) do { _Pragma("unroll") for (int i_ = 0; i_ < 4; ++i_) { const int idx_ = t256 + 256 * i_, row_ = idx_ >> 3, ch_ = idx_ & 7; \
        *(LAS v4u*)(base + (ch_ >> 2) * 8192 + row_ * 64 + (ch_ & 3) * 16) = KR[i_]; *(LAS v4u*)(base + 16384 + (ch_ >> 2) * 8192 + row_ * 64 + (ch_ & 3) * 16) = VR[i_]; } } while (0)
#define RG_STATE(ACC) do { _Pragma("unroll") for (int s_ = 0; s_ < 8; ++s_) ACC = MFMA32(cat8(trd(va + s_ * 1024), trd(va + s_ * 1024 + 256)), cat8(trd(ka + s_ * 1024), trd(ka + s_ * 1024 + 256)), ACC); } while (0)
__device__ __forceinline__ void ret_group_state(LAS unsigned char* ldsl, const bf16* KK, const bf16* VV, float* AG, int bx, int tid) {
    const int lane = tid & 63, wave = __builtin_amdgcn_readfirstlane(tid >> 6), h2 = wave >> 2, w4 = wave & 3, t256 = tid & 255;
    const int r32 = lane & 31, hi = lane >> 5, g1 = (lane >> 4) & 1, q = (lane & 15) >> 2, p = lane & 3;
    LAS unsigned char* base = ldsl + h2 * 32768;
    const int uid = 2 * bx + h2, bh = uid >> 3, g = uid & 7, b = bh >> 3, h = bh & 7, eb = w4 & 1, db = w4 >> 1;
    const size_t goff0 = ((size_t)b * SEQ + (size_t)g * 1024) * DM + 512 + h * 64;
    LAS unsigned char* va = base + 16384 + eb * 8192 + (8 * hi + q) * 64 + g1 * 32 + p * 8;
    LAS unsigned char* ka = base + db * 8192 + (8 * hi + q) * 64 + g1 * 32 + p * 8;
    const float g128 = __builtin_amdgcn_exp2f(128.0f * pg8::lg2gamma(h));
    v4u kr[4], vr[4];
    RG_PREF(kr, vr, goff0); RG_PUT(kr, vr); RG_PREF(kr, vr, goff0 + (size_t)128 * DM);
    __syncthreads();
    f32x16 acc; for (int i = 0; i < 16; ++i) acc[i] = 0.f;
#pragma unroll 1
    for (int i = 0; i < 8; ++i) {
        RG_STATE(acc);
#pragma unroll
        for (int r = 0; r < 16; ++r) acc[r] *= g128;
        __syncthreads();
        if (i < 7) { RG_PUT(kr, vr); if (i < 6) RG_PREF(kr, vr, goff0 + (size_t)(i + 2) * 128 * DM); __syncthreads(); }
    }
    float* up = AG + (size_t)uid * 4096 + (32 * db + r32) * 64 + 32 * eb + 4 * hi;
#pragma unroll
    for (int gg = 0; gg < 4; ++gg) *(pg8::f32x4*)(up + 8 * gg) = (pg8::f32x4){acc[4 * gg], acc[4 * gg + 1], acc[4 * gg + 2], acc[4 * gg + 3]};
}
__device__ __forceinline__ void qknorm_task(const float* nrm, unsigned* qk, int gw, int NGW, int lane) {
    for (int blk = gw; blk < M / 32; blk += NGW) {
        float mq = 0.f, mk = 0.f;
#pragma unroll
        for (int i = 0; i < 4; ++i) { const int rh = (blk * 32 + i * 8) * 8 + lane;
            const f32x2_ a = *(const f32x2_*)(nrm + (size_t)rh * 2), k = *(const f32x2_*)(nrm + (size_t)M * 16 + (size_t)rh * 2);
            mq = fmaxf(mq, a.x + a.y); mk = fmaxf(mk, k.x + k.y); }
        mq = fmaxf(mq, bpx(mq, lane, 8)); mq = fmaxf(mq, bpx(mq, lane, 16)); mq = fmaxf(mq, bpx(mq, lane, 32));
        mk = fmaxf(mk, bpx(mk, lane, 8)); mk = fmaxf(mk, bpx(mk, lane, 16)); mk = fmaxf(mk, bpx(mk, lane, 32));
        if (lane < 8) { const int bh = ((blk * 32) >> 13) * 8 + lane;
            atomicMax(qk + 2 * bh, __float_as_uint(sqrtf(mq))); atomicMax(qk + 2 * bh + 1, __float_as_uint(sqrtf(mk))); }
    }
}
__device__ __forceinline__ void ret_group_out(LAS unsigned char* ldsl, const bf16* QO, bf16* OUT, const bf16* KK, const bf16* VV, const bf16* Gt, const float* AG, int bx, int tid) {
    const int lane = tid & 63, wave = __builtin_amdgcn_readfirstlane(tid >> 6), h2 = wave >> 2, w4 = wave & 3, qb = w4, t256 = tid & 255;
    const int r32 = lane & 31, hi = lane >> 5, g1 = (lane >> 4) & 1, q = (lane & 15) >> 2, p = lane & 3;
    LAS unsigned char* base = ldsl + h2 * 59392;
    LAS unsigned char* simg = base + 32768;
    LAS unsigned char* stg = base + 40960 + qb * 4608;
    const int uid = 2 * bx + h2, bh = uid >> 3, g = uid & 7, b = bh >> 3, h = bh & 7, eb = w4 & 1, db = w4 >> 1;
    const size_t grow00 = (size_t)b * SEQ + (size_t)g * 1024; const int colh = 512 + h * 64;
    const size_t goff0 = grow00 * DM + colh;
    LAS unsigned char* va = base + 16384 + eb * 8192 + (8 * hi + q) * 64 + g1 * 32 + p * 8;
    LAS unsigned char* ka = base + db * 8192 + (8 * hi + q) * 64 + g1 * 32 + p * 8;
    LAS unsigned char* vb = base + 16384 + (4 * hi + q) * 64 + g1 * 32 + p * 8;
    const float lg = pg8::lg2gamma(h), g128 = __builtin_amdgcn_exp2f(128.0f * lg);
    v4u kr[4], vr[4];
    RG_PREF(kr, vr, goff0);
    bf16x8 qf[4];
#pragma unroll
    for (int ks = 0; ks < 4; ++ks) qf[ks] = *(const bf16x8*)(QO + (grow00 + 32 * qb + r32) * DM + colh + 16 * ks + 8 * hi);
    f32x16 sacc; for (int i = 0; i < 16; ++i) sacc[i] = 0.f;
    { const float* ap0 = AG + (size_t)(bh * 8) * 4096 + (32 * db + r32) * 64 + 32 * eb + 4 * hi;
#pragma unroll
      for (int bt = 0; bt < 4; ++bt) { pg8::f32x4 av[2][4];
#pragma unroll
          for (int k = 0; k < 2; ++k) { const int gp = 2 * bt + k;
#pragma unroll
              for (int gg = 0; gg < 4; ++gg) av[k][gg] = (gp < g) ? *(const pg8::f32x4*)(ap0 + (size_t)(gp < g ? gp : 0) * 4096 + 8 * gg) : (pg8::f32x4){0.f, 0.f, 0.f, 0.f}; }
#pragma unroll
          for (int k = 0; k < 2; ++k) { const int gp = 2 * bt + k; const float wgt = (gp < g) ? __builtin_amdgcn_exp2f((float)(g - 1 - gp) * 1024.0f * lg) : 0.f;
#pragma unroll
              for (int gg = 0; gg < 4; ++gg)
#pragma unroll
                  for (int j = 0; j < 4; ++j) sacc[4 * gg + j] += wgt * av[k][gg][j]; } } }
    RG_PUT(kr, vr);
    RG_PREF(kr, vr, goff0 + (size_t)128 * DM);
#pragma unroll 1
    for (int i = 0; i < 8; ++i) {
        const size_t grow0 = grow00 + (size_t)i * 128;
#pragma unroll
        for (int r = 0; r < 16; ++r) *(LAS unsigned short*)(simg + (32 * eb + crow16(r, hi)) * 128 + (32 * db + r32) * 2) = (unsigned short)(cvtpk(sacc[r], 0.f) & 0xffffu);
        __syncthreads();
        bf16x8 qn[4]; v4u gv[4];
        if (i < 7) {
#pragma unroll
            for (int ks = 0; ks < 4; ++ks) qn[ks] = *(const bf16x8*)(QO + (grow0 + 128 + 32 * qb + r32) * DM + colh + 16 * ks + 8 * hi); }
#pragma unroll
        for (int j = 0; j < 4; ++j) gv[j] = *(const v4u*)(Gt + (grow0 + 32 * qb + j * 8 + (lane >> 3)) * 512 + h * 64 + (lane & 7) * 8);
        f32x16 o0, o1;
#if PROBE_RG == 1
        f32x16 sacc_keep = sacc;
        for (int prb = 0; prb < 2; ++prb) { sacc = sacc_keep; asm volatile("" : "+v"(sacc));
#endif
        for (int r = 0; r < 16; ++r) { o0[r] = 0.f; o1[r] = 0.f; }
#pragma unroll
        for (int kb = 0; kb < 4; ++kb) if (kb <= qb) {
            f32x16 st; for (int r = 0; r < 16; ++r) st[r] = 0.f;
#pragma unroll
            for (int ks = 0; ks < 4; ++ks) st = MFMA32(*(const LAS bf16x8*)(base + (ks >> 1) * 8192 + (32 * kb + r32) * 64 + (16 * (ks & 1) + 8 * hi) * 2), qf[ks], st);
            if (kb == qb) {
#pragma unroll
                for (int r = 0; r < 16; ++r) if (crow16(r, hi) > r32) st[r] = 0.f;
            }
#pragma unroll
            for (int s = 0; s < 2; ++s) { v4u w; w.x = cvtpk(st[8 * s], st[8 * s + 1]); w.y = cvtpk(st[8 * s + 2], st[8 * s + 3]); w.z = cvtpk(st[8 * s + 4], st[8 * s + 5]); w.w = cvtpk(st[8 * s + 6], st[8 * s + 7]);
                const bf16x8 pk = __builtin_bit_cast(bf16x8, w); LAS unsigned char* vr_ = vb + (32 * kb + 16 * s) * 64;
                o0 = MFMA32(cat8(trd(vr_), trd(vr_ + 512)), pk, o0); o1 = MFMA32(cat8(trd(vr_ + 8192), trd(vr_ + 8192 + 512)), pk, o1); }
        }
#pragma unroll
        for (int ks = 0; ks < 4; ++ks) { o0 = MFMA32(*(const LAS bf16x8*)(simg + r32 * 128 + (16 * ks + 8 * hi) * 2), qf[ks], o0); o1 = MFMA32(*(const LAS bf16x8*)(simg + (32 + r32) * 128 + (16 * ks + 8 * hi) * 2), qf[ks], o1); }
        RG_STATE(sacc);
#pragma unroll
        for (int r = 0; r < 16; ++r) sacc[r] *= g128;
#if PROBE_RG == 1
        }
#endif
        __syncthreads();
        if (i < 7) RG_PUT(kr, vr);
        if (i < 6) RG_PREF(kr, vr, goff0 + (size_t)(i + 2) * 128 * DM);
#if PROBE_RG == 2
        for (int prb = 0; prb < 2; ++prb) { asm volatile("" : "+v"(o0), "+v"(o1));
#endif
        float sm = 0.f;
#pragma unroll
        for (int r = 0; r < 16; ++r) sm += o0[r] + o1[r];
        sm = pg8::halves_sum(sm); const float mu = sm * (1.0f / 64.0f); float vs = 0.f;
#pragma unroll
        for (int r = 0; r < 16; ++r) { const float d0 = o0[r] - mu, d1 = o1[r] - mu; vs += d0 * d0 + d1 * d1; }
        vs = pg8::halves_sum(vs); const float rstd = __builtin_amdgcn_rsqf(vs * (1.0f / 64.0f) + 1e-5f);
        typedef unsigned u32x2_ __attribute__((ext_vector_type(2)));
#pragma unroll
        for (int gg = 0; gg < 4; ++gg) {
            u32x2_ w0, w1; w0.x = cvtpk((o0[4 * gg] - mu) * rstd, (o0[4 * gg + 1] - mu) * rstd); w0.y = cvtpk((o0[4 * gg + 2] - mu) * rstd, (o0[4 * gg + 3] - mu) * rstd);
            w1.x = cvtpk((o1[4 * gg] - mu) * rstd, (o1[4 * gg + 1] - mu) * rstd); w1.y = cvtpk((o1[4 * gg + 2] - mu) * rstd, (o1[4 * gg + 3] - mu) * rstd);
            *(LAS u32x2_*)(stg + r32 * 136 + (8 * gg + 4 * hi) * 2) = w0; *(LAS u32x2_*)(stg + r32 * 136 + (32 + 8 * gg + 4 * hi) * 2) = w1; }
        LDS_WAIT(); asm volatile("" ::: "memory");
#pragma unroll
        for (int j = 0; j < 4; ++j) {
            const int row = j * 8 + (lane >> 3), ch = lane & 7; const u32x2_ a = *(LAS u32x2_*)(stg + row * 136 + ch * 16), bq = *(LAS u32x2_*)(stg + row * 136 + ch * 16 + 8);
            const v4u y = (v4u){a.x, a.y, bq.x, bq.y};
            pg8::f32x4 y0, y1, g0, g1_; pg8::unpack8(y, y0, y1); pg8::unpack8(gv[j], g0, g1_);
            *(v4u*)(OUT + (grow0 + 32 * qb + row) * DM + colh + ch * 8) = pg8::pack8(y0 * g0, y1 * g1_); }
        LDS_WAIT(); asm volatile("" ::: "memory");
#if PROBE_RG == 2
        }
#endif
        if (i < 7) {
#pragma unroll
            for (int ks = 0; ks < 4; ++ks) qf[ks] = qn[ks]; }
    }
}
#undef RG_PREF
#undef RG_PUT
#undef RG_STATE
struct FxItem { pg8::f32x4 f0, f1, h1, h2, w0, w1; };
__device__ __forceinline__ void fx_load(FxItem (&it)[3], const float* FIX, const float* HAL, const float* cw, int pm, int tid) {
#pragma unroll
    for (int k = 0; k < 3; ++k) { const int j = tid + k * (NWAVES * 64);
        if (j < 22 * 2 * 32) { const int c4 = (j & 31) * 4, r = (j >> 5) & 1, pn = j >> 6, unit = pm * 22 + pn; const size_t idx = (size_t)unit * 256 + r * 128 + c4; const int colg = pn * 128 + c4;
            it[k].f0 = *(const pg8::f32x4*)(FIX + idx * 2); it[k].f1 = *(const pg8::f32x4*)(FIX + idx * 2 + 4);
            it[k].h1 = *(const pg8::f32x4*)(HAL + ((size_t)(unit - 22) * 2 + 1) * 128 + c4); it[k].h2 = *(const pg8::f32x4*)(HAL + ((size_t)(unit - 22) * 2) * 128 + c4);
            it[k].w0 = *(const pg8::f32x4*)(cw + colg); it[k].w1 = *(const pg8::f32x4*)(cw + FF + colg); } }
}
__device__ __forceinline__ void fx_store(const FxItem (&it)[3], bf16* ACT, int pm, int tid) {
#pragma unroll
    for (int k = 0; k < 3; ++k) { const int j = tid + k * (NWAVES * 64);
        if (j < 22 * 2 * 32) { const int c4 = (j & 31) * 4, r = (j >> 5) & 1, pn = j >> 6, colg = pn * 128 + c4;
            const pg8::f32x4 yp = (pg8::f32x4){it[k].f0[0], it[k].f0[2], it[k].f1[0], it[k].f1[2]}, g = (pg8::f32x4){it[k].f0[1], it[k].f0[3], it[k].f1[1], it[k].f1[3]};
            const pg8::f32x4 y = (r == 0) ? yp + it[k].w1 * it[k].h1 + it[k].w0 * it[k].h2 : yp + it[k].w0 * it[k].h1;
            const pg8::f32x2 ga = pg8::gelu_pk((pg8::f32x2){y[0], y[1]}), gb = pg8::gelu_pk((pg8::f32x2){y[2], y[3]});
            typedef unsigned u32x2_ __attribute__((ext_vector_type(2)));
            u32x2_ o; o.x = cvtpk(ga.x * g[0], ga.y * g[1]); o.y = cvtpk(gb.x * g[2], gb.y * g[3]);
            *(u32x2_*)(ACT + (size_t)(pm * 256 + r) * FF + colg) = o; } }
}
__device__ __forceinline__ void ffn_fixup_own(const float* FIX, const float* HAL, const float* cw, bf16* ACT, const pg8::StaticOrder& S, int tid) {
    pg8::Unit u; int pms[4];
#pragma unroll
    for (int i = 0; i < 4; ++i) pms[i] = S.next(i, u) ? u.pm : 0;
    FxItem a[3], b[3];
    if (pms[0] & 31) fx_load(a, FIX, HAL, cw, pms[0], tid);
    if (pms[1] & 31) fx_load(b, FIX, HAL, cw, pms[1], tid);
    if (pms[0] & 31) fx_store(a, ACT, pms[0], tid);
    if (pms[2] & 31) fx_load(a, FIX, HAL, cw, pms[2], tid);
    if (pms[1] & 31) fx_store(b, ACT, pms[1], tid);
    if (pms[3] & 31) fx_load(b, FIX, HAL, cw, pms[3], tid);
    if (pms[2] & 31) fx_store(a, ACT, pms[2], tid);
    if (pms[3] & 31) fx_store(b, ACT, pms[3], tid);
    VM_WAIT(); __syncthreads();
    __builtin_amdgcn_fence(__ATOMIC_ACQUIRE, "agent");
}
__device__ __forceinline__ void final_task(const bf16* h, float* out, const float* ssq, const float* wf, int vcu, int wave, int lane) {
    constexpr int NGW = 32 * NWAVES; const int gw = (vcu >> 5) * SEQ + (vcu & 31) * NWAVES + wave, mend = ((vcu >> 5) + 1) * SEQ;
    pg8::f32x4 w[4];
#pragma unroll
    for (int j = 0; j < 4; ++j) w[j] = *(const pg8::f32x4*)(wf + (j >> 1) * 512 + lane * 8 + (j & 1) * 4);
    for (int m0 = gw; m0 < mend; m0 += 4 * NGW) {
        v4u hv[4][2]; float rs[4];
#pragma unroll
        for (int k = 0; k < 4; ++k) { const int m = m0 + k * NGW; rs[k] = pg8::row_rstd(ssq, m);
#pragma unroll
            for (int j = 0; j < 2; ++j) hv[k][j] = *(const v4u*)(h + (size_t)m * DM + j * 512 + lane * 8); }
#pragma unroll
        for (int k = 0; k < 4; ++k) { float* o = out + (size_t)(m0 + k * NGW) * DM;
#pragma unroll
            for (int j = 0; j < 2; ++j) { pg8::f32x4 v0, v1; pg8::unpack8(hv[k][j], v0, v1);
                __builtin_nontemporal_store(v0 * rs[k] * w[2 * j], (pg8::f32x4*)(o + j * 512 + lane * 8)); __builtin_nontemporal_store(v1 * rs[k] * w[2 * j + 1], (pg8::f32x4*)(o + j * 512 + lane * 8 + 4)); } } }
}

#ifndef STAGGER_TICKS_P7
#define STAGGER_TICKS_P7 0
#endif
__device__ __forceinline__ void stagger_wait(int bx, unsigned ticks) {
    if (ticks && ((bx >> 3) & 1)) { const unsigned long long t0 = __builtin_amdgcn_s_memrealtime(); while (__builtin_amdgcn_s_memrealtime() - t0 < ticks) __builtin_amdgcn_s_sleep(16); }
}
#define PH_BEGIN() int tq = tid_now(wvs); int zq = 0; asm volatile("" : "+v"(tq), "+v"(zq)); int mo_ = MISC_OFF + 44; asm volatile("" : "+v"(mo_));     int bx = __builtin_amdgcn_readfirstlane(*(volatile LAS int*)(ldsl + mo_)); asm volatile("" : "+s"(bx));     GAS unsigned char* wsg_ = (GAS unsigned char*)args.ws; asm volatile("" : "+s"(wsg_)); unsigned char* ws = (unsigned char*)wsg_;     \
    const int lq = tq & 63, wq = __builtin_amdgcn_readfirstlane(tq >> 6), gtq = bx * (NWAVES * 64) + tq, vcu = (G % 8 == 0) ? (bx % 8) * (G / 8) + bx / 8 : bx, gw = vcu * NWAVES + wq; (void)lq; (void)wq; (void)gtq; (void)gw
#ifndef DEPH_ODD
#define DEPH_ODD (bx & 1)
#endif
#define SSQB(n) ((float*)(ws + (((n) & 1) ? WS_SSQ1 : WS_SSQ0)))
__global__ void __launch_bounds__(NWAVES * 64, 2) fwd(Args args) {
    extern __shared__ __attribute__((aligned(16))) unsigned char lds[];
    LAS unsigned char* ldsl = (LAS unsigned char*)lds;
    const int wvs = __builtin_amdgcn_readfirstlane((int)threadIdx.x >> 6);
    volatile LAS unsigned* MISC = (volatile LAS unsigned*)(ldsl + MISC_OFF);
    const int G = gridDim.x;
    const int NGW = G * NWAVES, GT = G * NWAVES * 64;
    for (int u = threadIdx.x; u < (LDS_BYTES - LDSCTL_OFF) / 4; u += NWAVES * 64) ((LAS unsigned*)(ldsl + LDSCTL_OFF))[u] = 0u;
    if (args.ph_lo == 0 && threadIdx.x == 0) {
#pragma unroll
        for (int k = 0; k < 15; ++k) ((unsigned long long*)((unsigned*)(args.ws + WS_CTL) + CW_TAB))[k] = (unsigned long long)args.in[k]; }
    __syncthreads();
#if MK_ONE_LAUNCH
    constexpr int lo = 0, hi = NPH;
#else
    const int lo = args.ph_lo, hi = args.ph_hi;
#endif
    if (threadIdx.x == 0) MISC[11] = blockIdx.x;
    __syncthreads();
    XcdBarrier bar; bar.bar = (unsigned*)(args.ws + WS_CTL) + CW_BAR; bar.x = 0; bar.st = nullptr;
    if (hi - lo > 1) bar = xcd_barrier_post((unsigned*)(args.ws + WS_CTL) + CW_BAR, MISC + 8);
#ifndef ONLY
#define ONLY -1
#endif
#define PON(j) (ONLY < 0 || ONLY == (j))
#define IN(k) (lo <= (k) && (k) < hi)
#define SEAM(k, glob) do { if (IN(k) && IN((k) + 1)) { xcd_barrier(bar, (glob) || !MK_ONE_LAUNCH, wvs); if (PROBE_DUP == 15) xcd_barrier(bar, (glob) || !MK_ONE_LAUNCH, wvs); } } while (0)

    for (int rep = 0; rep < NREP(10); ++rep) if (PON(0) && IN(0)) { PH_BEGIN(); prologue(ws, zq, ldsl, gw, NGW, wq, lq, gtq, GT); }
    SEAM(0, true);

    for (int L = 0; L < DEPTH; ++L) {
        const int p0 = 1 + 9 * L;
        for (int rep = 0; rep < NREP(1); ++rep) if (PON(1) && IN(p0)) {
            PH_BEGIN();
            const bf16* hin = (const bf16*)(ws + ((L == 0) ? WS_HB : WS_HBT));
            flogit_task(hin, (const bf16*)(ws + WS_WFB) + (size_t)L * 8 * DM, SSQB(3 * L), INP(4) + L * NFH, (float*)(ws + WS_LF), G, vcu, wq, lq);
            if DEPH_ODD pb_task(INP(1) + (size_t)L * M * PLE, (bf16*)(ws + WS_PB), vcu, tq);
            pg8::Gemm g{hin, (const bf16*)(ws + WS_W + (size_t)L * W_LAYER + WO_IN), M, NIN, DM}; pg8::StaticOrder S; S.init(M, NIN, G, bx);
            pg8::EpiIn E{(bf16*)(ws + WS_QO), (bf16*)(ws + WS_KK), (bf16*)(ws + WS_VV), (bf16*)(ws + WS_G), SSQB(3 * L), (const float*)(ws + WS_CS), (float*)(ws + WS_NRM)};
            pg8::gemm_phase<pg8::EpiIn, pg8::StaticOrder, PG8_ALIGN, PG8_SP2, PROBE_KDUP == 1, PROBE_EDUP == 1>(ldsl, g, S, E, wvs);
            if (!DEPH_ODD) pb_task(INP(1) + (size_t)L * M * PLE, (bf16*)(ws + WS_PB), vcu, tq);
        }
        SEAM(p0, false);
        for (int rep = 0; rep < NREP(2); ++rep) if (PON(2) && IN(p0 + 1)) {
            PH_BEGIN();
            for (int rp2 = 0; rp2 < NREP(13); ++rp2) { cumsum_task((const float*)(ws + WS_LF), (float*)(ws + WS_CB), (LAS float*)ldsl, vcu, tq);
            qknorm_task((const float*)(ws + WS_NRM), (unsigned*)(ws + WS_CTL) + CW_QK + L * 128, gw, NGW, lq); }
            __syncthreads();
            ret_group_state(ldsl, (const bf16*)(ws + WS_KK), (const bf16*)(ws + WS_VV), (float*)(ws + WS_U), vcu, tq);
        }
        SEAM(p0 + 1, false);
        if (PON(3) && IN(p0 + 2)) {
            PH_BEGIN();
#pragma unroll 1
            for (int rep = 0; rep < NREP(4); ++rep) {
            ret_group_out(ldsl, (const bf16*)(ws + WS_QO), (PROBE_DUP == 4 && rep == 0) ? (bf16*)args.out : (bf16*)(ws + WS_QO), (const bf16*)(ws + WS_KK), (const bf16*)(ws + WS_VV), (const bf16*)(ws + WS_G), (const float*)(ws + WS_U), vcu, tq);
            __syncthreads(); }
            for (int rep = 0; rep < NREP(3); ++rep) {
            const attn_body::AttnTensors AT{(const attn_body::bf16*)(ws + WS_QO), (const attn_body::bf16*)(ws + WS_KK), (const attn_body::bf16*)(ws + WS_VV), (PROBE_DUP == 3 && rep == 0) ? (attn_body::bf16*)args.out : (attn_body::bf16*)(ws + WS_QO)};
            const attn_body::StaticOrder S(G, bx);
            attn_body::attn_phase<attn_body::StaticOrder>((char*)lds, AT, (const float*)(ws + WS_CB), (const float*)(ws + WS_CTL) + CW_QK + L * 128, S, wvs);
            __syncthreads(); }
        }
        SEAM(p0 + 2, false);
        for (int rep = 0; rep < NREP(5); ++rep) if (PON(5) && IN(p0 + 4)) {
            PH_BEGIN(); const bool dmy = (PROBE_DUP == 5 && rep == 0);
            pg8::Gemm g{(const bf16*)(ws + WS_QO), (const bf16*)(ws + WS_W + (size_t)L * W_LAYER + WO_OUT), M, DM, DM}; pg8::StaticOrder S; S.init(M, DM, G, bx);
            pg8::EpiRes<0> E{(const bf16*)(ws + ((L == 0) ? WS_HB : WS_HBT)), (bf16*)(ws + (dmy ? WS_X + 384 * MiB : WS_HB)), dmy ? SSQB(3 * L) : SSQB(3 * L + 1), nullptr, nullptr};
            pg8::gemm_phase<pg8::EpiRes<0>, pg8::StaticOrder, PG8_ALIGN, PG8_SP2, PROBE_KDUP == 5, PROBE_EDUP == 5>(ldsl, g, S, E, wvs);
            { VM_WAIT(); __syncthreads();
              pg8::Gemm g2{(const bf16*)(ws + WS_PB), (const bf16*)(ws + WS_W + (size_t)L * W_LAYER + WO_PROJ), M, DM, PLE}; pg8::StaticOrder S2; S2.init(M, DM, G, bx);
              pg8::EpiScaleBf16<false> E2{PP_BASE, DM, nullptr};
              pg8::gemm_phase<pg8::EpiScaleBf16<false>, pg8::StaticOrder, PG8_ALIGN, PG8_SP2>(ldsl, g2, S2, E2, wvs); }
        }
        SEAM(p0 + 4, false);
        for (int rep = 0; rep < NREP(6); ++rep) if (PON(6) && IN(p0 + 5)) {
            PH_BEGIN();
            pg8::Gemm g{(const bf16*)(ws + WS_HB), (const bf16*)(ws + WS_W + (size_t)L * W_LAYER + WO_A), M, 2 * FF, DM}; pg8::StaticOrder S; S.init(M, 2 * FF, G, bx);
            pg8::EpiFfnUp E{(bf16*)(ws + WS_ACT), SSQB(3 * L + 1), INP(8) + (size_t)L * 3 * FF, INP(9) + (size_t)L * FF, (float*)(ws + WS_FIX), (float*)(ws + WS_HAL), (LAS float*)(ldsl + LDSCTL_OFF + 1024)};
            pg8::gemm_phase<pg8::EpiFfnUp, pg8::StaticOrder, true, PG8_SP2, PROBE_KDUP == 6, PROBE_EDUP == 6>(ldsl, g, S, E, wvs);
        }
        SEAM(p0 + 5, false);
        if (PON(8) && IN(p0 + 7)) {
            PH_BEGIN();
            pg8::Gemm g{(const bf16*)(ws + WS_ACT), (const bf16*)(ws + WS_W + (size_t)L * W_LAYER + WO_DOWN), M, DM, FF}; pg8::StaticOrder S; S.init(M, DM, G, bx, 1);
            ffn_fixup_own((const float*)(ws + WS_FIX), (const float*)(ws + WS_HAL), INP(8) + (size_t)L * 3 * FF, (bf16*)(ws + WS_ACT), S, tq);
            pg8::EpiRes<0> E{(const bf16*)(ws + WS_HB), (bf16*)(ws + WS_HB), SSQB(3 * L + 2), nullptr, nullptr};
            pg8::gemm_phase<pg8::EpiRes<0>, pg8::StaticOrder, PG8_ALIGN, PG8_SP2, PROBE_KDUP == 8, PROBE_EDUP == 8>(ldsl, g, S, E, wvs);
        }
        SEAM(p0 + 7, false);
        if (PON(9) && IN(p0 + 8) && L + 1 < DEPTH) { PH_BEGIN(); if DEPH_ODD { convert_layer(ws, zq, ldsl, L + 1, gw, NGW, wq, lq); __syncthreads(); } }
        for (int rep = 0; rep < NREP(9); ++rep) if (PON(9) && IN(p0 + 8)) {
            PH_BEGIN(); const bool dmy = (PROBE_DUP == 9 && rep == 0);
            pg8::Gemm g{(const bf16*)(ws + WS_HB), (const bf16*)(ws + WS_W + (size_t)L * W_LAYER + WO_GATE), M, DM, DM}; pg8::StaticOrder S; S.init(M, DM, G, bx);
            pg8::EpiRes<1> E{(const bf16*)(ws + WS_HB), (bf16*)(ws + (dmy ? WS_X + 384 * MiB : WS_HBT)), dmy ? (float*)(ws + WS_X + 512 * MiB) : SSQB(3 * L + 3), SSQB(3 * L + 2), PP_BASE};
            pg8::gemm_phase<pg8::EpiRes<1>, pg8::StaticOrder, PG8_ALIGN, PG8_SP2, PROBE_KDUP == 9, PROBE_EDUP == 9, true  >(ldsl, g, S, E, wvs);
        }
        if (PON(9) && IN(p0 + 8) && L + 1 < DEPTH) { PH_BEGIN(); if (!DEPH_ODD) { __syncthreads(); convert_layer(ws, zq, ldsl, L + 1, gw, NGW, wq, lq); __syncthreads(); } }
        SEAM(p0 + 8, L + 1 < DEPTH);
    }
    if (PON(10) && IN(NPH - 1)) { PH_BEGIN(); final_task((const bf16*)(ws + WS_HBT), args.out, SSQB(3 * DEPTH), INP(14), vcu, wq, lq); }
#undef IN
#undef SEAM
}

extern "C" void kernel_launch(void* const* d_in, const int* in_sizes, int n_in, void* d_out, int out_size, void* d_ws, size_t ws_size, hipStream_t stream) {
    static int grid = 0;
    if (grid == 0) {
        if (n_in != 15 || out_size != M * DM || ws_size < WS_END) { fprintf(stderr, "kernel_launch: unexpected sizes (n_in %d, out %d, ws %zu)\n", n_in, out_size, ws_size); grid = -1; return; }
        if (hipFuncSetAttribute((const void*)fwd, hipFuncAttributeMaxDynamicSharedMemorySize, LDS_BYTES) != hipSuccess) { fprintf(stderr, "kernel_launch: hipFuncSetAttribute failed\n"); grid = -1; return; }
        int dev = 0, cus = 0, per_cu = 0;
        (void)hipGetDevice(&dev); (void)hipDeviceGetAttribute(&cus, hipDeviceAttributeMultiprocessorCount, dev);
        if (hipOccupancyMaxActiveBlocksPerMultiprocessor(&per_cu, (const void*)fwd, NWAVES * 64, LDS_BYTES) != hipSuccess || per_cu < 1) fprintf(stderr, "kernel_launch: occupancy query says %d\n", per_cu);
        (void)hipGetLastError();
        grid = 256;
        if (cus != 256) fprintf(stderr, "kernel_launch: device has %d CUs; this kernel's unit maps are built for 256\n", cus);
    }
    if (grid < 0) return;
    (void)hipMemsetAsync((char*)d_ws + WS_CTL, 0, CTL_ZERO_BYTES, stream);
    Args a{};
    for (int i = 0; i < 15; ++i) a.in[i] = (const float*)d_in[i];
    a.out = (float*)d_out; a.ws = (unsigned char*)d_ws;
#if MK_ONE_LAUNCH
    a.ph_lo = 0; a.ph_hi = NPH;
    hipLaunchKernelGGL(fwd, dim3(grid), dim3(NWAVES * 64), LDS_BYTES, stream, a);
#else
    for (int ph = 0; ph < NPH; ++ph) { a.ph_lo = ph; a.ph_hi = ph + 1; hipLaunchKernelGGL(fwd, dim3(grid), dim3(NWAVES * 64), LDS_BYTES, stream, a); }
#endif
}
```

```cpp
#include <hip/hip_runtime.h>
#include <cstdio>
#include <cstdint>
__device__ __forceinline__ int tid_now(int wv) { unsigned m1 = ~0u; asm volatile("" : "+s"(m1)); return (wv << 6) | (int)__builtin_amdgcn_mbcnt_hi(m1, __builtin_amdgcn_mbcnt_lo(m1, 0u)); }
namespace pg8 {
#define PG8_LAS __attribute__((address_space(3)))
typedef unsigned short bf16_t;
typedef short bf16x8 __attribute__((ext_vector_type(8)));
typedef float f32x4 __attribute__((ext_vector_type(4)));
typedef unsigned u32x4 __attribute__((ext_vector_type(4)));
constexpr int BM = 256, BK = 64, HALF = 128, HTB = HALF * BK * 2  , STAGE_BYTES = 8 * HTB, NXCD = 8, WGM = 8;

__host__ __device__ __forceinline__ int lds_byte(int r, int c) { const int st = (r >> 4) * 2 + (c >> 5), rr = r & 15, cc = c & 31, ob = rr * 64 + cc * 2; return st * 1024 + (ob ^ (((ob >> 9) & 1) << 5)); }
__host__ __device__ __forceinline__ void stage_rc(int b, int& R, int& C) { const int st = b / 1024, sb = b % 1024, swz = sb ^ (((sb >> 9) & 1) << 5); R = (st >> 1) * 16 + swz / 64; C = (st & 1) * 32 + (swz % 64) / 2; }
__host__ __device__ __forceinline__ int perm32(int rho) { const int n = rho >> 4, i = rho & 15; return 8 * (i >> 2) + 4 * n + (i & 3); }

struct Unit { int pm, pn; };
struct Gemm { const bf16_t* A; const bf16_t* Bt; int M, N, K; };

struct StaticOrder {
    int nM, nN, nwg, G, c, rev;
    __host__ __device__ void init(int M, int N, int G_, int c_, int rev_ = 0) { nM = M / BM; nN = N / BM; nwg = nM * nN; G = G_; c = c_; rev = rev_; }
    __host__ __device__ bool next(int i, Unit& u) const {
        const int nr = (nwg + G - 1) / G; if (i >= nr) return false;
        const long L = (long)(rev ? nr - 1 - i : i) * G + c; if (L >= nwg) return false;
        int wgid = (int)L; { const int q = nwg / NXCD, r = nwg % NXCD, xcd = wgid % NXCD, off = wgid / NXCD; wgid = (xcd < r ? xcd * (q + 1) : r * (q + 1) + (xcd - r) * q) + off; }
        const int nig = WGM * nN, gid = wgid / nig, fm = gid * WGM, gsz = (nM - fm) < WGM ? (nM - fm) : WGM;
        u.pm = fm + ((wgid % nig) % gsz); u.pn = (wgid % nig) / gsz; return true;
    }
    __device__ __forceinline__ void a_ready(const Unit&) const {}
    __device__ __forceinline__ void done(const Unit&) const {}
};

__device__ __forceinline__ unsigned cvt_pk_bf16(float lo, float hi) { unsigned r; asm volatile("v_cvt_pk_bf16_f32 %0, %1, %2" : "=v"(r) : "v"(lo), "v"(hi)); return r; }
typedef float f32x2 __attribute__((ext_vector_type(2)));
__device__ __forceinline__ f32x2 gelu_pk(f32x2 v) {
    f32x2 vc; vc.x = __builtin_amdgcn_fmed3f(v.x, -5.656854249f, 5.656854249f); vc.y = __builtin_amdgcn_fmed3f(v.y, -5.656854249f, 5.656854249f);
    const f32x2 v2 = vc * vc;
    f32x2 p = v2 * (-1.505995060e-12f) + 3.061199413e-10f; p = p * v2 + (-4.642651039e-08f); p = p * v2 + (-2.515756171e-06f); p = p * v2 + (-6.496460735e-05f); p = p * v2 + (-5.223043901e-04f); p = p * v2 + (-5.690807158e-03f);
    f32x2 q = v2 * (-9.103794904e-07f) + (-2.667175691e-05f); q = q * v2 + (-4.207067436e-04f); q = q * v2 + (-3.686664584e-03f); q = q * v2 + (-1.426473905e-02f);
    f32x2 r; r.x = __builtin_amdgcn_rcpf(q.x); r.y = __builtin_amdgcn_rcpf(q.y);
    const f32x2 t = (vc * p) * r + 0.5f;
    return v * t;
}

template <int ACT  > struct EpiBf16 {
    static constexpr bool PERM = true, AFTER_DRAIN = false; static_assert(ACT == 0 || ACT == 1, "EpiBf16: ACT is 0 (none) or 1 (gelu_pk)");
    bf16_t* O; int ldc; const float* bias; int split_cols; size_t split_stride; float scale0;
    __device__ __forceinline__ void operator()(const f32x4 (&acc)[2][2][4][2], const Unit& u, int wr, int wc, int fr, int fq) const {
        const int row0 = u.pm * BM + wr * 64 + fr; int colt = u.pn * BM; bf16_t* base = O;
        float sc = 1.f; if (split_cols) { const int t = colt / split_cols; base += (size_t)t * split_stride; colt -= t * split_cols; if (t == 0) sc = scale0; }
        const int col0 = colt + wc * 32 + 8 * fq, bcol0 = u.pn * BM + wc * 32 + 8 * fq;
        f32x4 bv[2][2];
#pragma unroll
        for (int bj = 0; bj < 2; ++bj)
#pragma unroll
            for (int n = 0; n < 2; ++n) bv[bj][n] = bias ? *(const f32x4*)(bias + bcol0 + bj * HALF + 4 * n) : (f32x4){0.f, 0.f, 0.f, 0.f};
#pragma unroll
        for (int ai = 0; ai < 2; ++ai)
#pragma unroll
            for (int m = 0; m < 4; ++m) { bf16_t* rowp = base + (size_t)(row0 + ai * HALF + m * 16) * ldc + col0;
#pragma unroll
                for (int bj = 0; bj < 2; ++bj) { f32x4 v0 = acc[ai][bj][m][0] + bv[bj][0], v1 = acc[ai][bj][m][1] + bv[bj][1];
                    if (ACT == 1) { f32x2 a = gelu_pk((f32x2){v0[0], v0[1]}), b = gelu_pk((f32x2){v0[2], v0[3]}), c = gelu_pk((f32x2){v1[0], v1[1]}), d = gelu_pk((f32x2){v1[2], v1[3]});
                        v0 = (f32x4){a.x, a.y, b.x, b.y}; v1 = (f32x4){c.x, c.y, d.x, d.y}; }
                    v0 = v0 * sc; v1 = v1 * sc; u32x4 w; w.x = cvt_pk_bf16(v0[0], v0[1]); w.y = cvt_pk_bf16(v0[2], v0[3]); w.z = cvt_pk_bf16(v1[0], v1[1]); w.w = cvt_pk_bf16(v1[2], v1[3]);
                    *(u32x4*)(rowp + bj * HALF) = w; } }
    }
};
constexpr float ATT_C2 = 0.125f * 1.4426950408889634f;
constexpr float RMS_EPS = 1e-6f;
__device__ __forceinline__ float lg2gamma(int h) { const float x = __builtin_amdgcn_exp2f(-5.0f - (float)h);
    return -x * (1.0f + x * (0.5f + x * (0.33333334f + x * (0.25f + x * (0.2f + x * 0.16666667f))))) * 1.4426950408889634f; }
__device__ __forceinline__ float xor16f(float v) { return __int_as_float(__builtin_amdgcn_ds_swizzle(__float_as_int(v), 0x401F)); }
__device__ __forceinline__ float halves_sum(float v) { const auto rr = __builtin_amdgcn_permlane32_swap(__float_as_uint(v), __float_as_uint(v), false, false); return __uint_as_float(rr[0]) + __uint_as_float(rr[1]); }
__device__ __forceinline__ float row_rstd(const float* ssq16, int row) {
    const f32x4* p = (const f32x4*)(ssq16 + (size_t)row * 16);
    const f32x4 a = p[0], b = p[1], c = p[2], d = p[3];
    const float s = (((a[0] + a[1]) + (a[2] + a[3])) + ((b[0] + b[1]) + (b[2] + b[3]))) + (((c[0] + c[1]) + (c[2] + c[3])) + ((d[0] + d[1]) + (d[2] + d[3])));
    return __builtin_amdgcn_rsqf(s * (1.0f / 1024.0f) + RMS_EPS);
}
__device__ __forceinline__ float row_rstd4(const float* ssq16, int row, int fq) {
    const f32x4 a = *(const f32x4*)(ssq16 + (unsigned)(row * 16 + 4 * fq));
    float s = (a[0] + a[1]) + (a[2] + a[3]); s += xor16f(s); s = halves_sum(s);
    return __builtin_amdgcn_rsqf(s * (1.0f / 1024.0f) + RMS_EPS);
}
__device__ __forceinline__ u32x4 pack8(const f32x4& v0, const f32x4& v1) { u32x4 w; w.x = cvt_pk_bf16(v0[0], v0[1]); w.y = cvt_pk_bf16(v0[2], v0[3]); w.z = cvt_pk_bf16(v1[0], v1[1]); w.w = cvt_pk_bf16(v1[2], v1[3]); return w; }
__device__ __forceinline__ float bf_lo(unsigned w) { return __uint_as_float(w << 16); }
__device__ __forceinline__ float bf_hi(unsigned w) { return __uint_as_float(w & 0xffff0000u); }
__device__ __forceinline__ void unpack8(const u32x4& w, f32x4& v0, f32x4& v1) { v0 = (f32x4){bf_lo(w.x), bf_hi(w.x), bf_lo(w.y), bf_hi(w.y)}; v1 = (f32x4){bf_lo(w.z), bf_hi(w.z), bf_lo(w.w), bf_hi(w.w)}; }
__device__ __forceinline__ float sigmoidf_(float x) { return __builtin_amdgcn_rcpf(1.0f + __expf(-x)); }

struct EpiIn {
    static constexpr bool PERM = true, AFTER_DRAIN = false;
    bf16_t *QO, *KK, *VV, *G; const float* ssq; const float* cs; float* nrm;
    template <int TYPE> __device__ __forceinline__ void run(const f32x4 (&acc)[2][2][4][2], const Unit& u, int wr, int wc, int fr, int fq) const {
        const int half = u.pn & 1, row0 = u.pm * BM + wr * 64 + fr, csub0 = half * 256 + wc * 32 + 8 * fq, jj = 4 * (wc & 1) + fq;
        float lgv[2] = {0.f, 0.f};
        if (TYPE == 3 || TYPE == 4) { lgv[0] = lg2gamma(csub0 >> 6); lgv[1] = lg2gamma((csub0 + 128) >> 6); }
        float rsa[2][4]; f32x4 cva[2][4], sva[2][4];
#pragma unroll
        for (int ai = 0; ai < 2; ++ai)
#pragma unroll
            for (int m = 0; m < 4; ++m) { const int row = row0 + ai * HALF + m * 16; rsa[ai][m] = row_rstd4(ssq, row, fq);
                if (TYPE == 3 || TYPE == 4) { const int pos = row & 8191; cva[ai][m] = *(const f32x4*)(cs + pos * 32 + 4 * jj); sva[ai][m] = *(const f32x4*)(cs + 8192 * 32 + pos * 32 + 4 * jj); } }
#pragma unroll
        for (int ai = 0; ai < 2; ++ai)
#pragma unroll
            for (int m = 0; m < 4; ++m) {
                const int row = row0 + ai * HALF + m * 16; const float rs = rsa[ai][m];
                f32x4 cv = (f32x4){0.f, 0.f, 0.f, 0.f}, sv = cv; float i1 = 0.f;
                if (TYPE == 3 || TYPE == 4) { cv = cva[ai][m]; sv = sva[ai][m]; i1 = (float)((row & 127) + 1); }
#pragma unroll
                for (int bj = 0; bj < 2; ++bj) {
                    f32x4 v0 = acc[ai][bj][m][0] * rs, v1 = acc[ai][bj][m][1] * rs;
                    const int csub = csub0 + bj * 128; bf16_t* dst;
                    if (TYPE == 0) { v0 = v0 * ATT_C2; v1 = v1 * ATT_C2; dst = QO + (unsigned)(row * 1024 + csub); }
                    else if (TYPE == 1) dst = KK + (unsigned)(row * 1024 + csub);
                    if (TYPE == 0 || TYPE == 1) { float s = ((v0[0] * v0[0] + v0[1] * v0[1]) + (v0[2] * v0[2] + v0[3] * v0[3])) + ((v1[0] * v1[0] + v1[1] * v1[1]) + (v1[2] * v1[2] + v1[3] * v1[3]));
                        s += xor16f(s); s = halves_sum(s); if (fq == 0) nrm[(unsigned)(TYPE * (65536 * 16) + row * 16 + (csub >> 6) * 2 + (wc & 1))] = s; }
                    else if (TYPE == 2) dst = VV + (unsigned)(row * 1024 + csub);
                    else if (TYPE == 3 || TYPE == 4) {
                        const f32x4 o0 = v0 * cv - v1 * sv, o1 = v0 * sv + v1 * cv;
                        const float lg = lgv[bj];
                        const float f = (TYPE == 3) ? __builtin_amdgcn_exp2f(i1 * lg) : 0.125f * __builtin_amdgcn_exp2f(-i1 * lg);
                        v0 = o0 * f; v1 = o1 * f; dst = (TYPE == 3 ? QO : KK) + (unsigned)(row * 1024 + 512 + csub);
                    }
                    else if (TYPE == 5) dst = VV + (unsigned)(row * 1024 + 512 + csub);
                    else {
#pragma unroll
                        for (int i = 0; i < 4; ++i) { v0[i] = v0[i] * sigmoidf_(v0[i]); v1[i] = v1[i] * sigmoidf_(v1[i]); }
                        dst = G + (unsigned)(row * 512 + csub);
                    }
                    *(u32x4*)dst = pack8(v0, v1);
                }
            }
    }
    __device__ __forceinline__ void operator()(const f32x4 (&acc)[2][2][4][2], const Unit& u, int wr, int wc, int fr, int fq) const {
        switch (u.pn >> 1) { case 0: run<0>(acc, u, wr, wc, fr, fq); break; case 1: run<1>(acc, u, wr, wc, fr, fq); break; case 2: run<2>(acc, u, wr, wc, fr, fq); break; case 3: run<3>(acc, u, wr, wc, fr, fq); break;
            case 4: run<4>(acc, u, wr, wc, fr, fq); break; case 5: run<5>(acc, u, wr, wc, fr, fq); break; default: run<6>(acc, u, wr, wc, fr, fq); break; }
    }
};

template <int MODE> struct EpiRes {
    static constexpr bool PERM = true, AFTER_DRAIN = false;
    const bf16_t* hin; bf16_t* hout; float* ssqw; const float* ssqr; const bf16_t* pp;
    __device__ __forceinline__ void operator()(const f32x4 (&acc)[2][2][4][2], const Unit& u, int wr, int wc, int fr, int fq) const {
        const int row0 = u.pm * BM + wr * 64 + fr, col0 = u.pn * BM + wc * 32 + 8 * fq;
#define ER_OFF(ai, m, bj) ((unsigned)((row0 + (ai) * HALF + (m) * 16) * 1024 + col0 + (bj) * HALF))
#define ER_DO(ai, m, HV, PV, RS) do { float sq = 0.f; \
            _Pragma("unroll") for (int bj = 0; bj < 2; ++bj) { f32x4 h0, h1; unpack8(HV[bj], h0, h1); f32x4 a0 = acc[ai][bj][m][0], a1 = acc[ai][bj][m][1]; \
                if (MODE == 1) { f32x4 p0, p1; unpack8(PV[bj], p0, p1); _Pragma("unroll") for (int i = 0; i < 4; ++i) { a0[i] = sigmoidf_(a0[i] * (RS)) * p0[i]; a1[i] = sigmoidf_(a1[i] * (RS)) * p1[i]; } } \
                const f32x4 v0 = h0 + a0, v1 = h1 + a1; *(u32x4*)(hout + ER_OFF(ai, m, bj)) = pack8(v0, v1); \
                sq += ((v0[0] * v0[0] + v0[1] * v0[1]) + (v0[2] * v0[2] + v0[3] * v0[3])) + ((v1[0] * v1[0] + v1[1] * v1[1]) + (v1[2] * v1[2] + v1[3] * v1[3])); } \
            sq += xor16f(sq); sq = halves_sum(sq); if (fq == 0) ssqw[(unsigned)((row0 + (ai) * HALF + (m) * 16) * 16 + u.pn * 4 + wc)] = sq; } while (0)
        float rs[2][4];
#pragma unroll
        for (int ai = 0; ai < 2; ++ai)
#pragma unroll
            for (int m = 0; m < 4; ++m) rs[ai][m] = (MODE == 1) ? row_rstd4(ssqr, row0 + ai * HALF + m * 16, fq) : 1.f;
        constexpr int NS = (MODE == 1) ? 4 : 8;
        u32x4 hv[NS][2], pv[(MODE == 1) ? NS : 1][2];
#define ER_LD(g, s) do { _Pragma("unroll") for (int bj = 0; bj < 2; ++bj) { hv[s][bj] = *(const u32x4*)(hin + ER_OFF((g) >> 2, (g) & 3, bj)); if (MODE == 1) pv[s][bj] = *(const u32x4*)(pp + ER_OFF((g) >> 2, (g) & 3, bj)); } } while (0)
#define ER_B(g, s) ER_DO((g) >> 2, (g) & 3, hv[s], pv[(MODE == 1) ? (s) : 0], rs[(g) >> 2][(g) & 3])
#pragma unroll
        for (int g = 0; g < NS; ++g) ER_LD(g, g);
#pragma unroll
        for (int g = 0; g < 8; ++g) { ER_B(g, g % NS); if (g + NS < 8) ER_LD(g + NS, g % NS); }
#undef ER_LD
#undef ER_B
#undef ER_OFF
#undef ER_DO
    }
};

template <bool SCALE> struct EpiScaleBf16 {
    static constexpr bool PERM = true, AFTER_DRAIN = false;
    bf16_t* O; int ldo; const float* ssq;
    __device__ __forceinline__ void operator()(const f32x4 (&acc)[2][2][4][2], const Unit& u, int wr, int wc, int fr, int fq) const {
        const int row0 = u.pm * BM + wr * 64 + fr, col0 = u.pn * BM + wc * 32 + 8 * fq;
#pragma unroll
        for (int ai = 0; ai < 2; ++ai)
#pragma unroll
            for (int m = 0; m < 4; ++m) {
                const int row = row0 + ai * HALF + m * 16; const float rs = SCALE ? row_rstd4(ssq, row, fq) : 1.f;
#pragma unroll
                for (int bj = 0; bj < 2; ++bj) *(u32x4*)(O + (unsigned)(row * ldo + col0 + bj * HALF)) = pack8(acc[ai][bj][m][0] * rs, acc[ai][bj][m][1] * rs);
            }
    }
};

__device__ __forceinline__ unsigned dpp_sh1(unsigned prev, unsigned cur) {
    const unsigned t = (unsigned)__builtin_amdgcn_update_dpp(0, (int)prev, 0x121  , 0xF, 0xF, false);
    return (unsigned)__builtin_amdgcn_update_dpp((int)t, (int)cur, 0x111  , 0xF, 0xF, false); }
__device__ __forceinline__ unsigned dpp_sh2(unsigned prev, unsigned cur) {
    const unsigned t = (unsigned)__builtin_amdgcn_update_dpp(0, (int)prev, 0x122  , 0xF, 0xF, false);
    return (unsigned)__builtin_amdgcn_update_dpp((int)t, (int)cur, 0x112  , 0xF, 0xF, false); }
__device__ __forceinline__ float dppf_ror1(float v) { return __uint_as_float((unsigned)__builtin_amdgcn_mov_dpp((int)__float_as_uint(v), 0x121  , 0xF, 0xF, false)); }
__device__ __forceinline__ float dppf_ror2(float v) { return __uint_as_float((unsigned)__builtin_amdgcn_mov_dpp((int)__float_as_uint(v), 0x122  , 0xF, 0xF, false)); }
__device__ __forceinline__ float dppf_shr1_keep(float old, float cur) { return __uint_as_float((unsigned)__builtin_amdgcn_update_dpp((int)__float_as_uint(old), (int)__float_as_uint(cur), 0x111  , 0xF, 0xF, false)); }
__device__ __forceinline__ float dppf_shr2_keep(float old, float cur) { return __uint_as_float((unsigned)__builtin_amdgcn_update_dpp((int)__float_as_uint(old), (int)__float_as_uint(cur), 0x112  , 0xF, 0xF, false)); }
__device__ __forceinline__ float dppf_sh1(float prev, float cur) { return __uint_as_float(dpp_sh1(__float_as_uint(prev), __float_as_uint(cur))); }
__device__ __forceinline__ float dppf_sh2(float prev, float cur) { return __uint_as_float(dpp_sh2(__float_as_uint(prev), __float_as_uint(cur))); }
struct EpiFfnUp {
    static constexpr bool PERM = true, AFTER_DRAIN = false;
    bf16_t* O; const float* ssq; const float* cw; const float* cb; float* FIX; float* HAL; PG8_LAS float* xch;
    __device__ __forceinline__ void operator()(const f32x4 (&acc)[2][2][4][2], const Unit& u, int wr, int wc, int fr, int fq) const {
        constexpr int FF = 2816;
        const int grow = u.pm * BM + wr * 64, row0 = grow + fr, colL = wc * 32 + 8 * fq, col0 = u.pn * 128 + colL, unit = u.pm * 22 + u.pn;
        float rs[2][4];
#pragma unroll
        for (int ai = 0; ai < 2; ++ai)
#pragma unroll
            for (int m = 0; m < 4; ++m) rs[ai][m] = row_rstd4(ssq, row0 + ai * HALF + m * 16, fq);
        if (fr >= 14) {
#pragma unroll
            for (int ai = 0; ai < 2; ++ai) { const f32x4 v0 = acc[ai][0][3][0] * rs[ai][3], v1 = acc[ai][0][3][1] * rs[ai][3];
                PG8_LAS float* x = xch + ((((ai * 2 + wr) * 4 + wc) * 2 + (fr - 14)) * 4 + fq) * 8; *(PG8_LAS f32x4*)x = v0; *(PG8_LAS f32x4*)(x + 4) = v1;
                if (ai == 1 && wr == 1) { float* h = HAL + ((size_t)unit * 2 + (fr - 14)) * 128 + colL; *(f32x4*)h = v0; *(f32x4*)(h + 4) = v1; } }
        }
        asm volatile("s_waitcnt lgkmcnt(0)" ::: "memory"); __builtin_amdgcn_s_barrier(); asm volatile("" ::: "memory");
        const bool partial = (u.pm & 31) != 0;
#pragma unroll
        for (int n = 0; n < 2; ++n) {
            const int col = col0 + 4 * n;
            const f32x4 w0 = *(const f32x4*)(cw + col), w1 = *(const f32x4*)(cw + FF + col), w2 = *(const f32x4*)(cw + 2 * FF + col), bb = *(const f32x4*)(cb + col);
#pragma unroll
            for (int ai = 0; ai < 2; ++ai) {
                f32x4 prev = (f32x4){0.f, 0.f, 0.f, 0.f};
                if (!(ai == 0 && wr == 0) && fr >= 14) { const int pai = (ai == 1 && wr == 1) ? 1 : 0, pwr = wr ^ 1;
                    prev = *(const PG8_LAS f32x4*)(xch + ((((pai * 2 + pwr) * 4 + wc) * 2 + (fr - 14)) * 4 + fq) * 8 + 4 * n); }
                f32x4 r1, r2;
#pragma unroll
                for (int j = 0; j < 4; ++j) { r1[j] = dppf_ror1(prev[j]); r2[j] = dppf_ror2(prev[j]); }
#pragma unroll
                for (int m = 0; m < 4; ++m) {
                    const f32x4 cur = acc[ai][0][m][n] * rs[ai][m];
                    f32x4 s1, s2;
#pragma unroll
                    for (int j = 0; j < 4; ++j) { s1[j] = dppf_shr1_keep(r1[j], cur[j]); s2[j] = dppf_shr2_keep(r2[j], cur[j]); }
                    if (m < 3) {
#pragma unroll
                        for (int j = 0; j < 4; ++j) { r1[j] = dppf_ror1(cur[j]); r2[j] = dppf_ror2(cur[j]); } }
                    const f32x4 y0 = bb + w2 * cur + w1 * s1 + w0 * s2;
                    const f32x2 ga = gelu_pk((f32x2){y0[0], y0[1]}), gb = gelu_pk((f32x2){y0[2], y0[3]});
                    const f32x4 g0 = acc[ai][1][m][n] * rs[ai][m];
                    typedef unsigned u32x2_t __attribute__((ext_vector_type(2)));
                    const f32x2 pa = ga * (f32x2){g0[0], g0[1]}, pb = gb * (f32x2){g0[2], g0[3]};
                    u32x2_t ov; ov.x = cvt_pk_bf16(pa.x, pa.y); ov.y = cvt_pk_bf16(pb.x, pb.y);
                    *(u32x2_t*)(O + (unsigned)((row0 + ai * HALF + m * 16) * FF + col)) = ov;
                    if (ai == 0 && m == 0 && wr == 0 && partial && fr < 2) {
                        const f32x4 yp = (fr == 1) ? bb + w2 * cur + w1 * s1 : bb + w2 * cur;
                        float* fx = FIX + (((size_t)unit * 2 + fr) * 128 + colL + 4 * n) * 2;
                        *(f32x4*)fx = (f32x4){yp[0], g0[0], yp[1], g0[1]}; *(f32x4*)(fx + 4) = (f32x4){yp[2], g0[2], yp[3], g0[3]}; }
                }
            }
        }
    }
};
#ifndef PG8_DMA_IN_MMA
#define PG8_DMA_IN_MMA 1
#endif
#ifndef PROBE_KDUP
#define PROBE_KDUP 0
#endif
#define PG8_UI(i) (KDUP ? ((i) >> 1) : (i))
template <class Epi, class Sched, bool ALIGN_EPI = false, bool SP2 = false, bool KDUP = false, bool EDUP = false>
__device__ __forceinline__ void gemm_phase(PG8_LAS unsigned char* lds, const Gemm g, const Sched& S, const Epi& E, const int wv  ) {
    int tid = tid_now(wv); asm volatile("" : "+v"(tid));
    const int wid = __builtin_amdgcn_readfirstlane(tid >> 6), lane = tid & 63, wr = wid >> 2, wc = wid & 3, fr = lane & 15, fq = lane >> 4;
    const int K = g.K, nt = K / BK;
    unsigned voffA[2], voffB[2];
#pragma unroll
    for (int i = 0; i < 2; ++i) { int R, C; stage_rc(tid * 16 + i * 8192, R, C); const int Rb = Epi::PERM ? ((R & ~31) + perm32(R & 31)) : R;
        voffA[i] = (unsigned)(R * K + C) * 2u; voffB[i] = (unsigned)(Rb * K + C) * 2u; }
    const size_t kstep = (size_t)(BK * 2);
    const size_t hstep = (size_t)HALF * K * 2;
    const size_t tstep = 2 * hstep;
    const unsigned ldsw = (unsigned)wid * 1024u;
    const int aoff = lds_byte(wr * 64 + fr, fq * 8), boff = lds_byte(wc * 32 + fr, fq * 8);
#define PG8_SA(b, h) (((b) * 2 + (h)) * HTB)
#define PG8_SB(b, h) ((4 + (b) * 2 + (h)) * HTB)
#define PG8_STAGE(bufoff, gbase, voff) do { _Pragma("unroll") for (int _i = 0; _i < 2; ++_i) \
        __builtin_amdgcn_global_load_lds((const unsigned*)((const char*)(gbase) + (voff)[_i]), (PG8_LAS unsigned*)(lds + (bufoff) + ldsw + _i * 8192), 16, 0, 0); } while (0)
#define PG8_LDA(dst, b, h) do { _Pragma("unroll") for (int m = 0; m < 4; ++m) _Pragma("unroll") for (int k = 0; k < 2; ++k) dst[m][k] = *(const PG8_LAS bf16x8*)(lds + PG8_SA(b, h) + aoff + m * 2048 + k * 1024); } while (0)
#define PG8_LDB(dst, b, h) do { _Pragma("unroll") for (int n = 0; n < 2; ++n) _Pragma("unroll") for (int k = 0; k < 2; ++k) dst[n][k] = *(const PG8_LAS bf16x8*)(lds + PG8_SB(b, h) + boff + n * 2048 + k * 1024); } while (0)
#define PG8_MMA(ai, bj, At, Bt) do { __builtin_amdgcn_s_setprio(1); _Pragma("unroll") for (int m = 0; m < 4; ++m) _Pragma("unroll") for (int n = 0; n < 2; ++n) _Pragma("unroll") for (int k = 0; k < 2; ++k) \
        acc[ai][bj][m][n] = __builtin_amdgcn_mfma_f32_16x16x32_bf16(Bt[n][k], At[m][k], acc[ai][bj][m][n], 0, 0, 0); __builtin_amdgcn_s_setprio(0); } while (0)
#define PG8_MM(ai, bj, At, Bt) do { _Pragma("unroll") for (int m = 0; m < 4; ++m) _Pragma("unroll") for (int n = 0; n < 2; ++n) _Pragma("unroll") for (int k = 0; k < 2; ++k) \
        acc[ai][bj][m][n] = __builtin_amdgcn_mfma_f32_16x16x32_bf16(Bt[n][k], At[m][k], acc[ai][bj][m][n], 0, 0, 0); } while (0)
#define PG8_MIX(NP) do { _Pragma("unroll") for (int p_ = 0; p_ < (NP); ++p_) { __builtin_amdgcn_sched_group_barrier(0x008, 2, 0); __builtin_amdgcn_sched_group_barrier(0x002, 1, 0); \
        __builtin_amdgcn_sched_group_barrier(0x008, 2, 0); __builtin_amdgcn_sched_group_barrier(0x020, 1, 0); } __builtin_amdgcn_sched_group_barrier(0x008, 32 - 4 * (NP), 0); } while (0)
#define PG8_WAIT_V(n) asm volatile("s_waitcnt vmcnt(" #n ")" ::: "memory")
#define PG8_WAIT_L(n) asm volatile("s_waitcnt lgkmcnt(" #n ")" ::: "memory")
#define PG8_BAR __builtin_amdgcn_s_barrier()
#define PG8_SCHED __builtin_amdgcn_sched_barrier(0)
    Unit cur, nxt; int ui = 0;
    if (!S.next(PG8_UI(0), cur)) return;
    f32x4 acc[2][2][4][2];
#pragma unroll
    for (int a = 0; a < 2; ++a)
#pragma unroll
        for (int b = 0; b < 2; ++b)
#pragma unroll
            for (int m = 0; m < 4; ++m)
#pragma unroll
                for (int n = 0; n < 2; ++n) acc[a][b][m][n] = (f32x4){0.f, 0.f, 0.f, 0.f};
    bf16x8 At[4][2], B0[2][2], B1[2][2];
    const char* cA = (const char*)g.A + (size_t)cur.pm * tstep; const char* cB = (const char*)g.Bt + (size_t)cur.pn * tstep;
    S.a_ready(cur);
    if constexpr (SP2) {
        PG8_STAGE(PG8_SB(0, 0), cB, voffB); PG8_STAGE(PG8_SB(0, 1), cB + hstep, voffB); PG8_STAGE(PG8_SA(0, 0), cA, voffA); PG8_STAGE(PG8_SA(0, 1), cA + hstep, voffA);
        if (wr == 1) PG8_BAR;
        PG8_WAIT_V(2); PG8_BAR;
        PG8_STAGE(PG8_SB(1, 0), cB + kstep, voffB); PG8_STAGE(PG8_SA(1, 0), cA + kstep, voffA); PG8_STAGE(PG8_SB(1, 1), cB + hstep + kstep, voffB);
        PG8_WAIT_V(6); PG8_BAR;
    } else {
        PG8_STAGE(PG8_SB(0, 0), cB, voffB); PG8_STAGE(PG8_SA(0, 0), cA, voffA); PG8_STAGE(PG8_SB(0, 1), cB + hstep, voffB); PG8_STAGE(PG8_SA(0, 1), cA + hstep, voffA);
        if (wr == 1) PG8_BAR;
        PG8_WAIT_V(4); PG8_BAR;
        PG8_STAGE(PG8_SB(1, 0), cB + kstep, voffB); PG8_STAGE(PG8_SA(1, 0), cA + kstep, voffA); PG8_STAGE(PG8_SB(1, 1), cB + hstep + kstep, voffB);
        PG8_WAIT_V(6); PG8_BAR;
    }
    for (;;) {
        const bool has_next = S.next(PG8_UI(ui + 1), nxt);
        const bool firstpass = KDUP && !(ui & 1);
        const char* nA = has_next ? (const char*)g.A + (size_t)nxt.pm * tstep : cA; const char* nB = has_next ? (const char*)g.Bt + (size_t)nxt.pn * tstep : cB;
        for (int t = 0; t < nt; t += 2) {
            const bool last = (t == nt - 2);
            const char* a1 = cA + (size_t)(t + 1) * kstep;
            const char* a2 = last ? nA : cA + (size_t)(t + 2) * kstep; const char* b2 = last ? nB : cB + (size_t)(t + 2) * kstep;
            const char* a3 = a2 + kstep; const char* b3 = b2 + kstep;
            if (last && has_next) S.a_ready(nxt);
            if constexpr (SP2) {
#if PG8_DMA_IN_MMA
            PG8_LDB(B0, 0, 0); PG8_LDB(B1, 0, 1); PG8_SCHED; PG8_LDA(At, 0, 0);
            PG8_WAIT_V(6); PG8_WAIT_L(0); PG8_BAR; __builtin_amdgcn_s_setprio(1); PG8_SCHED; PG8_MM(0, 0, At, B0); PG8_STAGE(PG8_SA(1, 1), a1 + hstep, voffA); PG8_MM(0, 1, At, B1); PG8_MIX(2); PG8_SCHED; __builtin_amdgcn_s_setprio(0); PG8_BAR; PG8_SCHED;
            PG8_LDA(At, 0, 1);
            PG8_WAIT_V(2); PG8_WAIT_L(0); PG8_BAR; __builtin_amdgcn_s_setprio(1); PG8_SCHED; PG8_MM(1, 0, At, B0); PG8_STAGE(PG8_SB(0, 0), b2, voffB); PG8_STAGE(PG8_SB(0, 1), b2 + hstep, voffB); PG8_STAGE(PG8_SA(0, 0), a2, voffA); PG8_MM(1, 1, At, B1); PG8_MIX(6); PG8_SCHED; __builtin_amdgcn_s_setprio(0); PG8_BAR; PG8_SCHED;
            PG8_LDB(B0, 1, 0); PG8_LDB(B1, 1, 1); PG8_SCHED; PG8_LDA(At, 1, 0);
            PG8_WAIT_V(6); PG8_WAIT_L(0); PG8_BAR; __builtin_amdgcn_s_setprio(1); PG8_SCHED; PG8_MM(0, 0, At, B0); PG8_STAGE(PG8_SA(0, 1), a2 + hstep, voffA); PG8_MM(0, 1, At, B1); PG8_MIX(2); PG8_SCHED; __builtin_amdgcn_s_setprio(0); PG8_BAR; PG8_SCHED;
            PG8_LDA(At, 1, 1);
            PG8_WAIT_V(2); PG8_WAIT_L(0); PG8_BAR; __builtin_amdgcn_s_setprio(1); PG8_SCHED; PG8_MM(1, 0, At, B0); PG8_STAGE(PG8_SB(1, 0), b3, voffB); PG8_STAGE(PG8_SB(1, 1), b3 + hstep, voffB); PG8_STAGE(PG8_SA(1, 0), a3, voffA); PG8_MM(1, 1, At, B1); PG8_MIX(6); PG8_SCHED; __builtin_amdgcn_s_setprio(0); PG8_BAR; PG8_SCHED;
#else
            PG8_LDB(B0, 0, 0); PG8_LDB(B1, 0, 1); PG8_SCHED; PG8_LDA(At, 0, 0); PG8_STAGE(PG8_SA(1, 1), a1 + hstep, voffA);
            PG8_WAIT_V(8); PG8_WAIT_L(0); PG8_BAR; PG8_MMA(0, 0, At, B0); PG8_MMA(0, 1, At, B1); PG8_BAR; PG8_SCHED;
            PG8_LDA(At, 0, 1); PG8_STAGE(PG8_SB(0, 0), b2, voffB); PG8_STAGE(PG8_SB(0, 1), b2 + hstep, voffB); PG8_STAGE(PG8_SA(0, 0), a2, voffA);
            PG8_WAIT_V(8); PG8_WAIT_L(0); PG8_BAR; PG8_MMA(1, 0, At, B0); PG8_MMA(1, 1, At, B1); PG8_BAR; PG8_SCHED;
            PG8_LDB(B0, 1, 0); PG8_LDB(B1, 1, 1); PG8_SCHED; PG8_LDA(At, 1, 0); PG8_STAGE(PG8_SA(0, 1), a2 + hstep, voffA);
            PG8_WAIT_V(8); PG8_WAIT_L(0); PG8_BAR; PG8_MMA(0, 0, At, B0); PG8_MMA(0, 1, At, B1); PG8_BAR; PG8_SCHED;
            PG8_LDA(At, 1, 1); PG8_STAGE(PG8_SB(1, 0), b3, voffB); PG8_STAGE(PG8_SB(1, 1), b3 + hstep, voffB); PG8_STAGE(PG8_SA(1, 0), a3, voffA);
            PG8_WAIT_V(8); PG8_WAIT_L(0); PG8_BAR; PG8_MMA(1, 0, At, B0); PG8_MMA(1, 1, At, B1); PG8_BAR; PG8_SCHED;
#endif
            } else {
            PG8_LDB(B0, 0, 0); PG8_SCHED; PG8_LDA(At, 0, 0); PG8_STAGE(PG8_SA(1, 1), a1 + hstep, voffA);
            PG8_WAIT_L(8); PG8_BAR; PG8_WAIT_L(0); PG8_MMA(0, 0, At, B0); PG8_BAR; PG8_SCHED;
            PG8_LDB(B1, 0, 1); PG8_STAGE(PG8_SB(0, 0), b2, voffB);
            PG8_BAR; PG8_WAIT_L(0); PG8_MMA(0, 1, At, B1); PG8_BAR;
            PG8_LDA(At, 0, 1); PG8_STAGE(PG8_SA(0, 0), a2, voffA);
            PG8_BAR; PG8_WAIT_L(0); PG8_MMA(1, 0, At, B0); PG8_BAR; PG8_SCHED;
            PG8_STAGE(PG8_SB(0, 1), b2 + hstep, voffB);
            PG8_WAIT_V(6); PG8_BAR; PG8_MMA(1, 1, At, B1); PG8_BAR;
            PG8_LDB(B0, 1, 0); PG8_SCHED; PG8_LDA(At, 1, 0); PG8_STAGE(PG8_SA(0, 1), a2 + hstep, voffA);
            PG8_WAIT_L(8); PG8_BAR; PG8_WAIT_L(0); PG8_MMA(0, 0, At, B0); PG8_BAR; PG8_SCHED;
            PG8_LDB(B1, 1, 1); PG8_STAGE(PG8_SB(1, 0), b3, voffB);
            PG8_BAR; PG8_WAIT_L(0); PG8_MMA(0, 1, At, B1); PG8_BAR;
            PG8_LDA(At, 1, 1); PG8_STAGE(PG8_SA(1, 0), a3, voffA);
            PG8_BAR; PG8_WAIT_L(0); PG8_MMA(1, 0, At, B0); PG8_BAR; PG8_SCHED;
            PG8_STAGE(PG8_SB(1, 1), b3 + hstep, voffB);
            PG8_WAIT_V(6); PG8_BAR; PG8_MMA(1, 1, At, B1); PG8_BAR;
            }
        }
        if constexpr (ALIGN_EPI) { if (wr == 0) PG8_BAR; }
        if (KDUP && !firstpass) {
#pragma unroll
            for (int a = 0; a < 2; ++a)
#pragma unroll
                for (int b = 0; b < 2; ++b)
#pragma unroll
                    for (int m = 0; m < 4; ++m)
#pragma unroll
                        for (int n = 0; n < 2; ++n) acc[a][b][m][n] = acc[a][b][m][n] * 0.5f; }
        if constexpr (!Epi::AFTER_DRAIN) if (!firstpass) { int t2 = tid_now(wv); asm volatile("" : "+v"(t2));
            E(acc, cur, wr, wc, t2 & 15, (t2 & 63) >> 4); if (EDUP) { asm volatile("" : "+v"(t2)); E(acc, cur, wr, wc, t2 & 15, (t2 & 63) >> 4); } S.done(cur); }
        if (!has_next) break;
        if (!firstpass)
#pragma unroll
        for (int a = 0; a < 2; ++a)
#pragma unroll
            for (int b = 0; b < 2; ++b)
#pragma unroll
                for (int m = 0; m < 4; ++m)
#pragma unroll
                    for (int n = 0; n < 2; ++n) acc[a][b][m][n] = (f32x4){0.f, 0.f, 0.f, 0.f};
        cur = nxt; cA = nA; cB = nB; ++ui;
        if constexpr (ALIGN_EPI) { if (wr == 1) PG8_BAR; }
    }
    PG8_WAIT_V(0);
    if constexpr (!ALIGN_EPI) { if (wr == 0) PG8_BAR; }
    PG8_BAR;
    if constexpr (Epi::AFTER_DRAIN) { E.fused(acc, cur, wr, wc, fr, fq, lds, wid, lane); S.done(cur); }
#undef PG8_SA
#undef PG8_SB
#undef PG8_STAGE
#undef PG8_LDA
#undef PG8_LDB
#undef PG8_MMA
#undef PG8_MM
#undef PG8_MIX
#undef PG8_WAIT_V
#undef PG8_WAIT_L
#undef PG8_BAR
#undef PG8_SCHED
}
}

#ifndef PG8_SP2
#define PG8_SP2 true
#endif
#ifndef PG8_ALIGN
#define PG8_ALIGN true
#endif
#include <hip/hip_bf16.h>
#include <cmath>
namespace attn_body {
using bf16=__hip_bfloat16;
using bf16x8=__attribute__((ext_vector_type(8)))short;
using s16x4=__attribute__((ext_vector_type(4)))short;
using f32x16=__attribute__((ext_vector_type(16)))float;
using u32x4=__attribute__((ext_vector_type(4)))unsigned;
constexpr int BATCH=8,NHEAD=16,SEQ=8192,D=64,DM=NHEAD*D;
constexpr int NW=8,QBLK=32,QB=QBLK*NW,KVBLK=64,NQB=SEQ/QB;
constexpr int ATTN_PITCH=DM, ATTN_UNIT_ROWS=QB;
__device__ __forceinline__ int crow(int r,int hi){return (r&3)+8*(r>>2)+4*hi;}
#define SBAR() __builtin_amdgcn_sched_barrier(0)
__device__ __forceinline__ void cmask(f32x16&p0,f32x16&p1,int jb,int qrel,int hi){
  const float NEG=-INFINITY; int kb=64*jb+4*hi;
  #pragma unroll
  for(int r=0;r<16;++r){int kv=kb+(r&3)+8*(r>>2); if(kv>qrel)p0[r]=NEG; if(kv+32>qrel)p1[r]=NEG;}
}

constexpr int NSLOT=3, SLOTB=8192;
constexpr int LDS_K=0, LDS_V=NSLOT*SLOTB, LDS_WS=2*NSLOT*SLOTB, LDS_OST=LDS_WS+NW*64*4, LDS_T0=84992, LDS_CB=86016, LDS_BYTES=LDS_CB+SEQ*4;
constexpr float C2=0.125f*1.4426950408889634f;
__device__ __forceinline__ void glds16(const void*gsrc,unsigned lds_dst){unsigned keep;
  asm volatile("s_mov_b32 %0, m0\n\ts_mov_b32 m0, %2\n\ts_nop 0\n\tglobal_load_lds_dwordx4 %1, off\n\ts_mov_b32 m0, %0":"=&s"(keep):"v"(gsrc),"s"(lds_dst):"memory");}
__device__ __forceinline__ float max3f(float a,float b,float c){float r;asm("v_max3_f32 %0, %1, %2, %3":"=v"(r):"v"(a),"v"(b),"v"(c));return r;}
__device__ __forceinline__ float max2f(float a,float b){float r;asm("v_max_f32_e32 %0, %1, %2":"=v"(r):"v"(a),"v"(b));return r;}
__device__ __forceinline__ float fadd_s(float a,float b){float r;asm("v_add_f32_e32 %0, %1, %2":"=v"(r):"v"(a),"v"(b));return r;}
__device__ __forceinline__ float fsub_s(float a,float b){float r;asm("v_sub_f32_e32 %0, %1, %2":"=v"(r):"v"(a),"v"(b));return r;}
typedef float f32x2_t __attribute__((ext_vector_type(2))); typedef __bf16 bf16x2_t __attribute__((ext_vector_type(2)));
__device__ __forceinline__ unsigned cvtpk_s(float lo,float hi){f32x2_t v={lo,hi};bf16x2_t b=__builtin_convertvector(v,bf16x2_t);return __builtin_bit_cast(unsigned,b);}
#define WAIT_BAR(N) asm volatile("s_waitcnt vmcnt(" #N ") lgkmcnt(0)\n\ts_barrier":::"memory")

__device__ __forceinline__ void qkt(f32x16&p0,f32x16&p1,const char*Kslot,const bf16x8*qr,const f32x16&c0in,const f32x16&c1in,int r32,int hi){
  const char*kb=Kslot+hi*1024+r32*16;
  #pragma unroll
  for(int d0=0;d0<4;++d0){
    const bf16x8 b0=*reinterpret_cast<const bf16x8*>(kb+d0*2048);
    const bf16x8 b1=*reinterpret_cast<const bf16x8*>(kb+d0*2048+512);
    if(d0==0){p0=__builtin_amdgcn_mfma_f32_32x32x16_bf16(b0,qr[0],c0in,0,0,0);p1=__builtin_amdgcn_mfma_f32_32x32x16_bf16(b1,qr[0],c1in,0,0,0);}
    else{p0=__builtin_amdgcn_mfma_f32_32x32x16_bf16(b0,qr[d0],p0,0,0,0);p1=__builtin_amdgcn_mfma_f32_32x32x16_bf16(b1,qr[d0],p1,0,0,0);}}
}
typedef __attribute__((address_space(3))) const char* lds_cptr;
typedef short v4i16_t __attribute__((ext_vector_type(4)));
__device__ __forceinline__ void kload8(bf16x8*kf,lds_cptr kp){
  kf[0]=*(const __attribute__((address_space(3))) bf16x8*)(kp);      kf[1]=*(const __attribute__((address_space(3))) bf16x8*)(kp+512);
  kf[2]=*(const __attribute__((address_space(3))) bf16x8*)(kp+2048); kf[3]=*(const __attribute__((address_space(3))) bf16x8*)(kp+2560);
  kf[4]=*(const __attribute__((address_space(3))) bf16x8*)(kp+4096); kf[5]=*(const __attribute__((address_space(3))) bf16x8*)(kp+4608);
  kf[6]=*(const __attribute__((address_space(3))) bf16x8*)(kp+6144); kf[7]=*(const __attribute__((address_space(3))) bf16x8*)(kp+6656);
}
__device__ __forceinline__ void kload2(bf16x8*kf,lds_cptr kp,int j){ kf[2*j]=*(const __attribute__((address_space(3))) bf16x8*)(kp+j*2048); kf[2*j+1]=*(const __attribute__((address_space(3))) bf16x8*)(kp+j*2048+512); }
__device__ __forceinline__ s16x4 vtr(lds_cptr p){ return __builtin_bit_cast(s16x4,__builtin_amdgcn_ds_read_tr16_b64_v4i16((__attribute__((address_space(3))) v4i16_t*)p)); }
__device__ __forceinline__ float rowmax(const f32x16&p0,const f32x16&p1){
  float a=max3f(p0[0],p0[1],p1[0]),b=max3f(p0[2],p0[3],p1[1]);a=max3f(a,p1[2],p1[3]);
  #pragma unroll
  for(int r=4;r<16;r+=4){a=max3f(a,p0[r],p0[r+1]);b=max3f(b,p0[r+2],p0[r+3]);a=max3f(a,p1[r],p1[r+1]);b=max3f(b,p1[r+2],p1[r+3]);}
  const float m=max2f(a,b);
  auto rr=__builtin_amdgcn_permlane32_swap(__float_as_uint(m),__float_as_uint(m),false,false);
  return max2f(__uint_as_float(rr[0]),__uint_as_float(rr[1]));
}
__device__ __forceinline__ void pv(f32x16*o,int vb,bf16x8 pa0,bf16x8 pa1,bf16x8 pa2,bf16x8 pa3){
  #pragma unroll
  for(int d0=0;d0<2;++d0){s16x4 lo[4],hi[4];
    #pragma unroll
    for(int ks=0;ks<4;++ks){
      asm volatile("ds_read_b64_tr_b16 %0,%1 offset:%c2":"=&v"(lo[ks]):"v"(vb),"i"(d0*4096+ks*1024):"memory");
      asm volatile("ds_read_b64_tr_b16 %0,%1 offset:%c2":"=&v"(hi[ks]):"v"(vb),"i"(d0*4096+ks*1024+512):"memory");}
    asm volatile("s_waitcnt lgkmcnt(0)":::"memory");SBAR();
    #define PK(k) (bf16x8){lo[k][0],lo[k][1],lo[k][2],lo[k][3],hi[k][0],hi[k][1],hi[k][2],hi[k][3]}
    o[d0]=__builtin_amdgcn_mfma_f32_32x32x16_bf16(pa0,PK(0),o[d0],0,0,0);
    o[d0]=__builtin_amdgcn_mfma_f32_32x32x16_bf16(pa1,PK(1),o[d0],0,0,0);
    o[d0]=__builtin_amdgcn_mfma_f32_32x32x16_bf16(pa2,PK(2),o[d0],0,0,0);
    o[d0]=__builtin_amdgcn_mfma_f32_32x32x16_bf16(pa3,PK(3),o[d0],0,0,0);
    #undef PK
  }
}

#ifndef ATTN_STORE16
#define ATTN_STORE16(p,v) (*(u32x4*)(p)=(v))
#endif
__device__ __forceinline__ bf16x8 mkkx(float x,int hi){
  const unsigned b0=cvtpk_s(x,0.f)&0xffffu; const float r1=x-__uint_as_float(b0<<16);
  const unsigned b1=cvtpk_s(r1,0.f)&0xffffu; const float r2=r1-__uint_as_float(b1<<16);
  const unsigned b2=cvtpk_s(r2,0.f)&0xffffu;
  u32x4 w; w.x=hi?0u:(b0|(b1<<16)); w.y=hi?0u:(b2|0x3F800000u); w.z=hi?0u:0x3F803F80u; w.w=0u; return __builtin_bit_cast(bf16x8,w);
}
template<int THRL> __device__ __forceinline__ void attn_unit(int b,int h,int qb,int t0,const bf16*Q,const bf16*__restrict__ K,const bf16*__restrict__ V,bf16*O,const float*cbg,char*shm,const int wv){
  int tid=tid_now(wv); asm volatile("":"+v"(tid));
  const int lane=tid&63,r32=lane&31,hi=lane>>5; const int wid=__builtin_amdgcn_readfirstlane(tid>>6);
  const long rowbase=(long)b*SEQ; const int q0=qb*QB;
  const bf16*Qw=Q+(rowbase+q0+wid*QBLK)*DM+h*D;
  const bf16*Kh=K+(rowbase+(long)t0*KVBLK)*DM+h*D,*Vh=V+(rowbase+(long)t0*KVBLK)*DM+h*D;
  const unsigned lds0=(unsigned)(uintptr_t)shm;
  float*wsf=(float*)(shm+LDS_WS)+wid*64;
  const bf16*ksrc=Kh+(long)lane*DM+wid*8;
  const bf16*vsrc=Vh+(long)(16*(wid&3)+(lane>>2))*DM+(wid>>2)*32+(lane&3)*8;
  const unsigned kdst=lds0+LDS_K+wid*1024, vdst=lds0+LDS_V+wid*1024;
  #define DMA_K(t,slot) glds16(ksrc+(long)(t)*KVBLK*DM,(unsigned)__builtin_amdgcn_readfirstlane(kdst+(slot)))
  #define DMA_V(t,slot) glds16(vsrc+(long)(t)*KVBLK*DM,(unsigned)__builtin_amdgcn_readfirstlane(vdst+(slot)))
  const int vb0=(int)(lds0+LDS_V)+((lane>>4)&1)*32+(lane&3)*8+(4*hi+((lane&15)>>2))*64;
  const char*Kbase=shm+LDS_K; bf16x8 kf[8];
  const lds_cptr shm3=(lds_cptr)shm; const lds_cptr kp0=shm3+LDS_K+hi*1024+r32*16; const lds_cptr vp0=shm3+LDS_V+((lane>>4)&1)*32+(lane&3)*8+(4*hi+((lane&15)>>2))*64;
  const int NT=(q0+QB)/KVBLK-t0;
  const float*cbl=(const float*)(shm+LDS_CB);
  DMA_K(0,0);DMA_V(0,0);DMA_K(1,SLOTB);
  { const float*cg=cbg+t0*KVBLK; float*cl=(float*)(shm+LDS_CB); const int n=NT*KVBLK;
    for(int i=tid;i<n;i+=NW*64)cl[i]=cg[i]; }
  bf16x8 qr[4];
  #pragma unroll
  for(int d0=0;d0<4;++d0)qr[d0]=*reinterpret_cast<const bf16x8*>(&Qw[(long)r32*DM+d0*16+hi*8]);
  float mhat=0.f,l_reg=0.f;f32x16 o[2];o[0]=f32x16{};o[1]=f32x16{};const f32x16 z16=f32x16{};
  const int qrel=wid*QBLK+r32;
  #define CMASK(P0,P1,t) do{int jb_=(t)-(NT-4); if(jb_>=0)cmask(P0,P1,jb_,qrel,hi);}while(0)
  bool resc=false;
  bf16x8 qx;
  #define MKQX() do{ const float nm_=-mhat; const unsigned a0_=cvtpk_s(nm_,0.f)&0xffffu; const float q1_=nm_-__uint_as_float(a0_<<16); const unsigned a1_=cvtpk_s(q1_,0.f)&0xffffu; \
    const float q2_=q1_-__uint_as_float(a1_<<16); const unsigned a2_=cvtpk_s(q2_,0.f)&0xffffu; u32x4 w_; w_.x=hi?0u:0x3F803F80u; w_.y=hi?0u:(0x3F80u|(a0_<<16)); w_.z=hi?0u:(a1_|(a2_<<16)); w_.w=0u; qx=__builtin_bit_cast(bf16x8,w_); }while(0)
  MKQX();
  #define START(P0,P1) do{ const float rm=rowmax(P0,P1); resc=false; \
    { const float dl=rm; mhat=fadd_s(mhat,dl); \
      _Pragma("unroll") for(int r=0;r<16;++r){P0[r]=fsub_s(P0[r],dl);P1[r]=fsub_s(P1[r],dl);} \
      MKQX(); } \
    _Pragma("unroll") for(int r=0;r<16;++r)P0[r]=__builtin_amdgcn_exp2f(P0[r]); }while(0)
  #define RESC() do{ if(resc){ asm volatile("s_waitcnt lgkmcnt(0)":::"memory"); \
      _Pragma("unroll") for(int d_=0;d_<2;++d_) _Pragma("unroll") for(int r=0;r<16;++r)o[d_][r]*=wsf[crow(r,hi)]; } }while(0)
  f32x16 pA0,pA1,pB0,pB1;
  int sl_prev=0,sl_cur=0,sl_next=SLOTB;
  #define ROT() do{sl_prev=sl_cur;sl_cur=sl_next;sl_next=(sl_next==(NSLOT-1)*SLOTB)?0:sl_next+SLOTB;}while(0)
  DMA_K(2,2*SLOTB);
  WAIT_BAR(3);
  const float cref=cbl[q0-t0*KVBLK+wid*QBLK];
  #define KXB(X0,X1,t) do{ X0=mkkx(cref-cbl[(t)*KVBLK+r32],hi); X1=mkkx(cref-cbl[(t)*KVBLK+32+r32],hi); }while(0)
  bf16x8 kx0,kx1; KXB(kx0,kx1,0);
  { const f32x16 i0=__builtin_amdgcn_mfma_f32_32x32x16_bf16(kx0,qx,z16,0,0,0), i1=__builtin_amdgcn_mfma_f32_32x32x16_bf16(kx1,qx,z16,0,0,0);
    qkt(pA0,pA1,Kbase,qr,i0,i1,r32,hi); }
  asm volatile("s_nop 15\n\ts_nop 7":"+v"(pA0),"+v"(pA1));CMASK(pA0,pA1,0);
  START(pA0,pA1);
  _Pragma("unroll") for(int r=0;r<16;++r)pA1[r]=__builtin_amdgcn_exp2f(pA1[r]);
  WAIT_BAR(0);
  DMA_K(3,0);DMA_V(1,SLOTB);
  ROT();
  kload8(kf,kp0+sl_cur);
  WAIT_BAR(2);
  s16x4 vlo[8],vhi[8]; u32x4 pw0,pw1,pw2,pw3;
  #define PKW(P,B) cvtpk_s(P[B],P[B+1])
  #define PAF(k) __builtin_bit_cast(bf16x8,pw##k)
  #define VFR(i) (bf16x8){vlo[i][0],vlo[i][1],vlo[i][2],vlo[i][3],vhi[i][0],vhi[i][1],vhi[i][2],vhi[i][3]}
  #define PIN(x) asm volatile("":"+v"(x))
  #define MX3(a,b,c) __builtin_fmaxf(__builtin_fmaxf((a),(b)),(c))
  #define GAPA(MF,A0,A1,A2,A3,W0,W1,PW) do{ MF; sacc+=A0; sacc+=A1; sacc+=A2; sacc+=A3; PIN(sacc); W0; W1; PIN(PW); SBAR(); }while(0)
  #define EX(v) __builtin_amdgcn_exp2f(v)
  #define GAPB(MF,X,B) do{ MF; X[B]=EX(X[B]); X[B+1]=EX(X[B+1]); X[B+2]=EX(X[B+2]); X[B+3]=EX(X[B+3]); PIN(X); SBAR(); }while(0)
  #define VRD(i) do{ vlo[i]=vtr(vp_+(((i)>>2)*4096+((i)&3)*1024)); vhi[i]=vtr(vp_+(((i)>>2)*4096+((i)&3)*1024+512)); }while(0)
  #define KRD(G,j) do{ if(G){ kload2(kf,kp0+sl_next,j); SBAR(); } }while(0)
  #define STEP(C0,C1,P0,P1,t,GK,GV,GL) do{ KXB(kx0,kx1,t); SBAR(); \
    C0=__builtin_amdgcn_mfma_f32_32x32x16_bf16(kx0,qx,z16,0,0,0); C1=__builtin_amdgcn_mfma_f32_32x32x16_bf16(kx1,qx,z16,0,0,0); SBAR(); \
    const lds_cptr vp_=vp0+sl_prev; \
    VRD(0); SBAR(); float sacc=(P0[0]+P0[1]); \
    GAPA(C0=__builtin_amdgcn_mfma_f32_32x32x16_bf16(kf[0],qr[0],C0,0,0,0), P0[2],P0[3],P0[4],P0[5],     pw0[0]=PKW(P0,0), pw0[1]=PKW(P0,2), pw0); \
    VRD(4); SBAR(); GAPA(C1=__builtin_amdgcn_mfma_f32_32x32x16_bf16(kf[1],qr[0],C1,0,0,0), P0[6],P0[7],P0[8],P0[9],     pw0[2]=PKW(P0,4), pw0[3]=PKW(P0,6), pw0); \
    VRD(1); SBAR(); GAPA(C0=__builtin_amdgcn_mfma_f32_32x32x16_bf16(kf[2],qr[1],C0,0,0,0),   P0[10],P0[11],P0[12],P0[13], pw1[0]=PKW(P0,8), pw1[1]=PKW(P0,10), pw1); \
    VRD(5); SBAR(); GAPA(C1=__builtin_amdgcn_mfma_f32_32x32x16_bf16(kf[3],qr[1],C1,0,0,0),   P0[14],P0[15],P1[0],P1[1],   pw1[2]=PKW(P0,12),pw1[3]=PKW(P0,14), pw1); \
    VRD(2); SBAR(); GAPA(C0=__builtin_amdgcn_mfma_f32_32x32x16_bf16(kf[4],qr[2],C0,0,0,0),   P1[2],P1[3],P1[4],P1[5],     pw2[0]=PKW(P1,0), pw2[1]=PKW(P1,2), pw2); \
    VRD(6); SBAR(); GAPA(C1=__builtin_amdgcn_mfma_f32_32x32x16_bf16(kf[5],qr[2],C1,0,0,0),   P1[6],P1[7],P1[8],P1[9],     pw2[2]=PKW(P1,4), pw2[3]=PKW(P1,6), pw2); \
    VRD(3); SBAR(); GAPA(C0=__builtin_amdgcn_mfma_f32_32x32x16_bf16(kf[6],qr[3],C0,0,0,0),   P1[10],P1[11],P1[12],P1[13], pw3[0]=PKW(P1,8), pw3[1]=PKW(P1,10), pw3); \
    VRD(7); SBAR(); GAPA(C1=__builtin_amdgcn_mfma_f32_32x32x16_bf16(kf[7],qr[3],C1,0,0,0),   P1[14],P1[15],0.f,0.f,       pw3[2]=PKW(P1,12),pw3[3]=PKW(P1,14), pw3); \
    l_reg+=sacc; \
    if(GK){DMA_K((t)+3,sl_cur);} if(GV){DMA_V((t)+1,sl_next);} \
    CMASK(C0,C1,t); \
    { float a=MX3(C0[0],C0[1],C1[0]),b=MX3(C0[2],C0[3],C1[1]); a=MX3(a,C1[2],C1[3]); \
      _Pragma("unroll") for(int r=4;r<16;r+=4){a=MX3(a,C0[r],C0[r+1]);b=MX3(b,C0[r+2],C0[r+3]);a=MX3(a,C1[r],C1[r+1]);b=MX3(b,C1[r+2],C1[r+3]);} \
      float rm=__builtin_fmaxf(a,b); { auto rr=__builtin_amdgcn_permlane32_swap(__float_as_uint(rm),__float_as_uint(rm),false,false); rm=__builtin_fmaxf(__uint_as_float(rr[0]),__uint_as_float(rr[1])); } \
      resc=false; \
      if(__builtin_expect(__any(rm>(float)THRL),0)){ const float dl=__builtin_fmaxf(rm,0.f); mhat+=dl; \
        _Pragma("unroll") for(int r=0;r<16;++r){C0[r]-=dl;C1[r]-=dl;} \
        MKQX(); \
        const float f=__builtin_amdgcn_exp2f(-dl); l_reg*=f; if(hi==0)wsf[r32]=f; resc=true; } } \
    SBAR(); \
    GAPB(o[0]=__builtin_amdgcn_mfma_f32_32x32x16_bf16(PAF(0),VFR(0),o[0],0,0,0), C0,0); \
    GAPB(o[1]=__builtin_amdgcn_mfma_f32_32x32x16_bf16(PAF(0),VFR(4),o[1],0,0,0), C0,4); \
    KRD(GL,0); GAPB(o[0]=__builtin_amdgcn_mfma_f32_32x32x16_bf16(PAF(1),VFR(1),o[0],0,0,0), C0,8); \
    KRD(GL,1); GAPB(o[1]=__builtin_amdgcn_mfma_f32_32x32x16_bf16(PAF(1),VFR(5),o[1],0,0,0), C0,12); \
    KRD(GL,2); GAPB(o[0]=__builtin_amdgcn_mfma_f32_32x32x16_bf16(PAF(2),VFR(2),o[0],0,0,0), C1,0); \
    KRD(GL,3); GAPB(o[1]=__builtin_amdgcn_mfma_f32_32x32x16_bf16(PAF(2),VFR(6),o[1],0,0,0), C1,4); \
    GAPB(o[0]=__builtin_amdgcn_mfma_f32_32x32x16_bf16(PAF(3),VFR(3),o[0],0,0,0), C1,8); \
    GAPB(o[1]=__builtin_amdgcn_mfma_f32_32x32x16_bf16(PAF(3),VFR(7),o[1],0,0,0), C1,12); \
    }while(0)
  int t=1;
  #undef CMASK
  #define CMASK(P0,P1,t) do{}while(0)
  for(;t+5<NT;t+=2){
    STEP(pB0,pB1,pA0,pA1,t,true,true,true);     WAIT_BAR(2); RESC(); ROT();
    STEP(pA0,pA1,pB0,pB1,t+1,true,true,true);   WAIT_BAR(2); RESC(); ROT();
  }
  #undef CMASK
  #define CMASK(P0,P1,t) do{int jb_=(t)-(NT-4); if(jb_>=0)cmask(P0,P1,jb_,qrel,hi);}while(0)
  #define ENDW(tt) do{ if((tt)+3<NT){WAIT_BAR(2);} else if((tt)+2<NT){WAIT_BAR(1);} else {WAIT_BAR(0);} }while(0)
  for(;t+1<NT;t+=2){
    STEP(pB0,pB1,pA0,pA1,t,(t+3<NT),(t+1<NT),(t+1<NT));       ENDW(t);   RESC(); ROT();
    STEP(pA0,pA1,pB0,pB1,t+1,(t+4<NT),(t+2<NT),(t+2<NT));     ENDW(t+1); RESC(); ROT();
  }
  STEP(pB0,pB1,pA0,pA1,NT-1,false,false,false); RESC();
  { float sacc=pB0[0]+pB0[1]; _Pragma("unroll") for(int r=2;r<16;++r)sacc+=pB0[r]; _Pragma("unroll") for(int r=0;r<16;++r)sacc+=pB1[r]; l_reg+=sacc;
    pw0=(u32x4){PKW(pB0,0),PKW(pB0,2),PKW(pB0,4),PKW(pB0,6)};pw1=(u32x4){PKW(pB0,8),PKW(pB0,10),PKW(pB0,12),PKW(pB0,14)};pw2=(u32x4){PKW(pB1,0),PKW(pB1,2),PKW(pB1,4),PKW(pB1,6)};pw3=(u32x4){PKW(pB1,8),PKW(pB1,10),PKW(pB1,12),PKW(pB1,14)};
    SBAR(); pv(o,vb0+sl_cur,PAF(0),PAF(1),PAF(2),PAF(3)); }
  #undef PKW
  #undef PAF
  #undef VFR
  #undef PIN
  #undef MX3
  #undef GAPA
  #undef GAPB
  #undef EX
  #undef VRD
  #undef KRD
  #undef STEP
  #undef ENDW
  #undef KXB
  #undef MKQX
  {auto rr=__builtin_amdgcn_permlane32_swap(__float_as_uint(l_reg),__float_as_uint(l_reg),false,false);l_reg=__uint_as_float(rr[0])+__uint_as_float(rr[1]);}
  if(hi==0)wsf[32+r32]=l_reg;asm volatile("s_waitcnt lgkmcnt(0)":::"memory");
  float rli[16];
  #pragma unroll
  for(int r=0;r<16;++r)rli[r]=__builtin_amdgcn_rcpf(wsf[32+crow(r,hi)]);
  bf16*Ow=O+(rowbase+q0+wid*QBLK)*DM+h*D;
  { bf16*stg=(bf16*)(shm+LDS_OST)+wid*2048;
    #pragma unroll
    for(int r=0;r<16;++r){const int orow=crow(r,hi);
      #pragma unroll
      for(int d0=0;d0<2;++d0)stg[orow*64+d0*32+r32]=__float2bfloat16(o[d0][r]*rli[r]);}
    asm volatile("s_waitcnt lgkmcnt(0)":::"memory");
    #pragma unroll
    for(int i=0;i<4;++i){const int row=i*8+(lane>>3),ch=lane&7; const u32x4 v=*(const u32x4*)(stg+row*64+ch*8); ATTN_STORE16(Ow+(long)row*DM+ch*8,v);} }
  asm volatile("s_waitcnt lgkmcnt(0)\n\ts_barrier":::"memory");
  #undef DMA_K
  #undef DMA_V
  #undef CMASK
  #undef START
  #undef RESC
  #undef ROT
}
constexpr int ATTN_LDS_BYTES=LDS_BYTES;
struct AttnTensors { const bf16* Q; const bf16* K; const bf16* V; bf16* O; };
struct AttnUnit { int bh; int qb; int t0; };
struct StaticOrder {
  int vcu;
  __device__ __forceinline__ explicit StaticOrder(int grid,int block):vcu((block%8)*(grid/8)+block/8){}
  __device__ __forceinline__ bool next(int i,AttnUnit&u)const{ if(i>=8)return false; const int s=vcu&7,k=i&3; u.bh=2*(vcu>>3)+(i>>2); u.qb=(k==0)?s:(k==1)?15-s:(k==2)?16+s:31-s; u.t0=0; return true; }
};
constexpr float PRUNE_MARGIN=40.f;
template<class Sched,int THRL=32> __device__ __forceinline__ void attn_phase(char*lds,const AttnTensors&T,const float*cb,const float*qk,const Sched&S,const int wv){
  { int tid=tid_now(wv); asm volatile("":"+v"(tid)); const int lane=tid&63,wid=__builtin_amdgcn_readfirstlane(tid>>6);
    AttnUnit u; S.next(wid,u);
    const float thr=2.02f*qk[2*u.bh]*qk[2*u.bh+1]+PRUNE_MARGIN; const float*c=cb+(size_t)u.bh*SEQ; const float cq=c[u.qb*QB];
    const bool p0=(c[64*lane+63]-cq>=thr), p1=(c[64*(lane+64)+63]-cq>=thr);
    int cnt=__builtin_popcountll(__ballot(p0))+__builtin_popcountll(__ballot(p1)); cnt&=~1; if(cnt>4*u.qb)cnt=4*u.qb;
    if(lane==0)((int*)(lds+LDS_T0))[wid]=cnt;
    __syncthreads(); }
  AttnUnit u;
  for(int i=0;S.next(i,u);++i){ const int t0=__builtin_amdgcn_readfirstlane(((const int*)(lds+LDS_T0))[i]); attn_unit<THRL>(u.bh>>3,u.bh&7,u.qb,t0,T.Q,T.K,T.V,T.O,cb+(size_t)u.bh*SEQ,lds,wv); }
}
#undef SBAR
#undef WAIT_BAR
}
#define GAS __attribute__((address_space(1)))
#define LAS __attribute__((address_space(3)))
typedef unsigned short bf16;
typedef unsigned v4u __attribute__((ext_vector_type(4)));
typedef float f32x4 __attribute__((ext_vector_type(4)));
typedef short bf16x8 __attribute__((ext_vector_type(8)));
typedef GAS unsigned gu32;
typedef GAS unsigned long long gu64;
#define RLX_AGENT __ATOMIC_RELAXED, __HIP_MEMORY_SCOPE_AGENT
#define LDS_WAIT() asm volatile("s_waitcnt lgkmcnt(0)" ::: "memory")
#define VM_WAIT() asm volatile("s_waitcnt vmcnt(0)" ::: "memory")
__device__ __forceinline__ unsigned long long rt() { return __builtin_amdgcn_s_memrealtime(); }
__device__ __forceinline__ unsigned f2bf(float f) { unsigned u = __builtin_bit_cast(unsigned, f); return (u + 0x7fffu + ((u >> 16) & 1u)) >> 16; }
__device__ __forceinline__ unsigned pk2(float lo, float hi) { return f2bf(lo) | (f2bf(hi) << 16); }

#define XB_TMO      128
#define XB_XCNT(j)  (256  + 64 * (j))
#define XB_XSUB(j)  (1280 + 64 * (j))
#define XB_XGEN(j)  (2304 + 64 * (j))
#define XB_TOP      3328
#define XB_TOPGEN   3392
#define XCD_BAR_WORDS 3456
#define XB_SPIN_CAP (1u << 18)

__device__ __forceinline__ unsigned xb_ld(unsigned* p)              { return __hip_atomic_load(p, __ATOMIC_RELAXED, __HIP_MEMORY_SCOPE_AGENT); }
__device__ __forceinline__ unsigned xb_add(unsigned* p, unsigned v) { return __hip_atomic_fetch_add(p, v, __ATOMIC_RELAXED, __HIP_MEMORY_SCOPE_AGENT); }
__device__ __forceinline__ unsigned xb_xcc_id() { return (unsigned)__builtin_amdgcn_s_getreg((3 << 11) | 20) & 0xFu; }
#define XB_SPIN(cond, bar) do { unsigned _sp = 0; while (cond) { __builtin_amdgcn_s_sleep(1); \
    if ((++_sp & 255u) == 0u) { if (xb_ld(&(bar)[XB_TMO])) break; if (_sp > XB_SPIN_CAP) { atomicAdd(&(bar)[XB_TMO], 1u); break; } } } } while (0)

struct XcdBarrier {
    unsigned* bar; unsigned x;
    volatile LAS unsigned* st;
};

__device__ __forceinline__ XcdBarrier xcd_barrier_post(unsigned* bar, volatile LAS unsigned* st) {
    XcdBarrier b; b.bar = bar; b.x = xb_xcc_id(); b.st = st;
    if (threadIdx.x == 0) { st[4] = xb_add(&bar[XB_XCNT(b.x)], 1u); st[3] = blockIdx.x; }
    return b;
}
__device__ __forceinline__ void xcd_barrier_complete(unsigned* bar, unsigned x, unsigned& nloc, unsigned& nx, unsigned& reg) {
    const unsigned G = gridDim.x * gridDim.y * gridDim.z;
    unsigned sum, cnt, mine, bad, sp = 0u;
    for (;;) {
        sum = 0u; cnt = 0u; bad = 0u;
#pragma unroll
        for (unsigned j = 0; j < 16; ++j) { const unsigned c = xb_ld(&bar[XB_XCNT(j)]); sum += c; cnt += (c > 0u) ? 1u : 0u; bad |= (j < 8u) ? (c ^ 32u) : c; }
        if (sum == G) break;
        __builtin_amdgcn_s_sleep(1);
        if ((++sp & 255u) == 0u) { if (xb_ld(&bar[XB_TMO])) { bad = 1u; break; } if (sp > XB_SPIN_CAP) { atomicAdd(&bar[XB_TMO], 1u); bad = 1u; break; } }
    }
#ifdef PROBE_FORCE_IRREGULAR
    bad = 1u;
#endif
    reg = (bad == 0u && G == 256u) ? 1u : 0u;
    mine = xb_ld(&bar[XB_XCNT(x)]);
    nloc = mine > 0u ? mine : 1u; nx = cnt > 0u ? cnt : 1u;
}

__device__ __forceinline__ void xcd_barrier(const XcdBarrier& b, const bool glob, const int wv  ) {
    asm volatile("s_waitcnt vmcnt(0)" ::: "memory");
    __syncthreads();
    if (tid_now(wv) == 0) {
        GAS unsigned* barg_ = (GAS unsigned*)b.bar; unsigned xq_ = b.x; asm volatile("" : "+s"(barg_), "+s"(xq_));
        unsigned* bar = (unsigned*)barg_;
        __builtin_amdgcn_s_waitcnt(0);
        unsigned nloc = b.st[0], nx = b.st[1];
        if (nloc == 0u) { unsigned reg; xcd_barrier_complete(bar, xq_, nloc, nx, reg); b.st[0] = nloc; b.st[1] = nx; b.st[2] = reg; if (reg) b.st[3] = b.st[4] * 8u + xq_; }
        const bool loc = !glob && b.st[2] != 0u;
        const unsigned old = xb_add(&bar[XB_XSUB(xq_)], 1u);
        const unsigned gen = old / nloc;
        if (old + 1u == (gen + 1u) * nloc) {
            if (!loc) {
            __builtin_amdgcn_fence(__ATOMIC_RELEASE, "agent");
            asm volatile("s_waitcnt vmcnt(0)" ::: "memory");
            const unsigned og = xb_add(&bar[XB_TOP], 1u);
            const unsigned tg = og / nx;
            if (og + 1u == (tg + 1u) * nx) xb_add(&bar[XB_TOPGEN], 1u);
            else XB_SPIN(xb_ld(&bar[XB_TOPGEN]) == tg, bar);
            }
            __builtin_amdgcn_fence(__ATOMIC_ACQUIRE, "agent");
            xb_add(&bar[XB_XGEN(xq_)], 1u);
            asm volatile("s_waitcnt vmcnt(0)" ::: "memory");
        } else {
            XB_SPIN(xb_ld(&bar[XB_XGEN(xq_)]) == gen, bar);
            __builtin_amdgcn_fence(__ATOMIC_ACQUIRE, "agent");
            asm volatile("s_waitcnt vmcnt(0)" ::: "memory");
        }
    }
    __syncthreads();
}

constexpr int NWAVES = 8;
#ifndef PROBE_DUP
#define PROBE_DUP 0
#endif
#define NREP(k) ((PROBE_DUP == (k)) ? 2 : 1)
#ifndef PROBE_RG
#define PROBE_RG 0
#endif
#ifndef PROBE_EDUP
#define PROBE_EDUP 0
#endif
#ifndef MK_ONE_LAUNCH
#define MK_ONE_LAUNCH 1
#endif
constexpr int BATCH = 8, SEQ = 8192, DM = 1024, DEPTH = 4, M = BATCH * SEQ;
constexpr int NIN = 3584, INW = 3592, FF = 2816, PLE = 256, NFH = 8, NCHK = SEQ / 128;
constexpr int NPH = 2 + 9 * DEPTH;
constexpr float LOG2E = 1.4426950408889634f;
constexpr size_t MiB = 1u << 20;
constexpr size_t WS_CTL = 0, CTL_ZERO_BYTES = 1 * MiB;
constexpr size_t WS_WFB = 1 * MiB;
constexpr size_t WS_CS = 2 * MiB;
constexpr size_t WS_LF = 4 * MiB;
constexpr size_t WS_CB = 6 * MiB;
constexpr size_t WS_SSQ0 = 9 * MiB, WS_SSQ1 = 13 * MiB;
constexpr size_t WS_W = 17 * MiB, W_LAYER = 28 * MiB;
constexpr size_t WO_IN = 0, WO_OUT = 7 * MiB, WO_A = 9 * MiB, WO_G = 14 * MiB + MiB / 2, WO_DOWN = 20 * MiB, WO_GATE = 25 * MiB + MiB / 2, WO_PROJ = 27 * MiB + MiB / 2;
constexpr size_t WS_HB = 129 * MiB;
constexpr size_t WS_PB = 257 * MiB;
constexpr size_t WS_X = 289 * MiB, XR = 81 * MiB;
#define XBUF(off, per_batch_bytes) (WS_X + (size_t)(off) + (size_t)(bx & 7) * (XR - (size_t)(per_batch_bytes)))
#define WS_QO  XBUF(0, 16 * MiB)
#define PP_BASE ((bf16*)(ws + WS_HBT))
#define WS_KK  XBUF(16 * MiB, 16 * MiB)
#define WS_VV  XBUF(32 * MiB, 16 * MiB)
#define WS_G   XBUF(48 * MiB, 8 * MiB)
#define WS_U   XBUF(56 * MiB, 1 * MiB)
#define WS_NRM XBUF(57 * MiB, MiB / 2)
#define WS_ACT XBUF(16 * MiB, 44 * MiB)
#define WS_FIX XBUF(62 * MiB, 704 * 2048)
#define WS_HAL XBUF(63 * MiB + MiB / 2, 704 * 1024)
#define WS_HBT XBUF(65 * MiB, 16 * MiB)
constexpr size_t WS_END = WS_X + 8 * XR;
static_assert(WS_W + DEPTH * W_LAYER == WS_HB && WS_END <= 1024 * MiB, "d_ws map");
constexpr int CW_QK = 65536;
constexpr int CW_TAB = 131072;
constexpr int CW_BAR = 4096;

constexpr int RING_BYTES = 131072, LDSCTL_OFF = RING_BYTES, MISC_OFF = LDSCTL_OFF + 320, LDS_BYTES = 147456;

typedef float f32x16 __attribute__((ext_vector_type(16)));
typedef short s16x4 __attribute__((ext_vector_type(4)));
typedef float f32x2_ __attribute__((ext_vector_type(2)));
typedef __bf16 bf16x2_ __attribute__((ext_vector_type(2)));
__device__ __forceinline__ unsigned cvtpk(float lo, float hi) { f32x2_ v = {lo, hi}; bf16x2_ b = __builtin_convertvector(v, bf16x2_); return __builtin_bit_cast(unsigned, b); }
__device__ __forceinline__ int crow16(int r, int hi) { return (r & 3) + 8 * (r >> 2) + 4 * hi; }
__device__ __forceinline__ float bpx(float v, int lane, int mask) { return __int_as_float(__builtin_amdgcn_ds_bpermute((lane ^ mask) << 2, __float_as_int(v))); }
__device__ __forceinline__ float wave_sum(float v, int lane) {
#pragma unroll
    for (int o = 1; o < 32; o <<= 1) v += bpx(v, lane, o);
    return pg8::halves_sum(v);
}
__device__ __forceinline__ s16x4 trd(LAS unsigned char* p) { typedef short v4i16_t __attribute__((ext_vector_type(4))); return __builtin_bit_cast(s16x4, __builtin_amdgcn_ds_read_tr16_b64_v4i16((LAS v4i16_t*)p)); }
__device__ __forceinline__ bf16x8 cat8(s16x4 lo, s16x4 hi) { return (bf16x8){lo[0], lo[1], lo[2], lo[3], hi[0], hi[1], hi[2], hi[3]}; }
#define MFMA32(a, b, c) __builtin_amdgcn_mfma_f32_32x32x16_bf16((a), (b), (c), 0, 0, 0)

__device__ __forceinline__ void tr_item(const float* W, int ldw, int c0, const float* kscale, int K, bf16* WT, int dst_row0, int mode, LAS float* scr, int item, int nblk, int lane) {
    const int kb = item / nblk, nb = item % nblk, k0 = 64 * kb, n0 = 32 * nb;
    { pg8::f32x4 v[8]; float sc[8];
#pragma unroll
      for (int p = 0; p < 8; ++p) { const int kk = 8 * p + (lane >> 3); v[p] = __builtin_nontemporal_load((const pg8::f32x4*)(W + (size_t)(k0 + kk) * ldw + c0 + n0 + 4 * (lane & 7))); sc[p] = kscale ? kscale[k0 + kk] : 1.f; }
#pragma unroll
      for (int p = 0; p < 8; ++p) { const int kk = 8 * p + (lane >> 3); LAS float* d = scr + kk * 33 + 4 * (lane & 7); d[0] = v[p][0] * sc[p]; d[1] = v[p][1] * sc[p]; d[2] = v[p][2] * sc[p]; d[3] = v[p][3] * sc[p]; } }
    LDS_WAIT(); asm volatile("" ::: "memory");
    const int c = lane & 7;
#pragma unroll
    for (int j = 0; j < 4; ++j) { const int n = (lane >> 3) + 8 * j, nn = n0 + n; const LAS float* s = scr + (8 * c) * 33 + n;
        int drow = nn; if (mode == 1) { const int d = nn & 63; drow = (nn & ~63) + ((d < 32) ? (8 * (d >> 2) + (d & 3)) : (8 * ((d - 32) >> 2) + 4 + (d & 3))); }
        if (mode == 2) drow = (nn >> 7) * 256 + (nn & 127);
        v4u o; o.x = cvtpk(s[0 * 33], s[1 * 33]); o.y = cvtpk(s[2 * 33], s[3 * 33]); o.z = cvtpk(s[4 * 33], s[5 * 33]); o.w = cvtpk(s[6 * 33], s[7 * 33]);
        *(GAS v4u*)(WT + (size_t)(dst_row0 + drow) * K + k0 + 8 * c) = o; }
    LDS_WAIT(); asm volatile("" ::: "memory");
}
constexpr int IT_IN = 7 * 256, IT_OUT = 512, IT_UP = 1408, IT_DOWN = 1408, IT_GATE = 512, IT_PROJ = 128, IT_LAYER = IT_IN + IT_OUT + 2 * IT_UP + IT_DOWN + IT_GATE + IT_PROJ;

struct Args { const float* in[15]; float* out; unsigned char* ws; int ph_lo, ph_hi; };
__device__ __forceinline__ const float* inp_ptr(const unsigned char* ws, int k, int zq) {
    const unsigned* t = (const unsigned*)(ws + WS_CTL) + CW_TAB + 2 * k + zq; const unsigned lo = t[0], hi = t[1];
    const GAS float* g = (const GAS float*)(((unsigned long long)(unsigned)__builtin_amdgcn_readfirstlane((int)hi) << 32) | (unsigned)__builtin_amdgcn_readfirstlane((int)lo));
    return (const float*)g;
}
#define INP(k) inp_ptr(ws, (k), zq)

__device__ __forceinline__ void convert_layer(unsigned char* ws, int zq, LAS unsigned char* ldsl, int l, int gw, int NGW, int wave, int lane) {
    LAS float* scr = (LAS float*)(ldsl + wave * 16384);
    unsigned char* wl = ws + WS_W + (size_t)l * W_LAYER;
    const float* w_in = INP(3) + (size_t)l * DM * INW; const float* w_up = INP(7) + (size_t)l * DM * 2 * FF;
    const float* nw_attn = INP(2) + l * DM; const float* nw_ffn = INP(6) + l * DM; const float* nw_ple = INP(11) + l * DM;
    const float* w_out = INP(5) + (size_t)l * DM * DM; const float* w_down = INP(10) + (size_t)l * FF * DM; const float* w_gate = INP(12) + (size_t)l * DM * DM; const float* w_proj = INP(13) + (size_t)l * PLE * DM;
    for (int it = gw; it < IT_LAYER; it += NGW) {
        int r = it;
        if (r < IT_IN) { const int seg = r >> 8; tr_item(w_in, INW, seg * 512 + (seg >= 3 ? 8 : 0), nw_attn, DM, (bf16*)(wl + WO_IN), seg * 512, (seg == 3 || seg == 4) ? 1 : 0, scr, r & 255, 16, lane); continue; } r -= IT_IN;
        if (r < IT_OUT) { tr_item(w_out, DM, 0, nullptr, DM, (bf16*)(wl + WO_OUT), 0, 0, scr, r, 32, lane); continue; } r -= IT_OUT;
        if (r < IT_UP) { tr_item(w_up, 2 * FF, 0, nw_ffn, DM, (bf16*)(wl + WO_A), 0, 2, scr, r, 88, lane); continue; } r -= IT_UP;
        if (r < IT_UP) { tr_item(w_up, 2 * FF, FF, nw_ffn, DM, (bf16*)(wl + WO_A), 128, 2, scr, r, 88, lane); continue; } r -= IT_UP;
        if (r < IT_DOWN) { tr_item(w_down, DM, 0, nullptr, FF, (bf16*)(wl + WO_DOWN), 0, 0, scr, r, 32, lane); continue; } r -= IT_DOWN;
        if (r < IT_GATE) { tr_item(w_gate, DM, 0, nw_ple, DM, (bf16*)(wl + WO_GATE), 0, 0, scr, r, 32, lane); continue; } r -= IT_GATE;
        tr_item(w_proj, DM, 0, nullptr, PLE, (bf16*)(wl + WO_PROJ), 0, 0, scr, r, 32, lane);
    }
}
__device__ __forceinline__ void prologue(unsigned char* ws, int zq, LAS unsigned char* ldsl, int gw, int NGW, int wave, int lane, int gtid, int GT) {
    convert_layer(ws, zq, ldsl, 0, gw, NGW, wave, lane);
    { bf16* wfb = (bf16*)(ws + WS_WFB); const float* nwa = INP(2); const float* win = INP(3);
      for (int i = gtid; i < DEPTH * 8 * DM; i += GT) { const int l = i / (8 * DM), j = (i / DM) & 7, k = i % DM;
          wfb[i] = (bf16)(cvtpk(nwa[l * DM + k] * win[(size_t)l * DM * INW + (size_t)k * INW + 1536 + j], 0.f) & 0xffffu); } }
    { float* cs = (float*)(ws + WS_CS);
      for (int i = gtid; i < SEQ * 32; i += GT) { const int pos = i >> 5, d = i & 31; const float inv = powf(10000.0f, -(float)(2 * d) / 64.0f), ang = (float)pos * inv; float sn, cn; sincosf(ang, &sn, &cn); cs[i] = cn; cs[SEQ * 32 + i] = sn; } }
    { bf16* hb = (bf16*)(ws + WS_HB); float* ssq = (float*)(ws + WS_SSQ0); const float* xin = INP(0);
      for (int m0 = gw; m0 < M; m0 += 4 * NGW) {
          f32x4 v[4][4];
#pragma unroll
          for (int k = 0; k < 4; ++k) { const float* xr = xin + (size_t)(m0 + k * NGW) * DM;
#pragma unroll
              for (int j = 0; j < 2; ++j) { v[k][2 * j] = __builtin_nontemporal_load((const f32x4*)(xr + j * 512 + lane * 8)); v[k][2 * j + 1] = __builtin_nontemporal_load((const f32x4*)(xr + j * 512 + lane * 8 + 4)); } }
#pragma unroll
          for (int k = 0; k < 4; ++k) { const int m = m0 + k * NGW; float s = 0.f;
#pragma unroll
              for (int j = 0; j < 2; ++j) { const f32x4 v0 = v[k][2 * j], v1 = v[k][2 * j + 1];
                  s += ((v0[0] * v0[0] + v0[1] * v0[1]) + (v0[2] * v0[2] + v0[3] * v0[3])) + ((v1[0] * v1[0] + v1[1] * v1[1]) + (v1[2] * v1[2] + v1[3] * v1[3]));
                  v4u o; o.x = cvtpk(v0[0], v0[1]); o.y = cvtpk(v0[2], v0[3]); o.z = cvtpk(v1[0], v1[1]); o.w = cvtpk(v1[2], v1[3]); *(v4u*)(hb + (size_t)m * DM + j * 512 + lane * 8) = o; }
              s = wave_sum(s, lane); if (lane < 16) ssq[(size_t)m * 16 + lane] = s * (1.0f / 16.0f); } } }
}

__device__ __forceinline__ void flogit_pb_task(const bf16* hb, const bf16* wfb, const float* ssq, const float* fbias, float* lf, const float* p, bf16* pb, int vcu, int wave, int lane) {
    const int r32 = lane & 31, hi = lane >> 5;
    const int row0 = vcu * 256 + wave * 32;
    const bf16* ap = hb + (size_t)(row0 + r32) * DM + 8 * hi; const bf16* bp = wfb + (r32 & 7) * DM + 8 * hi;
    const size_t i0 = (size_t)(vcu >> 5) * (SEQ * PLE / 8) + (size_t)(vcu & 31) * (NWAVES * 64) + wave * 64 + lane;
    f32x16 acc; for (int i = 0; i < 16; ++i) acc[i] = 0.f;
#pragma unroll 1
    for (int kb = 0; kb < 8; ++kb) {
        f32x4 pv[2][2];
#pragma unroll
        for (int j = 0; j < 2; ++j) { const float* s = p + (i0 + (size_t)(2 * kb + j) * (32 * NWAVES * 64)) * 8; pv[j][0] = __builtin_nontemporal_load((const f32x4*)s); pv[j][1] = __builtin_nontemporal_load((const f32x4*)(s + 4)); }
#pragma unroll
        for (int ks = 0; ks < 8; ++ks) acc = MFMA32(*(const bf16x8*)(ap + 16 * (8 * kb + ks)), *(const bf16x8*)(bp + 16 * (8 * kb + ks)), acc);
#pragma unroll
        for (int j = 0; j < 2; ++j) { v4u o; o.x = cvtpk(pv[j][0][0], pv[j][0][1]); o.y = cvtpk(pv[j][0][2], pv[j][0][3]); o.z = cvtpk(pv[j][1][0], pv[j][1][1]); o.w = cvtpk(pv[j][1][2], pv[j][1][3]);
            *(v4u*)(pb + (i0 + (size_t)(2 * kb + j) * (32 * NWAVES * 64)) * 8) = o; }
    }
    if (r32 < 8) { const float fb = fbias[r32];
#pragma unroll
        for (int r = 0; r < 16; ++r) { const int row = row0 + crow16(r, hi); const float x = acc[r] * pg8::row_rstd(ssq, row) + fb;
            lf[(size_t)row * 8 + r32] = fminf(x, 0.f) - __logf(1.0f + __expf(-fabsf(x))); } }
}

__device__ __forceinline__ void flogit_task(const bf16* hb, const bf16* wfb, const float* ssq, const float* fbias, float* lf, int G, int bx, int wave, int lane) {
    const int r32 = lane & 31, hi = lane >> 5;
    for (int blk = bx; blk < M / 256; blk += G) {
        const int row0 = blk * 256 + wave * 32;
        const bf16* ap = hb + (size_t)(row0 + r32) * DM + 8 * hi; const bf16* bp = wfb + (r32 & 7) * DM + 8 * hi;
        f32x16 acc; for (int i = 0; i < 16; ++i) acc[i] = 0.f;
#pragma unroll 8
        for (int ks = 0; ks < DM / 16; ++ks) acc = MFMA32(*(const bf16x8*)(ap + 16 * ks), *(const bf16x8*)(bp + 16 * ks), acc);
        if (r32 < 8) { const float fb = fbias[r32];
#pragma unroll
            for (int r = 0; r < 16; ++r) { const int row = row0 + crow16(r, hi); const float x = acc[r] * pg8::row_rstd(ssq, row) + fb;
                lf[(size_t)row * 8 + r32] = fminf(x, 0.f) - __logf(1.0f + __expf(-fabsf(x))); } }
    }
}
__device__ __forceinline__ void pb_task(const float* p, bf16* pb, int vcu, int tid) {
    const int i0 = (vcu >> 5) * (SEQ * PLE / 8);
    for (int j = (vcu & 31) * (NWAVES * 64) + tid; j < SEQ * PLE / 8; j += 32 * NWAVES * 64) { const int i = i0 + j; const f32x4 v0 = __builtin_nontemporal_load((const f32x4*)(p + (size_t)i * 8)), v1 = __builtin_nontemporal_load((const f32x4*)(p + (size_t)i * 8 + 4));
        v4u o; o.x = cvtpk(v0[0], v0[1]); o.y = cvtpk(v0[2], v0[3]); o.z = cvtpk(v1[0], v1[1]); o.w = cvtpk(v1[2], v1[3]); *(v4u*)(pb + (size_t)i * 8) = o; }
}

__device__ __forceinline__ float lane_up(float v, int lane, int o) { return __int_as_float(__builtin_amdgcn_ds_bpermute((lane - o) << 2, __float_as_int(v))); }
__device__ __forceinline__ void cumsum_task(const float* lf, float* cb, LAS float* red, int vcu, int tid) {
    const int b = vcu >> 5, r = vcu & 31, h = r & 7, qd = r >> 3, lane = tid & 63, wave = tid >> 6;
    const float* src = lf + ((size_t)b * SEQ) * 8 + h;
    float pre = 0.f, v[4];
    { float pv[3][4];
#pragma unroll
      for (int q = 0; q < 3; ++q)
#pragma unroll
          for (int i = 0; i < 4; ++i) pv[q][i] = (q < qd) ? src[(size_t)(q * 2048 + tid * 4 + i) * 8] : 0.f;
#pragma unroll
      for (int i = 0; i < 4; ++i) v[i] = src[(size_t)(qd * 2048 + tid * 4 + i) * 8];
#pragma unroll
      for (int q = 0; q < 3; ++q) pre += (pv[q][0] + pv[q][1]) + (pv[q][2] + pv[q][3]); }
    v[1] += v[0]; v[2] += v[1]; v[3] += v[2];
    float x = v[3];
#pragma unroll
    for (int o = 1; o < 64; o <<= 1) { const float y = lane_up(x, lane, o); if (lane >= o) x += y; }
    pre = wave_sum(pre, lane);
    if (lane == 63) red[wave] = x;
    if (lane == 0) red[8 + wave] = pre;
    __syncthreads();
    float off = 0.f;
#pragma unroll
    for (int w = 0; w < 8; ++w) { off += red[8 + w]; if (w < wave) off += red[w]; }
    off += x - v[3];
    *(f32x4*)(cb + (size_t)(b * 8 + h) * SEQ + qd * 2048 + tid * 4) = (f32x4){(off + v[0]) * LOG2E, (off + v[1]) * LOG2E, (off + v[2]) * LOG2E, (off + v[3]) * LOG2E};
    __syncthreads();
}
__device__ __forceinline__ void fill_img(LAS unsigned char* img, const bf16* g, int t256) {
#pragma unroll
    for (int i = 0; i < 4; ++i) { const int idx = t256 + 256 * i, row = idx >> 3, ch = idx & 7;
        *(LAS v4u*)(img + (ch >> 2) * 8192 + row * 64 + (ch & 3) * 16) = *(const v4u*)(g + (size_t)row * DM + ch * 8); }
}
#define RG_PREF(KR, VR, goff) do { _Pragma("unroll") for (int i_ = 0; i_ < 4; ++i_) { const int idx_ = t256 + 256 * i_, row_ = idx_ >> 3, ch_ = idx_ & 7; \
        KR[i_] = *(const v4u*)(KK + (goff) + (size_t)row_ * DM + ch_ * 8); VR[i_] = *(const v4u*)(VV + (goff) + (size_t)row_ * DM + ch_ * 8); } } while (0)
#define RG_PUT(KR, VR) do { _Pragma("unroll") for (int i_ = 0; i_ < 4; ++i_) { const int idx_ = t256 + 256 * i_, row_ = idx_ >> 3, ch_ = idx_ & 7; \
        *(LAS v4u*)(base + (ch_ >> 2) * 8192 + row_ * 64 + (ch_ & 3) * 16) = KR[i_]; *(LAS v4u*)(base + 16384 + (ch_ >> 2) * 8192 + row_ * 64 + (ch_ & 3) * 16) = VR[i_]; } } while (0)
#define RG_STATE(ACC) do { _Pragma("unroll") for (int s_ = 0; s_ < 8; ++s_) ACC = MFMA32(cat8(trd(va + s_ * 1024), trd(va + s_ * 1024 + 256)), cat8(trd(ka + s_ * 1024), trd(ka + s_ * 1024 + 256)), ACC); } while (0)
__device__ __forceinline__ void ret_group_state(LAS unsigned char* ldsl, const bf16* KK, const bf16* VV, float* AG, int bx, int tid) {
    const int lane = tid & 63, wave = __builtin_amdgcn_readfirstlane(tid >> 6), h2 = wave >> 2, w4 = wave & 3, t256 = tid & 255;
    const int r32 = lane & 31, hi = lane >> 5, g1 = (lane >> 4) & 1, q = (lane & 15) >> 2, p = lane & 3;
    LAS unsigned char* base = ldsl + h2 * 32768;
    const int uid = 2 * bx + h2, bh = uid >> 3, g = uid & 7, b = bh >> 3, h = bh & 7, eb = w4 & 1, db = w4 >> 1;
    const size_t goff0 = ((size_t)b * SEQ + (size_t)g * 1024) * DM + 512 + h * 64;
    LAS unsigned char* va = base + 16384 + eb * 8192 + (8 * hi + q) * 64 + g1 * 32 + p * 8;
    LAS unsigned char* ka = base + db * 8192 + (8 * hi + q) * 64 + g1 * 32 + p * 8;
    const float g128 = __builtin_amdgcn_exp2f(128.0f * pg8::lg2gamma(h));
    v4u kr[4], vr[4];
    RG_PREF(kr, vr, goff0); RG_PUT(kr, vr); RG_PREF(kr, vr, goff0 + (size_t)128 * DM);
    __syncthreads();
    f32x16 acc; for (int i = 0; i < 16; ++i) acc[i] = 0.f;
#pragma unroll 1
    for (int i = 0; i < 8; ++i) {
        RG_STATE(acc);
#pragma unroll
        for (int r = 0; r < 16; ++r) acc[r] *= g128;
        __syncthreads();
        if (i < 7) { RG_PUT(kr, vr); if (i < 6) RG_PREF(kr, vr, goff0 + (size_t)(i + 2) * 128 * DM); __syncthreads(); }
    }
    float* up = AG + (size_t)uid * 4096 + (32 * db + r32) * 64 + 32 * eb + 4 * hi;
#pragma unroll
    for (int gg = 0; gg < 4; ++gg) *(pg8::f32x4*)(up + 8 * gg) = (pg8::f32x4){acc[4 * gg], acc[4 * gg + 1], acc[4 * gg + 2], acc[4 * gg + 3]};
}
__device__ __forceinline__ void qknorm_task(const float* nrm, unsigned* qk, int gw, int NGW, int lane) {
    for (int blk = gw; blk < M / 32; blk += NGW) {
        float mq = 0.f, mk = 0.f;
#pragma unroll
        for (int i = 0; i < 4; ++i) { const int rh = (blk * 32 + i * 8) * 8 + lane;
            const f32x2_ a = *(const f32x2_*)(nrm + (size_t)rh * 2), k = *(const f32x2_*)(nrm + (size_t)M * 16 + (size_t)rh * 2);
            mq = fmaxf(mq, a.x + a.y); mk = fmaxf(mk, k.x + k.y); }
        mq = fmaxf(mq, bpx(mq, lane, 8)); mq = fmaxf(mq, bpx(mq, lane, 16)); mq = fmaxf(mq, bpx(mq, lane, 32));
        mk = fmaxf(mk, bpx(mk, lane, 8)); mk = fmaxf(mk, bpx(mk, lane, 16)); mk = fmaxf(mk, bpx(mk, lane, 32));
        if (lane < 8) { const int bh = ((blk * 32) >> 13) * 8 + lane;
            atomicMax(qk + 2 * bh, __float_as_uint(sqrtf(mq))); atomicMax(qk + 2 * bh + 1, __float_as_uint(sqrtf(mk))); }
    }
}
__device__ __forceinline__ void ret_group_out(LAS unsigned char* ldsl, const bf16* QO, bf16* OUT, const bf16* KK, const bf16* VV, const bf16* Gt, const float* AG, int bx, int tid) {
    const int lane = tid & 63, wave = __builtin_amdgcn_readfirstlane(tid >> 6), h2 = wave >> 2, w4 = wave & 3, qb = w4, t256 = tid & 255;
    const int r32 = lane & 31, hi = lane >> 5, g1 = (lane >> 4) & 1, q = (lane & 15) >> 2, p = lane & 3;
    LAS unsigned char* base = ldsl + h2 * 59392;
    LAS unsigned char* simg = base + 32768;
    LAS unsigned char* stg = base + 40960 + qb * 4608;
    const int uid = 2 * bx + h2, bh = uid >> 3, g = uid & 7, b = bh >> 3, h = bh & 7, eb = w4 & 1, db = w4 >> 1;
    const size_t grow00 = (size_t)b * SEQ + (size_t)g * 1024; const int colh = 512 + h * 64;
    const size_t goff0 = grow00 * DM + colh;
    LAS unsigned char* va = base + 16384 + eb * 8192 + (8 * hi + q) * 64 + g1 * 32 + p * 8;
    LAS unsigned char* ka = base + db * 8192 + (8 * hi + q) * 64 + g1 * 32 + p * 8;
    LAS unsigned char* vb = base + 16384 + (4 * hi + q) * 64 + g1 * 32 + p * 8;
    const float lg = pg8::lg2gamma(h), g128 = __builtin_amdgcn_exp2f(128.0f * lg);
    v4u kr[4], vr[4];
    RG_PREF(kr, vr, goff0);
    bf16x8 qf[4];
#pragma unroll
    for (int ks = 0; ks < 4; ++ks) qf[ks] = *(const bf16x8*)(QO + (grow00 + 32 * qb + r32) * DM + colh + 16 * ks + 8 * hi);
    f32x16 sacc; for (int i = 0; i < 16; ++i) sacc[i] = 0.f;
    { const float* ap0 = AG + (size_t)(bh * 8) * 4096 + (32 * db + r32) * 64 + 32 * eb + 4 * hi;
#pragma unroll
      for (int bt = 0; bt < 4; ++bt) { pg8::f32x4 av[2][4];
#pragma unroll
          for (int k = 0; k < 2; ++k) { const int gp = 2 * bt + k;
#pragma unroll
              for (int gg = 0; gg < 4; ++gg) av[k][gg] = (gp < g) ? *(const pg8::f32x4*)(ap0 + (size_t)(gp < g ? gp : 0) * 4096 + 8 * gg) : (pg8::f32x4){0.f, 0.f, 0.f, 0.f}; }
#pragma unroll
          for (int k = 0; k < 2; ++k) { const int gp = 2 * bt + k; const float wgt = (gp < g) ? __builtin_amdgcn_exp2f((float)(g - 1 - gp) * 1024.0f * lg) : 0.f;
#pragma unroll
              for (int gg = 0; gg < 4; ++gg)
#pragma unroll
                  for (int j = 0; j < 4; ++j) sacc[4 * gg + j] += wgt * av[k][gg][j]; } } }
    RG_PUT(kr, vr);
    RG_PREF(kr, vr, goff0 + (size_t)128 * DM);
#pragma unroll 1
    for (int i = 0; i < 8; ++i) {
        const size_t grow0 = grow00 + (size_t)i * 128;
#pragma unroll
        for (int r = 0; r < 16; ++r) *(LAS unsigned short*)(simg + (32 * eb + crow16(r, hi)) * 128 + (32 * db + r32) * 2) = (unsigned short)(cvtpk(sacc[r], 0.f) & 0xffffu);
        __syncthreads();
        bf16x8 qn[4]; v4u gv[4];
        if (i < 7) {
#pragma unroll
            for (int ks = 0; ks < 4; ++ks) qn[ks] = *(const bf16x8*)(QO + (grow0 + 128 + 32 * qb + r32) * DM + colh + 16 * ks + 8 * hi); }
#pragma unroll
        for (int j = 0; j < 4; ++j) gv[j] = *(const v4u*)(Gt + (grow0 + 32 * qb + j * 8 + (lane >> 3)) * 512 + h * 64 + (lane & 7) * 8);
        f32x16 o0, o1;
#if PROBE_RG == 1
        f32x16 sacc_keep = sacc;
        for (int prb = 0; prb < 2; ++prb) { sacc = sacc_keep; asm volatile("" : "+v"(sacc));
#endif
        for (int r = 0; r < 16; ++r) { o0[r] = 0.f; o1[r] = 0.f; }
#pragma unroll
        for (int kb = 0; kb < 4; ++kb) if (kb <= qb) {
            f32x16 st; for (int r = 0; r < 16; ++r) st[r] = 0.f;
#pragma unroll
            for (int ks = 0; ks < 4; ++ks) st = MFMA32(*(const LAS bf16x8*)(base + (ks >> 1) * 8192 + (32 * kb + r32) * 64 + (16 * (ks & 1) + 8 * hi) * 2), qf[ks], st);
            if (kb == qb) {
#pragma unroll
                for (int r = 0; r < 16; ++r) if (crow16(r, hi) > r32) st[r] = 0.f;
            }
#pragma unroll
            for (int s = 0; s < 2; ++s) { v4u w; w.x = cvtpk(st[8 * s], st[8 * s + 1]); w.y = cvtpk(st[8 * s + 2], st[8 * s + 3]); w.z = cvtpk(st[8 * s + 4], st[8 * s + 5]); w.w = cvtpk(st[8 * s + 6], st[8 * s + 7]);
                const bf16x8 pk = __builtin_bit_cast(bf16x8, w); LAS unsigned char* vr_ = vb + (32 * kb + 16 * s) * 64;
                o0 = MFMA32(cat8(trd(vr_), trd(vr_ + 512)), pk, o0); o1 = MFMA32(cat8(trd(vr_ + 8192), trd(vr_ + 8192 + 512)), pk, o1); }
        }
#pragma unroll
        for (int ks = 0; ks < 4; ++ks) { o0 = MFMA32(*(const LAS bf16x8*)(simg + r32 * 128 + (16 * ks + 8 * hi) * 2), qf[ks], o0); o1 = MFMA32(*(const LAS bf16x8*)(simg + (32 + r32) * 128 + (16 * ks + 8 * hi) * 2), qf[ks], o1); }
        RG_STATE(sacc);
#pragma unroll
        for (int r = 0; r < 16; ++r) sacc[r] *= g128;
#if PROBE_RG == 1
        }
#endif
        __syncthreads();
        if (i < 7) RG_PUT(kr, vr);
        if (i < 6) RG_PREF(kr, vr, goff0 + (size_t)(i + 2) * 128 * DM);
#if PROBE_RG == 2
        for (int prb = 0; prb < 2; ++prb) { asm volatile("" : "+v"(o0), "+v"(o1));
#endif
        float sm = 0.f;
#pragma unroll
        for (int r = 0; r < 16; ++r) sm += o0[r] + o1[r];
        sm = pg8::halves_sum(sm); const float mu = sm * (1.0f / 64.0f); float vs = 0.f;
#pragma unroll
        for (int r = 0; r < 16; ++r) { const float d0 = o0[r] - mu, d1 = o1[r] - mu; vs += d0 * d0 + d1 * d1; }
        vs = pg8::halves_sum(vs); const float rstd = __builtin_amdgcn_rsqf(vs * (1.0f / 64.0f) + 1e-5f);
        typedef unsigned u32x2_ __attribute__((ext_vector_type(2)));
#pragma unroll
        for (int gg = 0; gg < 4; ++gg) {
            u32x2_ w0, w1; w0.x = cvtpk((o0[4 * gg] - mu) * rstd, (o0[4 * gg + 1] - mu) * rstd); w0.y = cvtpk((o0[4 * gg + 2] - mu) * rstd, (o0[4 * gg + 3] - mu) * rstd);
            w1.x = cvtpk((o1[4 * gg] - mu) * rstd, (o1[4 * gg + 1] - mu) * rstd); w1.y = cvtpk((o1[4 * gg + 2] - mu) * rstd, (o1[4 * gg + 3] - mu) * rstd);
            *(LAS u32x2_*)(stg + r32 * 136 + (8 * gg + 4 * hi) * 2) = w0; *(LAS u32x2_*)(stg + r32 * 136 + (32 + 8 * gg + 4 * hi) * 2) = w1; }
        LDS_WAIT(); asm volatile("" ::: "memory");
#pragma unroll
        for (int j = 0; j < 4; ++j) {
            const int row = j * 8 + (lane >> 3), ch = lane & 7; const u32x2_ a = *(LAS u32x2_*)(stg + row * 136 + ch * 16), bq = *(LAS u32x2_*)(stg + row * 136 + ch * 16 + 8);
            const v4u y = (v4u){a.x, a.y, bq.x, bq.y};
            pg8::f32x4 y0, y1, g0, g1_; pg8::unpack8(y, y0, y1); pg8::unpack8(gv[j], g0, g1_);
            *(v4u*)(OUT + (grow0 + 32 * qb + row) * DM + colh + ch * 8) = pg8::pack8(y0 * g0, y1 * g1_); }
        LDS_WAIT(); asm volatile("" ::: "memory");
#if PROBE_RG == 2
        }
#endif
        if (i < 7) {
#pragma unroll
            for (int ks = 0; ks < 4; ++ks) qf[ks] = qn[ks]; }
    }
}
#undef RG_PREF
#undef RG_PUT
#undef RG_STATE
struct FxItem { pg8::f32x4 f0, f1, h1, h2, w0, w1; };
__device__ __forceinline__ void fx_load(FxItem (&it)[3], const float* FIX, const float* HAL, const float* cw, int pm, int tid) {
#pragma unroll
    for (int k = 0; k < 3; ++k) { const int j = tid + k * (NWAVES * 64);
        if (j < 22 * 2 * 32) { const int c4 = (j & 31) * 4, r = (j >> 5) & 1, pn = j >> 6, unit = pm * 22 + pn; const size_t idx = (size_t)unit * 256 + r * 128 + c4; const int colg = pn * 128 + c4;
            it[k].f0 = *(const pg8::f32x4*)(FIX + idx * 2); it[k].f1 = *(const pg8::f32x4*)(FIX + idx * 2 + 4);
            it[k].h1 = *(const pg8::f32x4*)(HAL + ((size_t)(unit - 22) * 2 + 1) * 128 + c4); it[k].h2 = *(const pg8::f32x4*)(HAL + ((size_t)(unit - 22) * 2) * 128 + c4);
            it[k].w0 = *(const pg8::f32x4*)(cw + colg); it[k].w1 = *(const pg8::f32x4*)(cw + FF + colg); } }
}
__device__ __forceinline__ void fx_store(const FxItem (&it)[3], bf16* ACT, int pm, int tid) {
#pragma unroll
    for (int k = 0; k < 3; ++k) { const int j = tid + k * (NWAVES * 64);
        if (j < 22 * 2 * 32) { const int c4 = (j & 31) * 4, r = (j >> 5) & 1, pn = j >> 6, colg = pn * 128 + c4;
            const pg8::f32x4 yp = (pg8::f32x4){it[k].f0[0], it[k].f0[2], it[k].f1[0], it[k].f1[2]}, g = (pg8::f32x4){it[k].f0[1], it[k].f0[3], it[k].f1[1], it[k].f1[3]};
            const pg8::f32x4 y = (r == 0) ? yp + it[k].w1 * it[k].h1 + it[k].w0 * it[k].h2 : yp + it[k].w0 * it[k].h1;
            const pg8::f32x2 ga = pg8::gelu_pk((pg8::f32x2){y[0], y[1]}), gb = pg8::gelu_pk((pg8::f32x2){y[2], y[3]});
            typedef unsigned u32x2_ __attribute__((ext_vector_type(2)));
            u32x2_ o; o.x = cvtpk(ga.x * g[0], ga.y * g[1]); o.y = cvtpk(gb.x * g[2], gb.y * g[3]);
            *(u32x2_*)(ACT + (size_t)(pm * 256 + r) * FF + colg) = o; } }
}
__device__ __forceinline__ void ffn_fixup_own(const float* FIX, const float* HAL, const float* cw, bf16* ACT, const pg8::StaticOrder& S, int tid) {
    pg8::Unit u; int pms[4];
#pragma unroll
    for (int i = 0; i < 4; ++i) pms[i] = S.next(i, u) ? u.pm : 0;
    FxItem a[3], b[3];
    if (pms[0] & 31) fx_load(a, FIX, HAL, cw, pms[0], tid);
    if (pms[1] & 31) fx_load(b, FIX, HAL, cw, pms[1], tid);
    if (pms[0] & 31) fx_store(a, ACT, pms[0], tid);
    if (pms[2] & 31) fx_load(a, FIX, HAL, cw, pms[2], tid);
    if (pms[1] & 31) fx_store(b, ACT, pms[1], tid);
    if (pms[3] & 31) fx_load(b, FIX, HAL, cw, pms[3], tid);
    if (pms[2] & 31) fx_store(a, ACT, pms[2], tid);
    if (pms[3] & 31) fx_store(b, ACT, pms[3], tid);
    VM_WAIT(); __syncthreads();
    __builtin_amdgcn_fence(__ATOMIC_ACQUIRE, "agent");
}
__device__ __forceinline__ void final_task(const bf16* h, float* out, const float* ssq, const float* wf, int vcu, int wave, int lane) {
    constexpr int NGW = 32 * NWAVES; const int gw = (vcu >> 5) * SEQ + (vcu & 31) * NWAVES + wave, mend = ((vcu >> 5) + 1) * SEQ;
    pg8::f32x4 w[4];
#pragma unroll
    for (int j = 0; j < 4; ++j) w[j] = *(const pg8::f32x4*)(wf + (j >> 1) * 512 + lane * 8 + (j & 1) * 4);
    for (int m0 = gw; m0 < mend; m0 += 4 * NGW) {
        v4u hv[4][2]; float rs[4];
#pragma unroll
        for (int k = 0; k < 4; ++k) { const int m = m0 + k * NGW; rs[k] = pg8::row_rstd(ssq, m);
#pragma unroll
            for (int j = 0; j < 2; ++j) hv[k][j] = *(const v4u*)(h + (size_t)m * DM + j * 512 + lane * 8); }
#pragma unroll
        for (int k = 0; k < 4; ++k) { float* o = out + (size_t)(m0 + k * NGW) * DM;
#pragma unroll
            for (int j = 0; j < 2; ++j) { pg8::f32x4 v0, v1; pg8::unpack8(hv[k][j], v0, v1);
                __builtin_nontemporal_store(v0 * rs[k] * w[2 * j], (pg8::f32x4*)(o + j * 512 + lane * 8)); __builtin_nontemporal_store(v1 * rs[k] * w[2 * j + 1], (pg8::f32x4*)(o + j * 512 + lane * 8 + 4)); } } }
}

#ifndef STAGGER_TICKS_P7
#define STAGGER_TICKS_P7 0
#endif
__device__ __forceinline__ void stagger_wait(int bx, unsigned ticks) {
    if (ticks && ((bx >> 3) & 1)) { const unsigned long long t0 = __builtin_amdgcn_s_memrealtime(); while (__builtin_amdgcn_s_memrealtime() - t0 < ticks) __builtin_amdgcn_s_sleep(16); }
}
#define PH_BEGIN() int tq = tid_now(wvs); int zq = 0; asm volatile("" : "+v"(tq), "+v"(zq)); int mo_ = MISC_OFF + 44; asm volatile("" : "+v"(mo_));     int bx = __builtin_amdgcn_readfirstlane(*(volatile LAS int*)(ldsl + mo_)); asm volatile("" : "+s"(bx));     GAS unsigned char* wsg_ = (GAS unsigned char*)args.ws; asm volatile("" : "+s"(wsg_)); unsigned char* ws = (unsigned char*)wsg_;     \
    const int lq = tq & 63, wq = __builtin_amdgcn_readfirstlane(tq >> 6), gtq = bx * (NWAVES * 64) + tq, vcu = (G % 8 == 0) ? (bx % 8) * (G / 8) + bx / 8 : bx, gw = vcu * NWAVES + wq; (void)lq; (void)wq; (void)gtq; (void)gw
#ifndef DEPH_ODD
#define DEPH_ODD (bx & 1)
#endif
#define SSQB(n) ((float*)(ws + (((n) & 1) ? WS_SSQ1 : WS_SSQ0)))
__global__ void __launch_bounds__(NWAVES * 64, 2) fwd(Args args) {
    extern __shared__ __attribute__((aligned(16))) unsigned char lds[];
    LAS unsigned char* ldsl = (LAS unsigned char*)lds;
    const int wvs = __builtin_amdgcn_readfirstlane((int)threadIdx.x >> 6);
    volatile LAS unsigned* MISC = (volatile LAS unsigned*)(ldsl + MISC_OFF);
    const int G = gridDim.x;
    const int NGW = G * NWAVES, GT = G * NWAVES * 64;
    for (int u = threadIdx.x; u < (LDS_BYTES - LDSCTL_OFF) / 4; u += NWAVES * 64) ((LAS unsigned*)(ldsl + LDSCTL_OFF))[u] = 0u;
    if (args.ph_lo == 0 && threadIdx.x == 0) {
#pragma unroll
        for (int k = 0; k < 15; ++k) ((unsigned long long*)((unsigned*)(args.ws + WS_CTL) + CW_TAB))[k] = (unsigned long long)args.in[k]; }
    __syncthreads();
#if MK_ONE_LAUNCH
    constexpr int lo = 0, hi = NPH;
#else
    const int lo = args.ph_lo, hi = args.ph_hi;
#endif
    if (threadIdx.x == 0) MISC[11] = blockIdx.x;
    __syncthreads();
    XcdBarrier bar; bar.bar = (unsigned*)(args.ws + WS_CTL) + CW_BAR; bar.x = 0; bar.st = nullptr;
    if (hi - lo > 1) bar = xcd_barrier_post((unsigned*)(args.ws + WS_CTL) + CW_BAR, MISC + 8);
#ifndef ONLY
#define ONLY -1
#endif
#define PON(j) (ONLY < 0 || ONLY == (j))
#define IN(k) (lo <= (k) && (k) < hi)
#define SEAM(k, glob) do { if (IN(k) && IN((k) + 1)) { xcd_barrier(bar, (glob) || !MK_ONE_LAUNCH, wvs); if (PROBE_DUP == 15) xcd_barrier(bar, (glob) || !MK_ONE_LAUNCH, wvs); } } while (0)

    for (int rep = 0; rep < NREP(10); ++rep) if (PON(0) && IN(0)) { PH_BEGIN(); prologue(ws, zq, ldsl, gw, NGW, wq, lq, gtq, GT); }
    SEAM(0, true);

    for (int L = 0; L < DEPTH; ++L) {
        const int p0 = 1 + 9 * L;
        for (int rep = 0; rep < NREP(1); ++rep) if (PON(1) && IN(p0)) {
            PH_BEGIN();
            const bf16* hin = (const bf16*)(ws + ((L == 0) ? WS_HB : WS_HBT));
            flogit_task(hin, (const bf16*)(ws + WS_WFB) + (size_t)L * 8 * DM, SSQB(3 * L), INP(4) + L * NFH, (float*)(ws + WS_LF), G, vcu, wq, lq);
            if DEPH_ODD pb_task(INP(1) + (size_t)L * M * PLE, (bf16*)(ws + WS_PB), vcu, tq);
            pg8::Gemm g{hin, (const bf16*)(ws + WS_W + (size_t)L * W_LAYER + WO_IN), M, NIN, DM}; pg8::StaticOrder S; S.init(M, NIN, G, bx);
            pg8::EpiIn E{(bf16*)(ws + WS_QO), (bf16*)(ws + WS_KK), (bf16*)(ws + WS_VV), (bf16*)(ws + WS_G), SSQB(3 * L), (const float*)(ws + WS_CS), (float*)(ws + WS_NRM)};
            pg8::gemm_phase<pg8::EpiIn, pg8::StaticOrder, PG8_ALIGN, PG8_SP2, PROBE_KDUP == 1, PROBE_EDUP == 1>(ldsl, g, S, E, wvs);
            if (!DEPH_ODD) pb_task(INP(1) + (size_t)L * M * PLE, (bf16*)(ws + WS_PB), vcu, tq);
        }
        SEAM(p0, false);
        for (int rep = 0; rep < NREP(2); ++rep) if (PON(2) && IN(p0 + 1)) {
            PH_BEGIN();
            for (int rp2 = 0; rp2 < NREP(13); ++rp2) { cumsum_task((const float*)(ws + WS_LF), (float*)(ws + WS_CB), (LAS float*)ldsl, vcu, tq);
            qknorm_task((const float*)(ws + WS_NRM), (unsigned*)(ws + WS_CTL) + CW_QK + L * 128, gw, NGW, lq); }
            __syncthreads();
            ret_group_state(ldsl, (const bf16*)(ws + WS_KK), (const bf16*)(ws + WS_VV), (float*)(ws + WS_U), vcu, tq);
        }
        SEAM(p0 + 1, false);
        if (PON(3) && IN(p0 + 2)) {
            PH_BEGIN();
#pragma unroll 1
            for (int rep = 0; rep < NREP(4); ++rep) {
            ret_group_out(ldsl, (const bf16*)(ws + WS_QO), (PROBE_DUP == 4 && rep == 0) ? (bf16*)args.out : (bf16*)(ws + WS_QO), (const bf16*)(ws + WS_KK), (const bf16*)(ws + WS_VV), (const bf16*)(ws + WS_G), (const float*)(ws + WS_U), vcu, tq);
            __syncthreads(); }
            for (int rep = 0; rep < NREP(3); ++rep) {
            const attn_body::AttnTensors AT{(const attn_body::bf16*)(ws + WS_QO), (const attn_body::bf16*)(ws + WS_KK), (const attn_body::bf16*)(ws + WS_VV), (PROBE_DUP == 3 && rep == 0) ? (attn_body::bf16*)args.out : (attn_body::bf16*)(ws + WS_QO)};
            const attn_body::StaticOrder S(G, bx);
            attn_body::attn_phase<attn_body::StaticOrder>((char*)lds, AT, (const float*)(ws + WS_CB), (const float*)(ws + WS_CTL) + CW_QK + L * 128, S, wvs);
            __syncthreads(); }
        }
        SEAM(p0 + 2, false);
        for (int rep = 0; rep < NREP(5); ++rep) if (PON(5) && IN(p0 + 4)) {
            PH_BEGIN(); const bool dmy = (PROBE_DUP == 5 && rep == 0);
            pg8::Gemm g{(const bf16*)(ws + WS_QO), (const bf16*)(ws + WS_W + (size_t)L * W_LAYER + WO_OUT), M, DM, DM}; pg8::StaticOrder S; S.init(M, DM, G, bx);
            pg8::EpiRes<0> E{(const bf16*)(ws + ((L == 0) ? WS_HB : WS_HBT)), (bf16*)(ws + (dmy ? WS_X + 384 * MiB : WS_HB)), dmy ? SSQB(3 * L) : SSQB(3 * L + 1), nullptr, nullptr};
            pg8::gemm_phase<pg8::EpiRes<0>, pg8::StaticOrder, PG8_ALIGN, PG8_SP2, PROBE_KDUP == 5, PROBE_EDUP == 5>(ldsl, g, S, E, wvs);
            { VM_WAIT(); __syncthreads();
              pg8::Gemm g2{(const bf16*)(ws + WS_PB), (const bf16*)(ws + WS_W + (size_t)L * W_LAYER + WO_PROJ), M, DM, PLE}; pg8::StaticOrder S2; S2.init(M, DM, G, bx);
              pg8::EpiScaleBf16<false> E2{PP_BASE, DM, nullptr};
              pg8::gemm_phase<pg8::EpiScaleBf16<false>, pg8::StaticOrder, PG8_ALIGN, PG8_SP2>(ldsl, g2, S2, E2, wvs); }
        }
        SEAM(p0 + 4, false);
        for (int rep = 0; rep < NREP(6); ++rep) if (PON(6) && IN(p0 + 5)) {
            PH_BEGIN();
            pg8::Gemm g{(const bf16*)(ws + WS_HB), (const bf16*)(ws + WS_W + (size_t)L * W_LAYER + WO_A), M, 2 * FF, DM}; pg8::StaticOrder S; S.init(M, 2 * FF, G, bx);
            pg8::EpiFfnUp E{(bf16*)(ws + WS_ACT), SSQB(3 * L + 1), INP(8) + (size_t)L * 3 * FF, INP(9) + (size_t)L * FF, (float*)(ws + WS_FIX), (float*)(ws + WS_HAL), (LAS float*)(ldsl + LDSCTL_OFF + 1024)};
            pg8::gemm_phase<pg8::EpiFfnUp, pg8::StaticOrder, true, PG8_SP2, PROBE_KDUP == 6, PROBE_EDUP == 6>(ldsl, g, S, E, wvs);
        }
        SEAM(p0 + 5, false);
        if (PON(8) && IN(p0 + 7)) {
            PH_BEGIN();
            pg8::Gemm g{(const bf16*)(ws + WS_ACT), (const bf16*)(ws + WS_W + (size_t)L * W_LAYER + WO_DOWN), M, DM, FF}; pg8::StaticOrder S; S.init(M, DM, G, bx, 1);
            ffn_fixup_own((const float*)(ws + WS_FIX), (const float*)(ws + WS_HAL), INP(8) + (size_t)L * 3 * FF, (bf16*)(ws + WS_ACT), S, tq);
            pg8::EpiRes<0> E{(const bf16*)(ws + WS_HB), (bf16*)(ws + WS_HB), SSQB(3 * L + 2), nullptr, nullptr};
            pg8::gemm_phase<pg8::EpiRes<0>, pg8::StaticOrder, PG8_ALIGN, PG8_SP2, PROBE_KDUP == 8, PROBE_EDUP == 8>(ldsl, g, S, E, wvs);
        }
        SEAM(p0 + 7, false);
        if (PON(9) && IN(p0 + 8) && L + 1 < DEPTH) { PH_BEGIN(); if DEPH_ODD { convert_layer(ws, zq, ldsl, L + 1, gw, NGW, wq, lq); __syncthreads(); } }
        for (int rep = 0; rep < NREP(9); ++rep) if (PON(9) && IN(p0 + 8)) {
            PH_BEGIN(); const bool dmy = (PROBE_DUP == 9 && rep == 0);
            pg8::Gemm g{(const bf16*)(ws + WS_HB), (const bf16*)(ws + WS_W + (size_t)L * W_LAYER + WO_GATE), M, DM, DM}; pg8::StaticOrder S; S.init(M, DM, G, bx);
            pg8::EpiRes<1> E{(const bf16*)(ws + WS_HB), (bf16*)(ws + (dmy ? WS_X + 384 * MiB : WS_HBT)), dmy ? (float*)(ws + WS_X + 512 * MiB) : SSQB(3 * L + 3), SSQB(3 * L + 2), PP_BASE};
            pg8::gemm_phase<pg8::EpiRes<1>, pg8::StaticOrder, PG8_ALIGN, PG8_SP2, PROBE_KDUP == 9, PROBE_EDUP == 9>(ldsl, g, S, E, wvs);
        }
        if (PON(9) && IN(p0 + 8) && L + 1 < DEPTH) { PH_BEGIN(); if (!DEPH_ODD) { __syncthreads(); convert_layer(ws, zq, ldsl, L + 1, gw, NGW, wq, lq); __syncthreads(); } }
        SEAM(p0 + 8, L + 1 < DEPTH);
    }
    if (PON(10) && IN(NPH - 1)) { PH_BEGIN(); final_task((const bf16*)(ws + WS_HBT), args.out, SSQB(3 * DEPTH), INP(14), vcu, wq, lq); }
#undef IN
#undef SEAM
}

extern "C" void kernel_launch(void* const* d_in, const int* in_sizes, int n_in, void* d_out, int out_size, void* d_ws, size_t ws_size, hipStream_t stream) {
    static int grid = 0;
    if (grid == 0) {
        if (n_in != 15 || out_size != M * DM || ws_size < WS_END) { fprintf(stderr, "kernel_launch: unexpected sizes (n_in %d, out %d, ws %zu)\n", n_in, out_size, ws_size); grid = -1; return; }
        if (hipFuncSetAttribute((const void*)fwd, hipFuncAttributeMaxDynamicSharedMemorySize, LDS_BYTES) != hipSuccess) { fprintf(stderr, "kernel_launch: hipFuncSetAttribute failed\n"); grid = -1; return; }
        int dev = 0, cus = 0, per_cu = 0;
        (void)hipGetDevice(&dev); (void)hipDeviceGetAttribute(&cus, hipDeviceAttributeMultiprocessorCount, dev);
        if (hipOccupancyMaxActiveBlocksPerMultiprocessor(&per_cu, (const void*)fwd, NWAVES * 64, LDS_BYTES) != hipSuccess || per_cu < 1) fprintf(stderr, "kernel_launch: occupancy query says %d\n", per_cu);
        (void)hipGetLastError();
        grid = 256;
        if (cus != 256) fprintf(stderr, "kernel_launch: device has %d CUs; this kernel's unit maps are built for 256\n", cus);
    }
    if (grid < 0) return;
    (void)hipMemsetAsync((char*)d_ws + WS_CTL, 0, CTL_ZERO_BYTES, stream);
    Args a{};
    for (int i = 0; i < 15; ++i) a.in[i] = (const float*)d_in[i];
    a.out = (float*)d_out; a.ws = (unsigned char*)d_ws;
#if MK_ONE_LAUNCH
    a.ph_lo = 0; a.ph_hi = NPH;
    hipLaunchKernelGGL(fwd, dim3(grid), dim3(NWAVES * 64), LDS_BYTES, stream, a);
#else
    for (int ph = 0; ph < NPH; ++ph) { a.ph_lo = ph; a.ph_hi = ph + 1; hipLaunchKernelGGL(fwd, dim3(grid), dim3(NWAVES * 64), LDS_BYTES, stream, a); }
#endif
}
```

```cpp
#include <hip/hip_runtime.h>
#include <cstdio>
#include <cstdint>
__device__ __forceinline__ int tid_now(int wv) { unsigned m1 = ~0u; asm volatile("" : "+s"(m1)); return (wv << 6) | (int)__builtin_amdgcn_mbcnt_hi(m1, __builtin_amdgcn_mbcnt_lo(m1, 0u)); }
namespace pg8 {
#define PG8_LAS __attribute__((address_space(3)))
typedef unsigned short bf16_t;
typedef short bf16x8 __attribute__((ext_vector_type(8)));
typedef float f32x4 __attribute__((ext_vector_type(4)));
typedef unsigned u32x4 __attribute__((ext_vector_type(4)));
constexpr int BM = 256, BK = 64, HALF = 128, HTB = HALF * BK * 2  , STAGE_BYTES = 8 * HTB, NXCD = 8, WGM = 8;

__host__ __device__ __forceinline__ int lds_byte(int r, int c) { const int st = (r >> 4) * 2 + (c >> 5), rr = r & 15, cc = c & 31, ob = rr * 64 + cc * 2; return st * 1024 + (ob ^ (((ob >> 9) & 1) << 5)); }
__host__ __device__ __forceinline__ void stage_rc(int b, int& R, int& C) { const int st = b / 1024, sb = b % 1024, swz = sb ^ (((sb >> 9) & 1) << 5); R = (st >> 1) * 16 + swz / 64; C = (st & 1) * 32 + (swz % 64) / 2; }
__host__ __device__ __forceinline__ int perm32(int rho) { const int n = rho >> 4, i = rho & 15; return 8 * (i >> 2) + 4 * n + (i & 3); }

struct Unit { int pm, pn; };
struct Gemm { const bf16_t* A; const bf16_t* Bt; int M, N, K; };

struct StaticOrder {
    int nM, nN, nwg, G, c, rev;
    __host__ __device__ void init(int M, int N, int G_, int c_, int rev_ = 0) { nM = M / BM; nN = N / BM; nwg = nM * nN; G = G_; c = c_; rev = rev_; }
    __host__ __device__ bool next(int i, Unit& u) const {
        const int nr = (nwg + G - 1) / G; if (i >= nr) return false;
        const long L = (long)(rev ? nr - 1 - i : i) * G + c; if (L >= nwg) return false;
        int wgid = (int)L; { const int q = nwg / NXCD, r = nwg % NXCD, xcd = wgid % NXCD, off = wgid / NXCD; wgid = (xcd < r ? xcd * (q + 1) : r * (q + 1) + (xcd - r) * q) + off; }
        const int nig = WGM * nN, gid = wgid / nig, fm = gid * WGM, gsz = (nM - fm) < WGM ? (nM - fm) : WGM;
        u.pm = fm + ((wgid % nig) % gsz); u.pn = (wgid % nig) / gsz; return true;
    }
    __device__ __forceinline__ void a_ready(const Unit&) const {}
    __device__ __forceinline__ void done(const Unit&) const {}
};

__device__ __forceinline__ unsigned cvt_pk_bf16(float lo, float hi) { unsigned r; asm volatile("v_cvt_pk_bf16_f32 %0, %1, %2" : "=v"(r) : "v"(lo), "v"(hi)); return r; }
typedef float f32x2 __attribute__((ext_vector_type(2)));
__device__ __forceinline__ f32x2 gelu_pk(f32x2 v) {
    f32x2 vc; vc.x = __builtin_amdgcn_fmed3f(v.x, -5.656854249f, 5.656854249f); vc.y = __builtin_amdgcn_fmed3f(v.y, -5.656854249f, 5.656854249f);
    const f32x2 v2 = vc * vc;
    f32x2 p = v2 * (-1.505995060e-12f) + 3.061199413e-10f; p = p * v2 + (-4.642651039e-08f); p = p * v2 + (-2.515756171e-06f); p = p * v2 + (-6.496460735e-05f); p = p * v2 + (-5.223043901e-04f); p = p * v2 + (-5.690807158e-03f);
    f32x2 q = v2 * (-9.103794904e-07f) + (-2.667175691e-05f); q = q * v2 + (-4.207067436e-04f); q = q * v2 + (-3.686664584e-03f); q = q * v2 + (-1.426473905e-02f);
    f32x2 r; r.x = __builtin_amdgcn_rcpf(q.x); r.y = __builtin_amdgcn_rcpf(q.y);
    const f32x2 t = (vc * p) * r + 0.5f;
    return v * t;
}

template <int ACT  > struct EpiBf16 {
    static constexpr bool PERM = true, AFTER_DRAIN = false; static_assert(ACT == 0 || ACT == 1, "EpiBf16: ACT is 0 (none) or 1 (gelu_pk)");
    bf16_t* O; int ldc; const float* bias; int split_cols; size_t split_stride; float scale0;
    __device__ __forceinline__ void operator()(const f32x4 (&acc)[2][2][4][2], const Unit& u, int wr, int wc, int fr, int fq) const {
        const int row0 = u.pm * BM + wr * 64 + fr; int colt = u.pn * BM; bf16_t* base = O;
        float sc = 1.f; if (split_cols) { const int t = colt / split_cols; base += (size_t)t * split_stride; colt -= t * split_cols; if (t == 0) sc = scale0; }
        const int col0 = colt + wc * 32 + 8 * fq, bcol0 = u.pn * BM + wc * 32 + 8 * fq;
        f32x4 bv[2][2];
#pragma unroll
        for (int bj = 0; bj < 2; ++bj)
#pragma unroll
            for (int n = 0; n < 2; ++n) bv[bj][n] = bias ? *(const f32x4*)(bias + bcol0 + bj * HALF + 4 * n) : (f32x4){0.f, 0.f, 0.f, 0.f};
#pragma unroll
        for (int ai = 0; ai < 2; ++ai)
#pragma unroll
            for (int m = 0; m < 4; ++m) { bf16_t* rowp = base + (size_t)(row0 + ai * HALF + m * 16) * ldc + col0;
#pragma unroll
                for (int bj = 0; bj < 2; ++bj) { f32x4 v0 = acc[ai][bj][m][0] + bv[bj][0], v1 = acc[ai][bj][m][1] + bv[bj][1];
                    if (ACT == 1) { f32x2 a = gelu_pk((f32x2){v0[0], v0[1]}), b = gelu_pk((f32x2){v0[2], v0[3]}), c = gelu_pk((f32x2){v1[0], v1[1]}), d = gelu_pk((f32x2){v1[2], v1[3]});
                        v0 = (f32x4){a.x, a.y, b.x, b.y}; v1 = (f32x4){c.x, c.y, d.x, d.y}; }
                    v0 = v0 * sc; v1 = v1 * sc; u32x4 w; w.x = cvt_pk_bf16(v0[0], v0[1]); w.y = cvt_pk_bf16(v0[2], v0[3]); w.z = cvt_pk_bf16(v1[0], v1[1]); w.w = cvt_pk_bf16(v1[2], v1[3]);
                    *(u32x4*)(rowp + bj * HALF) = w; } }
    }
};
constexpr float ATT_C2 = 0.125f * 1.4426950408889634f;
constexpr float RMS_EPS = 1e-6f;
__device__ __forceinline__ float lg2gamma(int h) { const float x = __builtin_amdgcn_exp2f(-5.0f - (float)h);
    return -x * (1.0f + x * (0.5f + x * (0.33333334f + x * (0.25f + x * (0.2f + x * 0.16666667f))))) * 1.4426950408889634f; }
__device__ __forceinline__ float xor16f(float v) { return __int_as_float(__builtin_amdgcn_ds_swizzle(__float_as_int(v), 0x401F)); }
__device__ __forceinline__ float halves_sum(float v) { const auto rr = __builtin_amdgcn_permlane32_swap(__float_as_uint(v), __float_as_uint(v), false, false); return __uint_as_float(rr[0]) + __uint_as_float(rr[1]); }
__device__ __forceinline__ float row_rstd(const float* ssq16, int row) {
    const f32x4* p = (const f32x4*)(ssq16 + (size_t)row * 16);
    const f32x4 a = p[0], b = p[1], c = p[2], d = p[3];
    const float s = (((a[0] + a[1]) + (a[2] + a[3])) + ((b[0] + b[1]) + (b[2] + b[3]))) + (((c[0] + c[1]) + (c[2] + c[3])) + ((d[0] + d[1]) + (d[2] + d[3])));
    return __builtin_amdgcn_rsqf(s * (1.0f / 1024.0f) + RMS_EPS);
}
__device__ __forceinline__ float row_rstd4(const float* ssq16, int row, int fq) {
    const f32x4 a = *(const f32x4*)(ssq16 + (unsigned)(row * 16 + 4 * fq));
    float s = (a[0] + a[1]) + (a[2] + a[3]); s += xor16f(s); s = halves_sum(s);
    return __builtin_amdgcn_rsqf(s * (1.0f / 1024.0f) + RMS_EPS);
}
__device__ __forceinline__ u32x4 pack8(const f32x4& v0, const f32x4& v1) { u32x4 w; w.x = cvt_pk_bf16(v0[0], v0[1]); w.y = cvt_pk_bf16(v0[2], v0[3]); w.z = cvt_pk_bf16(v1[0], v1[1]); w.w = cvt_pk_bf16(v1[2], v1[3]); return w; }
__device__ __forceinline__ float bf_lo(unsigned w) { return __uint_as_float(w << 16); }
__device__ __forceinline__ float bf_hi(unsigned w) { return __uint_as_float(w & 0xffff0000u); }
__device__ __forceinline__ void unpack8(const u32x4& w, f32x4& v0, f32x4& v1) { v0 = (f32x4){bf_lo(w.x), bf_hi(w.x), bf_lo(w.y), bf_hi(w.y)}; v1 = (f32x4){bf_lo(w.z), bf_hi(w.z), bf_lo(w.w), bf_hi(w.w)}; }
__device__ __forceinline__ float sigmoidf_(float x) { return __builtin_amdgcn_rcpf(1.0f + __expf(-x)); }

struct EpiIn {
    static constexpr bool PERM = true, AFTER_DRAIN = false;
    bf16_t *QO, *KK, *VV, *G; const float* ssq; const float* cs; float* nrm;
    template <int TYPE> __device__ __forceinline__ void run(const f32x4 (&acc)[2][2][4][2], const Unit& u, int wr, int wc, int fr, int fq) const {
        const int half = u.pn & 1, row0 = u.pm * BM + wr * 64 + fr, csub0 = half * 256 + wc * 32 + 8 * fq, jj = 4 * (wc & 1) + fq;
        float lgv[2] = {0.f, 0.f};
        if (TYPE == 3 || TYPE == 4) { lgv[0] = lg2gamma(csub0 >> 6); lgv[1] = lg2gamma((csub0 + 128) >> 6); }
        float rsa[2][4]; f32x4 cva[2][4], sva[2][4];
#pragma unroll
        for (int ai = 0; ai < 2; ++ai)
#pragma unroll
            for (int m = 0; m < 4; ++m) { const int row = row0 + ai * HALF + m * 16; rsa[ai][m] = row_rstd4(ssq, row, fq);
                if (TYPE == 3 || TYPE == 4) { const int pos = row & 8191; cva[ai][m] = *(const f32x4*)(cs + pos * 32 + 4 * jj); sva[ai][m] = *(const f32x4*)(cs + 8192 * 32 + pos * 32 + 4 * jj); } }
#pragma unroll
        for (int ai = 0; ai < 2; ++ai)
#pragma unroll
            for (int m = 0; m < 4; ++m) {
                const int row = row0 + ai * HALF + m * 16; const float rs = rsa[ai][m];
                f32x4 cv = (f32x4){0.f, 0.f, 0.f, 0.f}, sv = cv; float i1 = 0.f;
                if (TYPE == 3 || TYPE == 4) { cv = cva[ai][m]; sv = sva[ai][m]; i1 = (float)((row & 127) + 1); }
#pragma unroll
                for (int bj = 0; bj < 2; ++bj) {
                    f32x4 v0 = acc[ai][bj][m][0] * rs, v1 = acc[ai][bj][m][1] * rs;
                    const int csub = csub0 + bj * 128; bf16_t* dst;
                    if (TYPE == 0) { v0 = v0 * ATT_C2; v1 = v1 * ATT_C2; dst = QO + (unsigned)(row * 1024 + csub); }
                    else if (TYPE == 1) dst = KK + (unsigned)(row * 1024 + csub);
                    if (TYPE == 0 || TYPE == 1) { float s = ((v0[0] * v0[0] + v0[1] * v0[1]) + (v0[2] * v0[2] + v0[3] * v0[3])) + ((v1[0] * v1[0] + v1[1] * v1[1]) + (v1[2] * v1[2] + v1[3] * v1[3]));
                        s += xor16f(s); s = halves_sum(s); if (fq == 0) nrm[(unsigned)(TYPE * (65536 * 16) + row * 16 + (csub >> 6) * 2 + (wc & 1))] = s; }
                    else if (TYPE == 2) dst = VV + (unsigned)(row * 1024 + csub);
                    else if (TYPE == 3 || TYPE == 4) {
                        const f32x4 o0 = v0 * cv - v1 * sv, o1 = v0 * sv + v1 * cv;
                        const float lg = lgv[bj];
                        const float f = (TYPE == 3) ? __builtin_amdgcn_exp2f(i1 * lg) : 0.125f * __builtin_amdgcn_exp2f(-i1 * lg);
                        v0 = o0 * f; v1 = o1 * f; dst = (TYPE == 3 ? QO : KK) + (unsigned)(row * 1024 + 512 + csub);
                    }
                    else if (TYPE == 5) dst = VV + (unsigned)(row * 1024 + 512 + csub);
                    else {
#pragma unroll
                        for (int i = 0; i < 4; ++i) { v0[i] = v0[i] * sigmoidf_(v0[i]); v1[i] = v1[i] * sigmoidf_(v1[i]); }
                        dst = G + (unsigned)(row * 512 + csub);
                    }
                    *(u32x4*)dst = pack8(v0, v1);
                }
            }
    }
    __device__ __forceinline__ void operator()(const f32x4 (&acc)[2][2][4][2], const Unit& u, int wr, int wc, int fr, int fq) const {
        switch (u.pn >> 1) { case 0: run<0>(acc, u, wr, wc, fr, fq); break; case 1: run<1>(acc, u, wr, wc, fr, fq); break; case 2: run<2>(acc, u, wr, wc, fr, fq); break; case 3: run<3>(acc, u, wr, wc, fr, fq); break;
            case 4: run<4>(acc, u, wr, wc, fr, fq); break; case 5: run<5>(acc, u, wr, wc, fr, fq); break; default: run<6>(acc, u, wr, wc, fr, fq); break; }
    }
};

template <int MODE> struct EpiRes {
    static constexpr bool PERM = true, AFTER_DRAIN = false;
    const bf16_t* hin; bf16_t* hout; float* ssqw; const float* ssqr; const bf16_t* pp;
    __device__ __forceinline__ void operator()(const f32x4 (&acc)[2][2][4][2], const Unit& u, int wr, int wc, int fr, int fq) const {
        const int row0 = u.pm * BM + wr * 64 + fr, col0 = u.pn * BM + wc * 64 + 8 * fq;
#define ER_OFF(ai, m, bj) ((unsigned)((row0 + (ai) * HALF + (m) * 16) * 1024 + col0 + (bj) * 32))
#define ER_DO(ai, m, HV, PV, RS) do { float sq = 0.f; \
            _Pragma("unroll") for (int bj = 0; bj < 2; ++bj) { f32x4 h0, h1; unpack8(HV[bj], h0, h1); f32x4 a0 = acc[ai][bj][m][0], a1 = acc[ai][bj][m][1]; \
                if (MODE == 1) { f32x4 p0, p1; unpack8(PV[bj], p0, p1); _Pragma("unroll") for (int i = 0; i < 4; ++i) { a0[i] = sigmoidf_(a0[i] * (RS)) * p0[i]; a1[i] = sigmoidf_(a1[i] * (RS)) * p1[i]; } } \
                const f32x4 v0 = h0 + a0, v1 = h1 + a1; *(u32x4*)(hout + ER_OFF(ai, m, bj)) = pack8(v0, v1); \
                sq += ((v0[0] * v0[0] + v0[1] * v0[1]) + (v0[2] * v0[2] + v0[3] * v0[3])) + ((v1[0] * v1[0] + v1[1] * v1[1]) + (v1[2] * v1[2] + v1[3] * v1[3])); } \
            sq += xor16f(sq); sq = halves_sum(sq); if (fq == 0) ssqw[(unsigned)((row0 + (ai) * HALF + (m) * 16) * 16 + u.pn * 4 + wc)] = sq; } while (0)
        float rs[2][4];
#pragma unroll
        for (int ai = 0; ai < 2; ++ai)
#pragma unroll
            for (int m = 0; m < 4; ++m) rs[ai][m] = (MODE == 1) ? row_rstd4(ssqr, row0 + ai * HALF + m * 16, fq) : 1.f;
        constexpr int NS = (MODE == 1) ? 4 : 8;
        u32x4 hv[NS][2], pv[(MODE == 1) ? NS : 1][2];
#define ER_LD(g, s) do { _Pragma("unroll") for (int bj = 0; bj < 2; ++bj) { hv[s][bj] = *(const u32x4*)(hin + ER_OFF((g) >> 2, (g) & 3, bj)); if (MODE == 1) pv[s][bj] = *(const u32x4*)(pp + ER_OFF((g) >> 2, (g) & 3, bj)); } } while (0)
#define ER_B(g, s) ER_DO((g) >> 2, (g) & 3, hv[s], pv[(MODE == 1) ? (s) : 0], rs[(g) >> 2][(g) & 3])
#pragma unroll
        for (int g = 0; g < NS; ++g) ER_LD(g, g);
#pragma unroll
        for (int g = 0; g < 8; ++g) { ER_B(g, g % NS); if (g + NS < 8) ER_LD(g + NS, g % NS); }
#undef ER_LD
#undef ER_B
#undef ER_OFF
#undef ER_DO
    }
};

template <bool SCALE> struct EpiScaleBf16 {
    static constexpr bool PERM = true, AFTER_DRAIN = false;
    bf16_t* O; int ldo; const float* ssq;
    __device__ __forceinline__ void operator()(const f32x4 (&acc)[2][2][4][2], const Unit& u, int wr, int wc, int fr, int fq) const {
        const int row0 = u.pm * BM + wr * 64 + fr, col0 = u.pn * BM + wc * 32 + 8 * fq;
#pragma unroll
        for (int ai = 0; ai < 2; ++ai)
#pragma unroll
            for (int m = 0; m < 4; ++m) {
                const int row = row0 + ai * HALF + m * 16; const float rs = SCALE ? row_rstd4(ssq, row, fq) : 1.f;
#pragma unroll
                for (int bj = 0; bj < 2; ++bj) *(u32x4*)(O + (unsigned)(row * ldo + col0 + bj * HALF)) = pack8(acc[ai][bj][m][0] * rs, acc[ai][bj][m][1] * rs);
            }
    }
};

__device__ __forceinline__ unsigned dpp_sh1(unsigned prev, unsigned cur) {
    const unsigned t = (unsigned)__builtin_amdgcn_update_dpp(0, (int)prev, 0x121  , 0xF, 0xF, false);
    return (unsigned)__builtin_amdgcn_update_dpp((int)t, (int)cur, 0x111  , 0xF, 0xF, false); }
__device__ __forceinline__ unsigned dpp_sh2(unsigned prev, unsigned cur) {
    const unsigned t = (unsigned)__builtin_amdgcn_update_dpp(0, (int)prev, 0x122  , 0xF, 0xF, false);
    return (unsigned)__builtin_amdgcn_update_dpp((int)t, (int)cur, 0x112  , 0xF, 0xF, false); }
__device__ __forceinline__ float dppf_ror1(float v) { return __uint_as_float((unsigned)__builtin_amdgcn_mov_dpp((int)__float_as_uint(v), 0x121  , 0xF, 0xF, false)); }
__device__ __forceinline__ float dppf_ror2(float v) { return __uint_as_float((unsigned)__builtin_amdgcn_mov_dpp((int)__float_as_uint(v), 0x122  , 0xF, 0xF, false)); }
__device__ __forceinline__ float dppf_shr1_keep(float old, float cur) { return __uint_as_float((unsigned)__builtin_amdgcn_update_dpp((int)__float_as_uint(old), (int)__float_as_uint(cur), 0x111  , 0xF, 0xF, false)); }
__device__ __forceinline__ float dppf_shr2_keep(float old, float cur) { return __uint_as_float((unsigned)__builtin_amdgcn_update_dpp((int)__float_as_uint(old), (int)__float_as_uint(cur), 0x112  , 0xF, 0xF, false)); }
__device__ __forceinline__ float dppf_sh1(float prev, float cur) { return __uint_as_float(dpp_sh1(__float_as_uint(prev), __float_as_uint(cur))); }
__device__ __forceinline__ float dppf_sh2(float prev, float cur) { return __uint_as_float(dpp_sh2(__float_as_uint(prev), __float_as_uint(cur))); }
struct EpiFfnUp {
    static constexpr bool PERM = true, AFTER_DRAIN = false;
    bf16_t* O; const float* ssq; const float* cw; const float* cb; float* FIX; float* HAL; PG8_LAS float* xch;
    __device__ __forceinline__ void operator()(const f32x4 (&acc)[2][2][4][2], const Unit& u, int wr, int wc, int fr, int fq) const {
        constexpr int FF = 2816;
        const int grow = u.pm * BM + wr * 64, row0 = grow + fr, colL = wc * 32 + 8 * fq, col0 = u.pn * 128 + colL, unit = u.pm * 22 + u.pn;
        float rs[2][4];
#pragma unroll
        for (int ai = 0; ai < 2; ++ai)
#pragma unroll
            for (int m = 0; m < 4; ++m) rs[ai][m] = row_rstd4(ssq, row0 + ai * HALF + m * 16, fq);
        if (fr >= 14) {
#pragma unroll
            for (int ai = 0; ai < 2; ++ai) { const f32x4 v0 = acc[ai][0][3][0] * rs[ai][3], v1 = acc[ai][0][3][1] * rs[ai][3];
                PG8_LAS float* x = xch + ((((ai * 2 + wr) * 4 + wc) * 2 + (fr - 14)) * 4 + fq) * 8; *(PG8_LAS f32x4*)x = v0; *(PG8_LAS f32x4*)(x + 4) = v1;
                if (ai == 1 && wr == 1) { float* h = HAL + ((size_t)unit * 2 + (fr - 14)) * 128 + colL; *(f32x4*)h = v0; *(f32x4*)(h + 4) = v1; } }
        }
        asm volatile("s_waitcnt lgkmcnt(0)" ::: "memory"); __builtin_amdgcn_s_barrier(); asm volatile("" ::: "memory");
        const bool partial = (u.pm & 31) != 0;
#pragma unroll
        for (int n = 0; n < 2; ++n) {
            const int col = col0 + 4 * n;
            const f32x4 w0 = *(const f32x4*)(cw + col), w1 = *(const f32x4*)(cw + FF + col), w2 = *(const f32x4*)(cw + 2 * FF + col), bb = *(const f32x4*)(cb + col);
#pragma unroll
            for (int ai = 0; ai < 2; ++ai) {
                f32x4 prev = (f32x4){0.f, 0.f, 0.f, 0.f};
                if (!(ai == 0 && wr == 0) && fr >= 14) { const int pai = (ai == 1 && wr == 1) ? 1 : 0, pwr = wr ^ 1;
                    prev = *(const PG8_LAS f32x4*)(xch + ((((pai * 2 + pwr) * 4 + wc) * 2 + (fr - 14)) * 4 + fq) * 8 + 4 * n); }
                f32x4 r1, r2;
#pragma unroll
                for (int j = 0; j < 4; ++j) { r1[j] = dppf_ror1(prev[j]); r2[j] = dppf_ror2(prev[j]); }
#pragma unroll
                for (int m = 0; m < 4; ++m) {
                    const f32x4 cur = acc[ai][0][m][n] * rs[ai][m];
                    f32x4 s1, s2;
#pragma unroll
                    for (int j = 0; j < 4; ++j) { s1[j] = dppf_shr1_keep(r1[j], cur[j]); s2[j] = dppf_shr2_keep(r2[j], cur[j]); }
                    if (m < 3) {
#pragma unroll
                        for (int j = 0; j < 4; ++j) { r1[j] = dppf_ror1(cur[j]); r2[j] = dppf_ror2(cur[j]); } }
                    const f32x4 y0 = bb + w2 * cur + w1 * s1 + w0 * s2;
                    const f32x2 ga = gelu_pk((f32x2){y0[0], y0[1]}), gb = gelu_pk((f32x2){y0[2], y0[3]});
                    const f32x4 g0 = acc[ai][1][m][n] * rs[ai][m];
                    typedef unsigned u32x2_t __attribute__((ext_vector_type(2)));
                    const f32x2 pa = ga * (f32x2){g0[0], g0[1]}, pb = gb * (f32x2){g0[2], g0[3]};
                    u32x2_t ov; ov.x = cvt_pk_bf16(pa.x, pa.y); ov.y = cvt_pk_bf16(pb.x, pb.y);
                    *(u32x2_t*)(O + (unsigned)((row0 + ai * HALF + m * 16) * FF + col)) = ov;
                    if (ai == 0 && m == 0 && wr == 0 && partial && fr < 2) {
                        const f32x4 yp = (fr == 1) ? bb + w2 * cur + w1 * s1 : bb + w2 * cur;
                        float* fx = FIX + (((size_t)unit * 2 + fr) * 128 + colL + 4 * n) * 2;
                        *(f32x4*)fx = (f32x4){yp[0], g0[0], yp[1], g0[1]}; *(f32x4*)(fx + 4) = (f32x4){yp[2], g0[2], yp[3], g0[3]}; }
                }
            }
        }
    }
};
#ifndef PROBE_KDUP
#define PROBE_KDUP 0
#endif
#define PG8_UI(i) (KDUP ? ((i) >> 1) : (i))
template <class Epi, class Sched, bool ALIGN_EPI = false, bool SP2 = false, bool KDUP = false, bool EDUP = false>
__device__ __forceinline__ void gemm_phase(PG8_LAS unsigned char* lds, const Gemm g, const Sched& S, const Epi& E, const int wv  ) {
    int tid = tid_now(wv); asm volatile("" : "+v"(tid));
    const int wid = __builtin_amdgcn_readfirstlane(tid >> 6), lane = tid & 63, wr = wid >> 2, wc = wid & 3, fr = lane & 15, fq = lane >> 4;
    const int K = g.K, nt = K / BK;
    unsigned voffA[2], voffB[2];
#pragma unroll
    for (int i = 0; i < 2; ++i) { int R, C; stage_rc(tid * 16 + i * 8192, R, C); const int Rb = Epi::PERM ? ((R & ~31) + perm32(R & 31)) : R;
        voffA[i] = (unsigned)(R * K + C) * 2u; voffB[i] = (unsigned)(Rb * K + C) * 2u; }
    const size_t kstep = (size_t)(BK * 2);
    const size_t hstep = (size_t)HALF * K * 2;
    const size_t tstep = 2 * hstep;
    const unsigned ldsw = (unsigned)wid * 1024u;
    const int aoff = lds_byte(wr * 64 + fr, fq * 8), boff = lds_byte(wc * 32 + fr, fq * 8);
#define PG8_SA(b, h) (((b) * 2 + (h)) * HTB)
#define PG8_SB(b, h) ((4 + (b) * 2 + (h)) * HTB)
#define PG8_STAGE(bufoff, gbase, voff) do { _Pragma("unroll") for (int _i = 0; _i < 2; ++_i) \
        __builtin_amdgcn_global_load_lds((const unsigned*)((const char*)(gbase) + (voff)[_i]), (PG8_LAS unsigned*)(lds + (bufoff) + ldsw + _i * 8192), 16, 0, 0); } while (0)
#define PG8_LDA(dst, b, h) do { _Pragma("unroll") for (int m = 0; m < 4; ++m) _Pragma("unroll") for (int k = 0; k < 2; ++k) dst[m][k] = *(const PG8_LAS bf16x8*)(lds + PG8_SA(b, h) + aoff + m * 2048 + k * 1024); } while (0)
#define PG8_LDB(dst, b, h) do { _Pragma("unroll") for (int n = 0; n < 2; ++n) _Pragma("unroll") for (int k = 0; k < 2; ++k) dst[n][k] = *(const PG8_LAS bf16x8*)(lds + PG8_SB(b, h) + boff + n * 2048 + k * 1024); } while (0)
#define PG8_MMA(ai, bj, At, Bt) do { __builtin_amdgcn_s_setprio(1); _Pragma("unroll") for (int m = 0; m < 4; ++m) _Pragma("unroll") for (int n = 0; n < 2; ++n) _Pragma("unroll") for (int k = 0; k < 2; ++k) \
        acc[ai][bj][m][n] = __builtin_amdgcn_mfma_f32_16x16x32_bf16(Bt[n][k], At[m][k], acc[ai][bj][m][n], 0, 0, 0); __builtin_amdgcn_s_setprio(0); } while (0)
#define PG8_WAIT_V(n) asm volatile("s_waitcnt vmcnt(" #n ")" ::: "memory")
#define PG8_WAIT_L(n) asm volatile("s_waitcnt lgkmcnt(" #n ")" ::: "memory")
#define PG8_BAR __builtin_amdgcn_s_barrier()
#define PG8_SCHED __builtin_amdgcn_sched_barrier(0)
    Unit cur, nxt; int ui = 0;
    if (!S.next(PG8_UI(0), cur)) return;
    f32x4 acc[2][2][4][2];
#pragma unroll
    for (int a = 0; a < 2; ++a)
#pragma unroll
        for (int b = 0; b < 2; ++b)
#pragma unroll
            for (int m = 0; m < 4; ++m)
#pragma unroll
                for (int n = 0; n < 2; ++n) acc[a][b][m][n] = (f32x4){0.f, 0.f, 0.f, 0.f};
    bf16x8 At[4][2], B0[2][2], B1[2][2];
    const char* cA = (const char*)g.A + (size_t)cur.pm * tstep; const char* cB = (const char*)g.Bt + (size_t)cur.pn * tstep;
    S.a_ready(cur);
    if constexpr (SP2) {
        PG8_STAGE(PG8_SB(0, 0), cB, voffB); PG8_STAGE(PG8_SB(0, 1), cB + hstep, voffB); PG8_STAGE(PG8_SA(0, 0), cA, voffA); PG8_STAGE(PG8_SA(0, 1), cA + hstep, voffA);
        if (wr == 1) PG8_BAR;
        PG8_WAIT_V(2); PG8_BAR;
        PG8_STAGE(PG8_SB(1, 0), cB + kstep, voffB); PG8_STAGE(PG8_SA(1, 0), cA + kstep, voffA); PG8_STAGE(PG8_SB(1, 1), cB + hstep + kstep, voffB);
        PG8_WAIT_V(6); PG8_BAR;
    } else {
        PG8_STAGE(PG8_SB(0, 0), cB, voffB); PG8_STAGE(PG8_SA(0, 0), cA, voffA); PG8_STAGE(PG8_SB(0, 1), cB + hstep, voffB); PG8_STAGE(PG8_SA(0, 1), cA + hstep, voffA);
        if (wr == 1) PG8_BAR;
        PG8_WAIT_V(4); PG8_BAR;
        PG8_STAGE(PG8_SB(1, 0), cB + kstep, voffB); PG8_STAGE(PG8_SA(1, 0), cA + kstep, voffA); PG8_STAGE(PG8_SB(1, 1), cB + hstep + kstep, voffB);
        PG8_WAIT_V(6); PG8_BAR;
    }
    for (;;) {
        const bool has_next = S.next(PG8_UI(ui + 1), nxt);
        const bool firstpass = KDUP && !(ui & 1);
        const char* nA = has_next ? (const char*)g.A + (size_t)nxt.pm * tstep : cA; const char* nB = has_next ? (const char*)g.Bt + (size_t)nxt.pn * tstep : cB;
        for (int t = 0; t < nt; t += 2) {
            const bool last = (t == nt - 2);
            const char* a1 = cA + (size_t)(t + 1) * kstep;
            const char* a2 = last ? nA : cA + (size_t)(t + 2) * kstep; const char* b2 = last ? nB : cB + (size_t)(t + 2) * kstep;
            const char* a3 = a2 + kstep; const char* b3 = b2 + kstep;
            if (last && has_next) S.a_ready(nxt);
            if constexpr (SP2) {
            PG8_LDB(B0, 0, 0); PG8_LDB(B1, 0, 1); PG8_SCHED; PG8_LDA(At, 0, 0); PG8_STAGE(PG8_SA(1, 1), a1 + hstep, voffA);
            PG8_WAIT_V(8); PG8_WAIT_L(0); PG8_BAR; PG8_MMA(0, 0, At, B0); PG8_MMA(0, 1, At, B1); PG8_BAR; PG8_SCHED;
            PG8_LDA(At, 0, 1); PG8_STAGE(PG8_SB(0, 0), b2, voffB); PG8_STAGE(PG8_SB(0, 1), b2 + hstep, voffB); PG8_STAGE(PG8_SA(0, 0), a2, voffA);
            PG8_WAIT_V(8); PG8_WAIT_L(0); PG8_BAR; PG8_MMA(1, 0, At, B0); PG8_MMA(1, 1, At, B1); PG8_BAR; PG8_SCHED;
            PG8_LDB(B0, 1, 0); PG8_LDB(B1, 1, 1); PG8_SCHED; PG8_LDA(At, 1, 0); PG8_STAGE(PG8_SA(0, 1), a2 + hstep, voffA);
            PG8_WAIT_V(8); PG8_WAIT_L(0); PG8_BAR; PG8_MMA(0, 0, At, B0); PG8_MMA(0, 1, At, B1); PG8_BAR; PG8_SCHED;
            PG8_LDA(At, 1, 1); PG8_STAGE(PG8_SB(1, 0), b3, voffB); PG8_STAGE(PG8_SB(1, 1), b3 + hstep, voffB); PG8_STAGE(PG8_SA(1, 0), a3, voffA);
            PG8_WAIT_V(8); PG8_WAIT_L(0); PG8_BAR; PG8_MMA(1, 0, At, B0); PG8_MMA(1, 1, At, B1); PG8_BAR; PG8_SCHED;
            } else {
            PG8_LDB(B0, 0, 0); PG8_SCHED; PG8_LDA(At, 0, 0); PG8_STAGE(PG8_SA(1, 1), a1 + hstep, voffA);
            PG8_WAIT_L(8); PG8_BAR; PG8_WAIT_L(0); PG8_MMA(0, 0, At, B0); PG8_BAR; PG8_SCHED;
            PG8_LDB(B1, 0, 1); PG8_STAGE(PG8_SB(0, 0), b2, voffB);
            PG8_BAR; PG8_WAIT_L(0); PG8_MMA(0, 1, At, B1); PG8_BAR;
            PG8_LDA(At, 0, 1); PG8_STAGE(PG8_SA(0, 0), a2, voffA);
            PG8_BAR; PG8_WAIT_L(0); PG8_MMA(1, 0, At, B0); PG8_BAR; PG8_SCHED;
            PG8_STAGE(PG8_SB(0, 1), b2 + hstep, voffB);
            PG8_WAIT_V(6); PG8_BAR; PG8_MMA(1, 1, At, B1); PG8_BAR;
            PG8_LDB(B0, 1, 0); PG8_SCHED; PG8_LDA(At, 1, 0); PG8_STAGE(PG8_SA(0, 1), a2 + hstep, voffA);
            PG8_WAIT_L(8); PG8_BAR; PG8_WAIT_L(0); PG8_MMA(0, 0, At, B0); PG8_BAR; PG8_SCHED;
            PG8_LDB(B1, 1, 1); PG8_STAGE(PG8_SB(1, 0), b3, voffB);
            PG8_BAR; PG8_WAIT_L(0); PG8_MMA(0, 1, At, B1); PG8_BAR;
            PG8_LDA(At, 1, 1); PG8_STAGE(PG8_SA(1, 0), a3, voffA);
            PG8_BAR; PG8_WAIT_L(0); PG8_MMA(1, 0, At, B0); PG8_BAR; PG8_SCHED;
            PG8_STAGE(PG8_SB(1, 1), b3 + hstep, voffB);
            PG8_WAIT_V(6); PG8_BAR; PG8_MMA(1, 1, At, B1); PG8_BAR;
            }
        }
        if constexpr (ALIGN_EPI) { if (wr == 0) PG8_BAR; }
        if (KDUP && !firstpass) {
#pragma unroll
            for (int a = 0; a < 2; ++a)
#pragma unroll
                for (int b = 0; b < 2; ++b)
#pragma unroll
                    for (int m = 0; m < 4; ++m)
#pragma unroll
                        for (int n = 0; n < 2; ++n) acc[a][b][m][n] = acc[a][b][m][n] * 0.5f; }
        if constexpr (!Epi::AFTER_DRAIN) if (!firstpass) { int t2 = tid_now(wv); asm volatile("" : "+v"(t2));
            E(acc, cur, wr, wc, t2 & 15, (t2 & 63) >> 4); if (EDUP) { asm volatile("" : "+v"(t2)); E(acc, cur, wr, wc, t2 & 15, (t2 & 63) >> 4); } S.done(cur); }
        if (!has_next) break;
        if (!firstpass)
#pragma unroll
        for (int a = 0; a < 2; ++a)
#pragma unroll
            for (int b = 0; b < 2; ++b)
#pragma unroll
                for (int m = 0; m < 4; ++m)
#pragma unroll
                    for (int n = 0; n < 2; ++n) acc[a][b][m][n] = (f32x4){0.f, 0.f, 0.f, 0.f};
        cur = nxt; cA = nA; cB = nB; ++ui;
        if constexpr (ALIGN_EPI) { if (wr == 1) PG8_BAR; }
    }
    PG8_WAIT_V(0);
    if constexpr (!ALIGN_EPI) { if (wr == 0) PG8_BAR; }
    PG8_BAR;
    if constexpr (Epi::AFTER_DRAIN) { E.fused(acc, cur, wr, wc, fr, fq, lds, wid, lane); S.done(cur); }
#undef PG8_SA
#undef PG8_SB
#undef PG8_STAGE
#undef PG8_LDA
#undef PG8_LDB
#undef PG8_MMA
#undef PG8_WAIT_V
#undef PG8_WAIT_L
#undef PG8_BAR
#undef PG8_SCHED
}
}

#ifndef PG8_SP2
#define PG8_SP2 true
#endif
#ifndef PG8_ALIGN
#define PG8_ALIGN true
#endif
#include <hip/hip_bf16.h>
#include <cmath>
namespace attn_body {
using bf16=__hip_bfloat16;
using bf16x8=__attribute__((ext_vector_type(8)))short;
using s16x4=__attribute__((ext_vector_type(4)))short;
using f32x16=__attribute__((ext_vector_type(16)))float;
using u32x4=__attribute__((ext_vector_type(4)))unsigned;
constexpr int BATCH=8,NHEAD=16,SEQ=8192,D=64,DM=NHEAD*D;
constexpr int NW=8,QBLK=32,QB=QBLK*NW,KVBLK=64,NQB=SEQ/QB;
constexpr int ATTN_PITCH=DM, ATTN_UNIT_ROWS=QB;
__device__ __forceinline__ int crow(int r,int hi){return (r&3)+8*(r>>2)+4*hi;}
#define SBAR() __builtin_amdgcn_sched_barrier(0)
__device__ __forceinline__ void cmask(f32x16&p0,f32x16&p1,int jb,int qrel,int hi){
  const float NEG=-INFINITY; int kb=64*jb+4*hi;
  #pragma unroll
  for(int r=0;r<16;++r){int kv=kb+(r&3)+8*(r>>2); if(kv>qrel)p0[r]=NEG; if(kv+32>qrel)p1[r]=NEG;}
}

constexpr int NSLOT=3, SLOTB=8192;
constexpr int LDS_K=0, LDS_V=NSLOT*SLOTB, LDS_WS=2*NSLOT*SLOTB, LDS_OST=LDS_WS+NW*64*4, LDS_T0=84992, LDS_CB=86016, LDS_BYTES=LDS_CB+SEQ*4;
constexpr float C2=0.125f*1.4426950408889634f;
__device__ __forceinline__ void glds16(const void*gsrc,unsigned lds_dst){unsigned keep;
  asm volatile("s_mov_b32 %0, m0\n\ts_mov_b32 m0, %2\n\ts_nop 0\n\tglobal_load_lds_dwordx4 %1, off\n\ts_mov_b32 m0, %0":"=&s"(keep):"v"(gsrc),"s"(lds_dst):"memory");}
__device__ __forceinline__ float max3f(float a,float b,float c){float r;asm("v_max3_f32 %0, %1, %2, %3":"=v"(r):"v"(a),"v"(b),"v"(c));return r;}
__device__ __forceinline__ float max2f(float a,float b){float r;asm("v_max_f32_e32 %0, %1, %2":"=v"(r):"v"(a),"v"(b));return r;}
__device__ __forceinline__ float fadd_s(float a,float b){float r;asm("v_add_f32_e32 %0, %1, %2":"=v"(r):"v"(a),"v"(b));return r;}
__device__ __forceinline__ float fsub_s(float a,float b){float r;asm("v_sub_f32_e32 %0, %1, %2":"=v"(r):"v"(a),"v"(b));return r;}
typedef float f32x2_t __attribute__((ext_vector_type(2))); typedef __bf16 bf16x2_t __attribute__((ext_vector_type(2)));
__device__ __forceinline__ unsigned cvtpk_s(float lo,float hi){f32x2_t v={lo,hi};bf16x2_t b=__builtin_convertvector(v,bf16x2_t);return __builtin_bit_cast(unsigned,b);}
#define WAIT_BAR(N) asm volatile("s_waitcnt vmcnt(" #N ") lgkmcnt(0)\n\ts_barrier":::"memory")

__device__ __forceinline__ void qkt(f32x16&p0,f32x16&p1,const char*Kslot,const bf16x8*qr,const f32x16&c0in,const f32x16&c1in,int r32,int hi){
  const char*kb=Kslot+hi*1024+r32*16;
  #pragma unroll
  for(int d0=0;d0<4;++d0){
    const bf16x8 b0=*reinterpret_cast<const bf16x8*>(kb+d0*2048);
    const bf16x8 b1=*reinterpret_cast<const bf16x8*>(kb+d0*2048+512);
    if(d0==0){p0=__builtin_amdgcn_mfma_f32_32x32x16_bf16(b0,qr[0],c0in,0,0,0);p1=__builtin_amdgcn_mfma_f32_32x32x16_bf16(b1,qr[0],c1in,0,0,0);}
    else{p0=__builtin_amdgcn_mfma_f32_32x32x16_bf16(b0,qr[d0],p0,0,0,0);p1=__builtin_amdgcn_mfma_f32_32x32x16_bf16(b1,qr[d0],p1,0,0,0);}}
}
typedef __attribute__((address_space(3))) const char* lds_cptr;
typedef short v4i16_t __attribute__((ext_vector_type(4)));
__device__ __forceinline__ void kload8(bf16x8*kf,lds_cptr kp){
  kf[0]=*(const __attribute__((address_space(3))) bf16x8*)(kp);      kf[1]=*(const __attribute__((address_space(3))) bf16x8*)(kp+512);
  kf[2]=*(const __attribute__((address_space(3))) bf16x8*)(kp+2048); kf[3]=*(const __attribute__((address_space(3))) bf16x8*)(kp+2560);
  kf[4]=*(const __attribute__((address_space(3))) bf16x8*)(kp+4096); kf[5]=*(const __attribute__((address_space(3))) bf16x8*)(kp+4608);
  kf[6]=*(const __attribute__((address_space(3))) bf16x8*)(kp+6144); kf[7]=*(const __attribute__((address_space(3))) bf16x8*)(kp+6656);
}
__device__ __forceinline__ void kload2(bf16x8*kf,lds_cptr kp,int j){ kf[2*j]=*(const __attribute__((address_space(3))) bf16x8*)(kp+j*2048); kf[2*j+1]=*(const __attribute__((address_space(3))) bf16x8*)(kp+j*2048+512); }
__device__ __forceinline__ s16x4 vtr(lds_cptr p){ return __builtin_bit_cast(s16x4,__builtin_amdgcn_ds_read_tr16_b64_v4i16((__attribute__((address_space(3))) v4i16_t*)p)); }
__device__ __forceinline__ float rowmax(const f32x16&p0,const f32x16&p1){
  float a=max3f(p0[0],p0[1],p1[0]),b=max3f(p0[2],p0[3],p1[1]);a=max3f(a,p1[2],p1[3]);
  #pragma unroll
  for(int r=4;r<16;r+=4){a=max3f(a,p0[r],p0[r+1]);b=max3f(b,p0[r+2],p0[r+3]);a=max3f(a,p1[r],p1[r+1]);b=max3f(b,p1[r+2],p1[r+3]);}
  const float m=max2f(a,b);
  auto rr=__builtin_amdgcn_permlane32_swap(__float_as_uint(m),__float_as_uint(m),false,false);
  return max2f(__uint_as_float(rr[0]),__uint_as_float(rr[1]));
}
__device__ __forceinline__ void pv(f32x16*o,int vb,bf16x8 pa0,bf16x8 pa1,bf16x8 pa2,bf16x8 pa3){
  #pragma unroll
  for(int d0=0;d0<2;++d0){s16x4 lo[4],hi[4];
    #pragma unroll
    for(int ks=0;ks<4;++ks){
      asm volatile("ds_read_b64_tr_b16 %0,%1 offset:%c2":"=&v"(lo[ks]):"v"(vb),"i"(d0*4096+ks*1024):"memory");
      asm volatile("ds_read_b64_tr_b16 %0,%1 offset:%c2":"=&v"(hi[ks]):"v"(vb),"i"(d0*4096+ks*1024+512):"memory");}
    asm volatile("s_waitcnt lgkmcnt(0)":::"memory");SBAR();
    #define PK(k) (bf16x8){lo[k][0],lo[k][1],lo[k][2],lo[k][3],hi[k][0],hi[k][1],hi[k][2],hi[k][3]}
    o[d0]=__builtin_amdgcn_mfma_f32_32x32x16_bf16(pa0,PK(0),o[d0],0,0,0);
    o[d0]=__builtin_amdgcn_mfma_f32_32x32x16_bf16(pa1,PK(1),o[d0],0,0,0);
    o[d0]=__builtin_amdgcn_mfma_f32_32x32x16_bf16(pa2,PK(2),o[d0],0,0,0);
    o[d0]=__builtin_amdgcn_mfma_f32_32x32x16_bf16(pa3,PK(3),o[d0],0,0,0);
    #undef PK
  }
}

#ifndef ATTN_STORE16
#define ATTN_STORE16(p,v) (*(u32x4*)(p)=(v))
#endif
__device__ __forceinline__ bf16x8 mkkx(float x,int hi){
  const unsigned b0=cvtpk_s(x,0.f)&0xffffu; const float r1=x-__uint_as_float(b0<<16);
  const unsigned b1=cvtpk_s(r1,0.f)&0xffffu; const float r2=r1-__uint_as_float(b1<<16);
  const unsigned b2=cvtpk_s(r2,0.f)&0xffffu;
  u32x4 w; w.x=hi?0u:(b0|(b1<<16)); w.y=hi?0u:(b2|0x3F800000u); w.z=hi?0u:0x3F803F80u; w.w=0u; return __builtin_bit_cast(bf16x8,w);
}
template<int THRL> __device__ __forceinline__ void attn_unit(int b,int h,int qb,int t0,const bf16*Q,const bf16*__restrict__ K,const bf16*__restrict__ V,bf16*O,const float*cbg,char*shm,const int wv){
  int tid=tid_now(wv); asm volatile("":"+v"(tid));
  const int lane=tid&63,r32=lane&31,hi=lane>>5; const int wid=__builtin_amdgcn_readfirstlane(tid>>6);
  const long rowbase=(long)b*SEQ; const int q0=qb*QB;
  const bf16*Qw=Q+(rowbase+q0+wid*QBLK)*DM+h*D;
  const bf16*Kh=K+(rowbase+(long)t0*KVBLK)*DM+h*D,*Vh=V+(rowbase+(long)t0*KVBLK)*DM+h*D;
  const unsigned lds0=(unsigned)(uintptr_t)shm;
  float*wsf=(float*)(shm+LDS_WS)+wid*64;
  const bf16*ksrc=Kh+(long)lane*DM+wid*8;
  const bf16*vsrc=Vh+(long)(16*(wid&3)+(lane>>2))*DM+(wid>>2)*32+(lane&3)*8;
  const unsigned kdst=lds0+LDS_K+wid*1024, vdst=lds0+LDS_V+wid*1024;
  #define DMA_K(t,slot) glds16(ksrc+(long)(t)*KVBLK*DM,(unsigned)__builtin_amdgcn_readfirstlane(kdst+(slot)))
  #define DMA_V(t,slot) glds16(vsrc+(long)(t)*KVBLK*DM,(unsigned)__builtin_amdgcn_readfirstlane(vdst+(slot)))
  const int vb0=(int)(lds0+LDS_V)+((lane>>4)&1)*32+(lane&3)*8+(4*hi+((lane&15)>>2))*64;
  const char*Kbase=shm+LDS_K; bf16x8 kf[8];
  const lds_cptr shm3=(lds_cptr)shm; const lds_cptr kp0=shm3+LDS_K+hi*1024+r32*16; const lds_cptr vp0=shm3+LDS_V+((lane>>4)&1)*32+(lane&3)*8+(4*hi+((lane&15)>>2))*64;
  const int NT=(q0+QB)/KVBLK-t0;
  const float*cbl=(const float*)(shm+LDS_CB);
  DMA_K(0,0);DMA_V(0,0);DMA_K(1,SLOTB);
  { const float*cg=cbg+t0*KVBLK; float*cl=(float*)(shm+LDS_CB); const int n=NT*KVBLK;
    for(int i=tid;i<n;i+=NW*64)cl[i]=cg[i]; }
  bf16x8 qr[4];
  #pragma unroll
  for(int d0=0;d0<4;++d0)qr[d0]=*reinterpret_cast<const bf16x8*>(&Qw[(long)r32*DM+d0*16+hi*8]);
  float mhat=0.f,l_reg=0.f;f32x16 o[2];o[0]=f32x16{};o[1]=f32x16{};const f32x16 z16=f32x16{};
  const int qrel=wid*QBLK+r32;
  #define CMASK(P0,P1,t) do{int jb_=(t)-(NT-4); if(jb_>=0)cmask(P0,P1,jb_,qrel,hi);}while(0)
  bool resc=false;
  bf16x8 qx;
  #define MKQX() do{ const float nm_=-mhat; const unsigned a0_=cvtpk_s(nm_,0.f)&0xffffu; const float q1_=nm_-__uint_as_float(a0_<<16); const unsigned a1_=cvtpk_s(q1_,0.f)&0xffffu; \
    const float q2_=q1_-__uint_as_float(a1_<<16); const unsigned a2_=cvtpk_s(q2_,0.f)&0xffffu; u32x4 w_; w_.x=hi?0u:0x3F803F80u; w_.y=hi?0u:(0x3F80u|(a0_<<16)); w_.z=hi?0u:(a1_|(a2_<<16)); w_.w=0u; qx=__builtin_bit_cast(bf16x8,w_); }while(0)
  MKQX();
  #define START(P0,P1) do{ const float rm=rowmax(P0,P1); resc=false; \
    { const float dl=rm; mhat=fadd_s(mhat,dl); \
      _Pragma("unroll") for(int r=0;r<16;++r){P0[r]=fsub_s(P0[r],dl);P1[r]=fsub_s(P1[r],dl);} \
      MKQX(); } \
    _Pragma("unroll") for(int r=0;r<16;++r)P0[r]=__builtin_amdgcn_exp2f(P0[r]); }while(0)
  #define RESC() do{ if(resc){ asm volatile("s_waitcnt lgkmcnt(0)":::"memory"); \
      _Pragma("unroll") for(int d_=0;d_<2;++d_) _Pragma("unroll") for(int r=0;r<16;++r)o[d_][r]*=wsf[crow(r,hi)]; } }while(0)
  f32x16 pA0,pA1,pB0,pB1;
  int sl_prev=0,sl_cur=0,sl_next=SLOTB;
  #define ROT() do{sl_prev=sl_cur;sl_cur=sl_next;sl_next=(sl_next==(NSLOT-1)*SLOTB)?0:sl_next+SLOTB;}while(0)
  DMA_K(2,2*SLOTB);
  WAIT_BAR(3);
  const float cref=cbl[q0-t0*KVBLK+wid*QBLK];
  #define KXB(X0,X1,t) do{ X0=mkkx(cref-cbl[(t)*KVBLK+r32],hi); X1=mkkx(cref-cbl[(t)*KVBLK+32+r32],hi); }while(0)
  bf16x8 kx0,kx1; KXB(kx0,kx1,0);
  { const f32x16 i0=__builtin_amdgcn_mfma_f32_32x32x16_bf16(kx0,qx,z16,0,0,0), i1=__builtin_amdgcn_mfma_f32_32x32x16_bf16(kx1,qx,z16,0,0,0);
    qkt(pA0,pA1,Kbase,qr,i0,i1,r32,hi); }
  asm volatile("s_nop 15\n\ts_nop 7":"+v"(pA0),"+v"(pA1));CMASK(pA0,pA1,0);
  START(pA0,pA1);
  _Pragma("unroll") for(int r=0;r<16;++r)pA1[r]=__builtin_amdgcn_exp2f(pA1[r]);
  WAIT_BAR(0);
  DMA_K(3,0);DMA_V(1,SLOTB);
  ROT();
  kload8(kf,kp0+sl_cur);
  WAIT_BAR(2);
  s16x4 vlo[8],vhi[8]; u32x4 pw0,pw1,pw2,pw3;
  #define PKW(P,B) cvtpk_s(P[B],P[B+1])
  #define PAF(k) __builtin_bit_cast(bf16x8,pw##k)
  #define VFR(i) (bf16x8){vlo[i][0],vlo[i][1],vlo[i][2],vlo[i][3],vhi[i][0],vhi[i][1],vhi[i][2],vhi[i][3]}
  #define PIN(x) asm volatile("":"+v"(x))
  #define MX3(a,b,c) __builtin_fmaxf(__builtin_fmaxf((a),(b)),(c))
  #define GAPA(MF,A0,A1,A2,A3,W0,W1,PW) do{ MF; sacc+=A0; sacc+=A1; sacc+=A2; sacc+=A3; PIN(sacc); W0; W1; PIN(PW); SBAR(); }while(0)
  #define EX(v) __builtin_amdgcn_exp2f(v)
  #define GAPB(MF,X,B) do{ MF; X[B]=EX(X[B]); X[B+1]=EX(X[B+1]); X[B+2]=EX(X[B+2]); X[B+3]=EX(X[B+3]); PIN(X); SBAR(); }while(0)
  #define VRD(i) do{ vlo[i]=vtr(vp_+(((i)>>2)*4096+((i)&3)*1024)); vhi[i]=vtr(vp_+(((i)>>2)*4096+((i)&3)*1024+512)); }while(0)
  #define KRD(G,j) do{ if(G){ kload2(kf,kp0+sl_next,j); SBAR(); } }while(0)
  #define STEP(C0,C1,P0,P1,t,GK,GV,GL) do{ KXB(kx0,kx1,t); SBAR(); \
    C0=__builtin_amdgcn_mfma_f32_32x32x16_bf16(kx0,qx,z16,0,0,0); C1=__builtin_amdgcn_mfma_f32_32x32x16_bf16(kx1,qx,z16,0,0,0); SBAR(); \
    const lds_cptr vp_=vp0+sl_prev; \
    VRD(0); SBAR(); float sacc=(P0[0]+P0[1]); \
    GAPA(C0=__builtin_amdgcn_mfma_f32_32x32x16_bf16(kf[0],qr[0],C0,0,0,0), P0[2],P0[3],P0[4],P0[5],     pw0[0]=PKW(P0,0), pw0[1]=PKW(P0,2), pw0); \
    VRD(4); SBAR(); GAPA(C1=__builtin_amdgcn_mfma_f32_32x32x16_bf16(kf[1],qr[0],C1,0,0,0), P0[6],P0[7],P0[8],P0[9],     pw0[2]=PKW(P0,4), pw0[3]=PKW(P0,6), pw0); \
    VRD(1); SBAR(); GAPA(C0=__builtin_amdgcn_mfma_f32_32x32x16_bf16(kf[2],qr[1],C0,0,0,0),   P0[10],P0[11],P0[12],P0[13], pw1[0]=PKW(P0,8), pw1[1]=PKW(P0,10), pw1); \
    VRD(5); SBAR(); GAPA(C1=__builtin_amdgcn_mfma_f32_32x32x16_bf16(kf[3],qr[1],C1,0,0,0),   P0[14],P0[15],P1[0],P1[1],   pw1[2]=PKW(P0,12),pw1[3]=PKW(P0,14), pw1); \
    VRD(2); SBAR(); GAPA(C0=__builtin_amdgcn_mfma_f32_32x32x16_bf16(kf[4],qr[2],C0,0,0,0),   P1[2],P1[3],P1[4],P1[5],     pw2[0]=PKW(P1,0), pw2[1]=PKW(P1,2), pw2); \
    VRD(6); SBAR(); GAPA(C1=__builtin_amdgcn_mfma_f32_32x32x16_bf16(kf[5],qr[2],C1,0,0,0),   P1[6],P1[7],P1[8],P1[9],     pw2[2]=PKW(P1,4), pw2[3]=PKW(P1,6), pw2); \
    VRD(3); SBAR(); GAPA(C0=__builtin_amdgcn_mfma_f32_32x32x16_bf16(kf[6],qr[3],C0,0,0,0),   P1[10],P1[11],P1[12],P1[13], pw3[0]=PKW(P1,8), pw3[1]=PKW(P1,10), pw3); \
    VRD(7); SBAR(); GAPA(C1=__builtin_amdgcn_mfma_f32_32x32x16_bf16(kf[7],qr[3],C1,0,0,0),   P1[14],P1[15],0.f,0.f,       pw3[2]=PKW(P1,12),pw3[3]=PKW(P1,14), pw3); \
    l_reg+=sacc; \
    if(GK){DMA_K((t)+3,sl_cur);} if(GV){DMA_V((t)+1,sl_next);} \
    CMASK(C0,C1,t); \
    { float a=MX3(C0[0],C0[1],C1[0]),b=MX3(C0[2],C0[3],C1[1]); a=MX3(a,C1[2],C1[3]); \
      _Pragma("unroll") for(int r=4;r<16;r+=4){a=MX3(a,C0[r],C0[r+1]);b=MX3(b,C0[r+2],C0[r+3]);a=MX3(a,C1[r],C1[r+1]);b=MX3(b,C1[r+2],C1[r+3]);} \
      float rm=__builtin_fmaxf(a,b); { auto rr=__builtin_amdgcn_permlane32_swap(__float_as_uint(rm),__float_as_uint(rm),false,false); rm=__builtin_fmaxf(__uint_as_float(rr[0]),__uint_as_float(rr[1])); } \
      resc=false; \
      if(__builtin_expect(__any(rm>(float)THRL),0)){ const float dl=__builtin_fmaxf(rm,0.f); mhat+=dl; \
        _Pragma("unroll") for(int r=0;r<16;++r){C0[r]-=dl;C1[r]-=dl;} \
        MKQX(); \
        const float f=__builtin_amdgcn_exp2f(-dl); l_reg*=f; if(hi==0)wsf[r32]=f; resc=true; } } \
    SBAR(); \
    GAPB(o[0]=__builtin_amdgcn_mfma_f32_32x32x16_bf16(PAF(0),VFR(0),o[0],0,0,0), C0,0); \
    GAPB(o[1]=__builtin_amdgcn_mfma_f32_32x32x16_bf16(PAF(0),VFR(4),o[1],0,0,0), C0,4); \
    KRD(GL,0); GAPB(o[0]=__builtin_amdgcn_mfma_f32_32x32x16_bf16(PAF(1),VFR(1),o[0],0,0,0), C0,8); \
    KRD(GL,1); GAPB(o[1]=__builtin_amdgcn_mfma_f32_32x32x16_bf16(PAF(1),VFR(5),o[1],0,0,0), C0,12); \
    KRD(GL,2); GAPB(o[0]=__builtin_amdgcn_mfma_f32_32x32x16_bf16(PAF(2),VFR(2),o[0],0,0,0), C1,0); \
    KRD(GL,3); GAPB(o[1]=__builtin_amdgcn_mfma_f32_32x32x16_bf16(PAF(2),VFR(6),o[1],0,0,0), C1,4); \
    GAPB(o[0]=__builtin_amdgcn_mfma_f32_32x32x16_bf16(PAF(3),VFR(3),o[0],0,0,0), C1,8); \
    GAPB(o[1]=__builtin_amdgcn_mfma_f32_32x32x16_bf16(PAF(3),VFR(7),o[1],0,0,0), C1,12); \
    }while(0)
  int t=1;
  #undef CMASK
  #define CMASK(P0,P1,t) do{}while(0)
  for(;t+5<NT;t+=2){
    STEP(pB0,pB1,pA0,pA1,t,true,true,true);     WAIT_BAR(2); RESC(); ROT();
    STEP(pA0,pA1,pB0,pB1,t+1,true,true,true);   WAIT_BAR(2); RESC(); ROT();
  }
  #undef CMASK
  #define CMASK(P0,P1,t) do{int jb_=(t)-(NT-4); if(jb_>=0)cmask(P0,P1,jb_,qrel,hi);}while(0)
  #define ENDW(tt) do{ if((tt)+3<NT){WAIT_BAR(2);} else if((tt)+2<NT){WAIT_BAR(1);} else {WAIT_BAR(0);} }while(0)
  for(;t+1<NT;t+=2){
    STEP(pB0,pB1,pA0,pA1,t,(t+3<NT),(t+1<NT),(t+1<NT));       ENDW(t);   RESC(); ROT();
    STEP(pA0,pA1,pB0,pB1,t+1,(t+4<NT),(t+2<NT),(t+2<NT));     ENDW(t+1); RESC(); ROT();
  }
  STEP(pB0,pB1,pA0,pA1,NT-1,false,false,false); RESC();
  { float sacc=pB0[0]+pB0[1]; _Pragma("unroll") for(int r=2;r<16;++r)sacc+=pB0[r]; _Pragma("unroll") for(int r=0;r<16;++r)sacc+=pB1[r]; l_reg+=sacc;
    pw0=(u32x4){PKW(pB0,0),PKW(pB0,2),PKW(pB0,4),PKW(pB0,6)};pw1=(u32x4){PKW(pB0,8),PKW(pB0,10),PKW(pB0,12),PKW(pB0,14)};pw2=(u32x4){PKW(pB1,0),PKW(pB1,2),PKW(pB1,4),PKW(pB1,6)};pw3=(u32x4){PKW(pB1,8),PKW(pB1,10),PKW(pB1,12),PKW(pB1,14)};
    SBAR(); pv(o,vb0+sl_cur,PAF(0),PAF(1),PAF(2),PAF(3)); }
  #undef PKW
  #undef PAF
  #undef VFR
  #undef PIN
  #undef MX3
  #undef GAPA
  #undef GAPB
  #undef EX
  #undef VRD
  #undef KRD
  #undef STEP
  #undef ENDW
  #undef KXB
  #undef MKQX
  {auto rr=__builtin_amdgcn_permlane32_swap(__float_as_uint(l_reg),__float_as_uint(l_reg),false,false);l_reg=__uint_as_float(rr[0])+__uint_as_float(rr[1]);}
  if(hi==0)wsf[32+r32]=l_reg;asm volatile("s_waitcnt lgkmcnt(0)":::"memory");
  float rli[16];
  #pragma unroll
  for(int r=0;r<16;++r)rli[r]=__builtin_amdgcn_rcpf(wsf[32+crow(r,hi)]);
  bf16*Ow=O+(rowbase+q0+wid*QBLK)*DM+h*D;
  { bf16*stg=(bf16*)(shm+LDS_OST)+wid*2048;
    #pragma unroll
    for(int r=0;r<16;++r){const int orow=crow(r,hi);
      #pragma unroll
      for(int d0=0;d0<2;++d0)stg[orow*64+d0*32+r32]=__float2bfloat16(o[d0][r]*rli[r]);}
    asm volatile("s_waitcnt lgkmcnt(0)":::"memory");
    #pragma unroll
    for(int i=0;i<4;++i){const int row=i*8+(lane>>3),ch=lane&7; const u32x4 v=*(const u32x4*)(stg+row*64+ch*8); ATTN_STORE16(Ow+(long)row*DM+ch*8,v);} }
  asm volatile("s_waitcnt lgkmcnt(0)\n\ts_barrier":::"memory");
  #undef DMA_K
  #undef DMA_V
  #undef CMASK
  #undef START
  #undef RESC
  #undef ROT
}
constexpr int ATTN_LDS_BYTES=LDS_BYTES;
struct AttnTensors { const bf16* Q; const bf16* K; const bf16* V; bf16* O; };
struct AttnUnit { int bh; int qb; int t0; };
struct StaticOrder {
  int vcu;
  __device__ __forceinline__ explicit StaticOrder(int grid,int block):vcu((block%8)*(grid/8)+block/8){}
  __device__ __forceinline__ bool next(int i,AttnUnit&u)const{ if(i>=8)return false; const int s=vcu&7,k=i&3; u.bh=2*(vcu>>3)+(i>>2); u.qb=(k==0)?s:(k==1)?15-s:(k==2)?16+s:31-s; u.t0=0; return true; }
};
constexpr float PRUNE_MARGIN=40.f;
template<class Sched,int THRL=32> __device__ __forceinline__ void attn_phase(char*lds,const AttnTensors&T,const float*cb,const float*qk,const Sched&S,const int wv){
  { int tid=tid_now(wv); asm volatile("":"+v"(tid)); const int lane=tid&63,wid=__builtin_amdgcn_readfirstlane(tid>>6);
    AttnUnit u; S.next(wid,u);
    const float thr=2.02f*qk[2*u.bh]*qk[2*u.bh+1]+PRUNE_MARGIN; const float*c=cb+(size_t)u.bh*SEQ; const float cq=c[u.qb*QB];
    const bool p0=(c[64*lane+63]-cq>=thr), p1=(c[64*(lane+64)+63]-cq>=thr);
    int cnt=__builtin_popcountll(__ballot(p0))+__builtin_popcountll(__ballot(p1)); cnt&=~1; if(cnt>4*u.qb)cnt=4*u.qb;
    if(lane==0)((int*)(lds+LDS_T0))[wid]=cnt;
    __syncthreads(); }
  AttnUnit u;
  for(int i=0;S.next(i,u);++i){ const int t0=__builtin_amdgcn_readfirstlane(((const int*)(lds+LDS_T0))[i]); attn_unit<THRL>(u.bh>>3,u.bh&7,u.qb,t0,T.Q,T.K,T.V,T.O,cb+(size_t)u.bh*SEQ,lds,wv); }
}
#undef SBAR
#undef WAIT_BAR
}
#define GAS __attribute__((address_space(1)))
#define LAS __attribute__((address_space(3)))
typedef unsigned short bf16;
typedef unsigned v4u __attribute__((ext_vector_type(4)));
typedef float f32x4 __attribute__((ext_vector_type(4)));
typedef short bf16x8 __attribute__((ext_vector_type(8)));
typedef GAS unsigned gu32;
typedef GAS unsigned long long gu64;
#define RLX_AGENT __ATOMIC_RELAXED, __HIP_MEMORY_SCOPE_AGENT
#define LDS_WAIT() asm volatile("s_waitcnt lgkmcnt(0)" ::: "memory")
#define VM_WAIT() asm volatile("s_waitcnt vmcnt(0)" ::: "memory")
__device__ __forceinline__ unsigned long long rt() { return __builtin_amdgcn_s_memrealtime(); }
__device__ __forceinline__ unsigned f2bf(float f) { unsigned u = __builtin_bit_cast(unsigned, f); return (u + 0x7fffu + ((u >> 16) & 1u)) >> 16; }
__device__ __forceinline__ unsigned pk2(float lo, float hi) { return f2bf(lo) | (f2bf(hi) << 16); }

#define XB_TMO      128
#define XB_XCNT(j)  (256  + 64 * (j))
#define XB_XSUB(j)  (1280 + 64 * (j))
#define XB_XGEN(j)  (2304 + 64 * (j))
#define XB_TOP      3328
#define XB_TOPGEN   3392
#define XCD_BAR_WORDS 3456
#define XB_SPIN_CAP (1u << 18)

__device__ __forceinline__ unsigned xb_ld(unsigned* p)              { return __hip_atomic_load(p, __ATOMIC_RELAXED, __HIP_MEMORY_SCOPE_AGENT); }
__device__ __forceinline__ unsigned xb_add(unsigned* p, unsigned v) { return __hip_atomic_fetch_add(p, v, __ATOMIC_RELAXED, __HIP_MEMORY_SCOPE_AGENT); }
__device__ __forceinline__ unsigned xb_xcc_id() { return (unsigned)__builtin_amdgcn_s_getreg((3 << 11) | 20) & 0xFu; }
#define XB_SPIN(cond, bar) do { unsigned _sp = 0; while (cond) { __builtin_amdgcn_s_sleep(1); \
    if ((++_sp & 255u) == 0u) { if (xb_ld(&(bar)[XB_TMO])) break; if (_sp > XB_SPIN_CAP) { atomicAdd(&(bar)[XB_TMO], 1u); break; } } } } while (0)

struct XcdBarrier {
    unsigned* bar; unsigned x;
    volatile LAS unsigned* st;
};

__device__ __forceinline__ XcdBarrier xcd_barrier_post(unsigned* bar, volatile LAS unsigned* st) {
    XcdBarrier b; b.bar = bar; b.x = xb_xcc_id(); b.st = st;
    if (threadIdx.x == 0) { st[4] = xb_add(&bar[XB_XCNT(b.x)], 1u); st[3] = blockIdx.x; }
    return b;
}
__device__ __forceinline__ void xcd_barrier_complete(unsigned* bar, unsigned x, unsigned& nloc, unsigned& nx, unsigned& reg) {
    const unsigned G = gridDim.x * gridDim.y * gridDim.z;
    unsigned sum, cnt, mine, bad, sp = 0u;
    for (;;) {
        sum = 0u; cnt = 0u; bad = 0u;
#pragma unroll
        for (unsigned j = 0; j < 16; ++j) { const unsigned c = xb_ld(&bar[XB_XCNT(j)]); sum += c; cnt += (c > 0u) ? 1u : 0u; bad |= (j < 8u) ? (c ^ 32u) : c; }
        if (sum == G) break;
        __builtin_amdgcn_s_sleep(1);
        if ((++sp & 255u) == 0u) { if (xb_ld(&bar[XB_TMO])) { bad = 1u; break; } if (sp > XB_SPIN_CAP) { atomicAdd(&bar[XB_TMO], 1u); bad = 1u; break; } }
    }
#ifdef PROBE_FORCE_IRREGULAR
    bad = 1u;
#endif
    reg = (bad == 0u && G == 256u) ? 1u : 0u;
    mine = xb_ld(&bar[XB_XCNT(x)]);
    nloc = mine > 0u ? mine : 1u; nx = cnt > 0u ? cnt : 1u;
}

__device__ __forceinline__ void xcd_barrier(const XcdBarrier& b, const bool glob, const int wv  ) {
    asm volatile("s_waitcnt vmcnt(0)" ::: "memory");
    __syncthreads();
    if (tid_now(wv) == 0) {
        GAS unsigned* barg_ = (GAS unsigned*)b.bar; unsigned xq_ = b.x; asm volatile("" : "+s"(barg_), "+s"(xq_));
        unsigned* bar = (unsigned*)barg_;
        __builtin_amdgcn_s_waitcnt(0);
        unsigned nloc = b.st[0], nx = b.st[1];
        if (nloc == 0u) { unsigned reg; xcd_barrier_complete(bar, xq_, nloc, nx, reg); b.st[0] = nloc; b.st[1] = nx; b.st[2] = reg; if (reg) b.st[3] = b.st[4] * 8u + xq_; }
        const bool loc = !glob && b.st[2] != 0u;
        const unsigned old = xb_add(&bar[XB_XSUB(xq_)], 1u);
        const unsigned gen = old / nloc;
        if (old + 1u == (gen + 1u) * nloc) {
            if (!loc) {
            __builtin_amdgcn_fence(__ATOMIC_RELEASE, "agent");
            asm volatile("s_waitcnt vmcnt(0)" ::: "memory");
            const unsigned og = xb_add(&bar[XB_TOP], 1u);
            const unsigned tg = og / nx;
            if (og + 1u == (tg + 1u) * nx) xb_add(&bar[XB_TOPGEN], 1u);
            else XB_SPIN(xb_ld(&bar[XB_TOPGEN]) == tg, bar);
            }
            __builtin_amdgcn_fence(__ATOMIC_ACQUIRE, "agent");
            xb_add(&bar[XB_XGEN(xq_)], 1u);
            asm volatile("s_waitcnt vmcnt(0)" ::: "memory");
        } else {
            XB_SPIN(xb_ld(&bar[XB_XGEN(xq_)]) == gen, bar);
            __builtin_amdgcn_fence(__ATOMIC_ACQUIRE, "agent");
            asm volatile("s_waitcnt vmcnt(0)" ::: "memory");
        }
    }
    __syncthreads();
}

constexpr int NWAVES = 8;
#ifndef PROBE_DUP
#define PROBE_DUP 0
#endif
#define NREP(k) ((PROBE_DUP == (k)) ? 2 : 1)
#ifndef PROBE_RG
#define PROBE_RG 0
#endif
#ifndef PROBE_EDUP
#define PROBE_EDUP 0
#endif
#ifndef MK_ONE_LAUNCH
#define MK_ONE_LAUNCH 1
#endif
constexpr int BATCH = 8, SEQ = 8192, DM = 1024, DEPTH = 4, M = BATCH * SEQ;
constexpr int NIN = 3584, INW = 3592, FF = 2816, PLE = 256, NFH = 8, NCHK = SEQ / 128;
constexpr int NPH = 2 + 9 * DEPTH;
constexpr float LOG2E = 1.4426950408889634f;
constexpr size_t MiB = 1u << 20;
constexpr size_t WS_CTL = 0, CTL_ZERO_BYTES = 1 * MiB;
constexpr size_t WS_WFB = 1 * MiB;
constexpr size_t WS_CS = 2 * MiB;
constexpr size_t WS_LF = 4 * MiB;
constexpr size_t WS_CB = 6 * MiB;
constexpr size_t WS_SSQ0 = 9 * MiB, WS_SSQ1 = 13 * MiB;
constexpr size_t WS_W = 17 * MiB, W_LAYER = 28 * MiB;
constexpr size_t WO_IN = 0, WO_OUT = 7 * MiB, WO_A = 9 * MiB, WO_G = 14 * MiB + MiB / 2, WO_DOWN = 20 * MiB, WO_GATE = 25 * MiB + MiB / 2, WO_PROJ = 27 * MiB + MiB / 2;
constexpr size_t WS_HB = 129 * MiB;
constexpr size_t WS_PB = 257 * MiB;
constexpr size_t WS_X = 289 * MiB, XR = 81 * MiB;
#define XBUF(off, per_batch_bytes) (WS_X + (size_t)(off) + (size_t)(bx & 7) * (XR - (size_t)(per_batch_bytes)))
#define WS_QO  XBUF(0, 16 * MiB)
#define PP_BASE ((bf16*)(ws + WS_HBT))
#define WS_KK  XBUF(16 * MiB, 16 * MiB)
#define WS_VV  XBUF(32 * MiB, 16 * MiB)
#define WS_G   XBUF(48 * MiB, 8 * MiB)
#define WS_U   XBUF(56 * MiB, 1 * MiB)
#define WS_NRM XBUF(57 * MiB, MiB / 2)
#define WS_ACT XBUF(16 * MiB, 44 * MiB)
#define WS_FIX XBUF(62 * MiB, 704 * 2048)
#define WS_HAL XBUF(63 * MiB + MiB / 2, 704 * 1024)
#define WS_HBT XBUF(65 * MiB, 16 * MiB)
constexpr size_t WS_END = WS_X + 8 * XR;
static_assert(WS_W + DEPTH * W_LAYER == WS_HB && WS_END <= 1024 * MiB, "d_ws map");
constexpr int CW_QK = 65536;
constexpr int CW_TAB = 131072;
constexpr int CW_BAR = 4096;

constexpr int RING_BYTES = 131072, LDSCTL_OFF = RING_BYTES, MISC_OFF = LDSCTL_OFF + 320, LDS_BYTES = 147456;

typedef float f32x16 __attribute__((ext_vector_type(16)));
typedef short s16x4 __attribute__((ext_vector_type(4)));
typedef float f32x2_ __attribute__((ext_vector_type(2)));
typedef __bf16 bf16x2_ __attribute__((ext_vector_type(2)));
__device__ __forceinline__ unsigned cvtpk(float lo, float hi) { f32x2_ v = {lo, hi}; bf16x2_ b = __builtin_convertvector(v, bf16x2_); return __builtin_bit_cast(unsigned, b); }
__device__ __forceinline__ int crow16(int r, int hi) { return (r & 3) + 8 * (r >> 2) + 4 * hi; }
__device__ __forceinline__ float bpx(float v, int lane, int mask) { return __int_as_float(__builtin_amdgcn_ds_bpermute((lane ^ mask) << 2, __float_as_int(v))); }
__device__ __forceinline__ float wave_sum(float v, int lane) {
#pragma unroll
    for (int o = 1; o < 32; o <<= 1) v += bpx(v, lane, o);
    return pg8::halves_sum(v);
}
__device__ __forceinline__ s16x4 trd(LAS unsigned char* p) { typedef short v4i16_t __attribute__((ext_vector_type(4))); return __builtin_bit_cast(s16x4, __builtin_amdgcn_ds_read_tr16_b64_v4i16((LAS v4i16_t*)p)); }
__device__ __forceinline__ bf16x8 cat8(s16x4 lo, s16x4 hi) { return (bf16x8){lo[0], lo[1], lo[2], lo[3], hi[0], hi[1], hi[2], hi[3]}; }
#define MFMA32(a, b, c) __builtin_amdgcn_mfma_f32_32x32x16_bf16((a), (b), (c), 0, 0, 0)

__device__ __forceinline__ void tr_item(const float* W, int ldw, int c0, const float* kscale, int K, bf16* WT, int dst_row0, int mode, LAS float* scr, int item, int nblk, int lane) {
    const int kb = item / nblk, nb = item % nblk, k0 = 64 * kb, n0 = 32 * nb;
    { pg8::f32x4 v[8]; float sc[8];
#pragma unroll
      for (int p = 0; p < 8; ++p) { const int kk = 8 * p + (lane >> 3); v[p] = __builtin_nontemporal_load((const pg8::f32x4*)(W + (size_t)(k0 + kk) * ldw + c0 + n0 + 4 * (lane & 7))); sc[p] = kscale ? kscale[k0 + kk] : 1.f; }
#pragma unroll
      for (int p = 0; p < 8; ++p) { const int kk = 8 * p + (lane >> 3); LAS float* d = scr + kk * 33 + 4 * (lane & 7); d[0] = v[p][0] * sc[p]; d[1] = v[p][1] * sc[p]; d[2] = v[p][2] * sc[p]; d[3] = v[p][3] * sc[p]; } }
    LDS_WAIT(); asm volatile("" ::: "memory");
    const int c = lane & 7;
#pragma unroll
    for (int j = 0; j < 4; ++j) { const int n = (lane >> 3) + 8 * j, nn = n0 + n; const LAS float* s = scr + (8 * c) * 33 + n;
        int drow = nn; if (mode == 1) { const int d = nn & 63; drow = (nn & ~63) + ((d < 32) ? (8 * (d >> 2) + (d & 3)) : (8 * ((d - 32) >> 2) + 4 + (d & 3))); }
        if (mode == 3) drow = (nn & ~255) + ((nn >> 5) & 1) * 128 + ((nn >> 6) & 3) * 32 + (nn & 31);
        if (mode == 2) drow = (nn >> 7) * 256 + (nn & 127);
        v4u o; o.x = cvtpk(s[0 * 33], s[1 * 33]); o.y = cvtpk(s[2 * 33], s[3 * 33]); o.z = cvtpk(s[4 * 33], s[5 * 33]); o.w = cvtpk(s[6 * 33], s[7 * 33]);
        *(GAS v4u*)(WT + (size_t)(dst_row0 + drow) * K + k0 + 8 * c) = o; }
    LDS_WAIT(); asm volatile("" ::: "memory");
}
constexpr int IT_IN = 7 * 256, IT_OUT = 512, IT_UP = 1408, IT_DOWN = 1408, IT_GATE = 512, IT_PROJ = 128, IT_LAYER = IT_IN + IT_OUT + 2 * IT_UP + IT_DOWN + IT_GATE + IT_PROJ;

struct Args { const float* in[15]; float* out; unsigned char* ws; int ph_lo, ph_hi; };
__device__ __forceinline__ const float* inp_ptr(const unsigned char* ws, int k, int zq) {
    const unsigned* t = (const unsigned*)(ws + WS_CTL) + CW_TAB + 2 * k + zq; const unsigned lo = t[0], hi = t[1];
    const GAS float* g = (const GAS float*)(((unsigned long long)(unsigned)__builtin_amdgcn_readfirstlane((int)hi) << 32) | (unsigned)__builtin_amdgcn_readfirstlane((int)lo));
    return (const float*)g;
}
#define INP(k) inp_ptr(ws, (k), zq)

__device__ __forceinline__ void convert_layer(unsigned char* ws, int zq, LAS unsigned char* ldsl, int l, int gw, int NGW, int wave, int lane) {
    LAS float* scr = (LAS float*)(ldsl + wave * 16384);
    unsigned char* wl = ws + WS_W + (size_t)l * W_LAYER;
    const float* w_in = INP(3) + (size_t)l * DM * INW; const float* w_up = INP(7) + (size_t)l * DM * 2 * FF;
    const float* nw_attn = INP(2) + l * DM; const float* nw_ffn = INP(6) + l * DM; const float* nw_ple = INP(11) + l * DM;
    const float* w_out = INP(5) + (size_t)l * DM * DM; const float* w_down = INP(10) + (size_t)l * FF * DM; const float* w_gate = INP(12) + (size_t)l * DM * DM; const float* w_proj = INP(13) + (size_t)l * PLE * DM;
    for (int it = gw; it < IT_LAYER; it += NGW) {
        int r = it;
        if (r < IT_IN) { const int seg = r >> 8; tr_item(w_in, INW, seg * 512 + (seg >= 3 ? 8 : 0), nw_attn, DM, (bf16*)(wl + WO_IN), seg * 512, (seg == 3 || seg == 4) ? 1 : 0, scr, r & 255, 16, lane); continue; } r -= IT_IN;
        if (r < IT_OUT) { tr_item(w_out, DM, 0, nullptr, DM, (bf16*)(wl + WO_OUT), 0, 3, scr, r, 32, lane); continue; } r -= IT_OUT;
        if (r < IT_UP) { tr_item(w_up, 2 * FF, 0, nw_ffn, DM, (bf16*)(wl + WO_A), 0, 2, scr, r, 88, lane); continue; } r -= IT_UP;
        if (r < IT_UP) { tr_item(w_up, 2 * FF, FF, nw_ffn, DM, (bf16*)(wl + WO_A), 128, 2, scr, r, 88, lane); continue; } r -= IT_UP;
        if (r < IT_DOWN) { tr_item(w_down, DM, 0, nullptr, FF, (bf16*)(wl + WO_DOWN), 0, 3, scr, r, 32, lane); continue; } r -= IT_DOWN;
        if (r < IT_GATE) { tr_item(w_gate, DM, 0, nw_ple, DM, (bf16*)(wl + WO_GATE), 0, 3, scr, r, 32, lane); continue; } r -= IT_GATE;
        tr_item(w_proj, DM, 0, nullptr, PLE, (bf16*)(wl + WO_PROJ), 0, 0, scr, r, 32, lane);
    }
}
__device__ __forceinline__ void prologue(unsigned char* ws, int zq, LAS unsigned char* ldsl, int gw, int NGW, int wave, int lane, int gtid, int GT) {
    convert_layer(ws, zq, ldsl, 0, gw, NGW, wave, lane);
    { bf16* wfb = (bf16*)(ws + WS_WFB); const float* nwa = INP(2); const float* win = INP(3);
      for (int i = gtid; i < DEPTH * 8 * DM; i += GT) { const int l = i / (8 * DM), j = (i / DM) & 7, k = i % DM;
          wfb[i] = (bf16)(cvtpk(nwa[l * DM + k] * win[(size_t)l * DM * INW + (size_t)k * INW + 1536 + j], 0.f) & 0xffffu); } }
    { float* cs = (float*)(ws + WS_CS);
      for (int i = gtid; i < SEQ * 32; i += GT) { const int pos = i >> 5, d = i & 31; const float inv = powf(10000.0f, -(float)(2 * d) / 64.0f), ang = (float)pos * inv; float sn, cn; sincosf(ang, &sn, &cn); cs[i] = cn; cs[SEQ * 32 + i] = sn; } }
    { bf16* hb = (bf16*)(ws + WS_HB); float* ssq = (float*)(ws + WS_SSQ0); const float* xin = INP(0);
      for (int m0 = gw; m0 < M; m0 += 4 * NGW) {
          f32x4 v[4][4];
#pragma unroll
          for (int k = 0; k < 4; ++k) { const float* xr = xin + (size_t)(m0 + k * NGW) * DM;
#pragma unroll
              for (int j = 0; j < 2; ++j) { v[k][2 * j] = __builtin_nontemporal_load((const f32x4*)(xr + j * 512 + lane * 8)); v[k][2 * j + 1] = __builtin_nontemporal_load((const f32x4*)(xr + j * 512 + lane * 8 + 4)); } }
#pragma unroll
          for (int k = 0; k < 4; ++k) { const int m = m0 + k * NGW; float s = 0.f;
#pragma unroll
              for (int j = 0; j < 2; ++j) { const f32x4 v0 = v[k][2 * j], v1 = v[k][2 * j + 1];
                  s += ((v0[0] * v0[0] + v0[1] * v0[1]) + (v0[2] * v0[2] + v0[3] * v0[3])) + ((v1[0] * v1[0] + v1[1] * v1[1]) + (v1[2] * v1[2] + v1[3] * v1[3]));
                  v4u o; o.x = cvtpk(v0[0], v0[1]); o.y = cvtpk(v0[2], v0[3]); o.z = cvtpk(v1[0], v1[1]); o.w = cvtpk(v1[2], v1[3]); *(v4u*)(hb + (size_t)m * DM + j * 512 + lane * 8) = o; }
              s = wave_sum(s, lane); if (lane < 16) ssq[(size_t)m * 16 + lane] = s * (1.0f / 16.0f); } } }
}

__device__ __forceinline__ void flogit_pb_task(const bf16* hb, const bf16* wfb, const float* ssq, const float* fbias, float* lf, const float* p, bf16* pb, int vcu, int wave, int lane) {
    const int r32 = lane & 31, hi = lane >> 5;
    const int row0 = vcu * 256 + wave * 32;
    const bf16* ap = hb + (size_t)(row0 + r32) * DM + 8 * hi; const bf16* bp = wfb + (r32 & 7) * DM + 8 * hi;
    const size_t i0 = (size_t)(vcu >> 5) * (SEQ * PLE / 8) + (size_t)(vcu & 31) * (NWAVES * 64) + wave * 64 + lane;
    f32x16 acc; for (int i = 0; i < 16; ++i) acc[i] = 0.f;
#pragma unroll 1
    for (int kb = 0; kb < 8; ++kb) {
        f32x4 pv[2][2];
#pragma unroll
        for (int j = 0; j < 2; ++j) { const float* s = p + (i0 + (size_t)(2 * kb + j) * (32 * NWAVES * 64)) * 8; pv[j][0] = __builtin_nontemporal_load((const f32x4*)s); pv[j][1] = __builtin_nontemporal_load((const f32x4*)(s + 4)); }
#pragma unroll
        for (int ks = 0; ks < 8; ++ks) acc = MFMA32(*(const bf16x8*)(ap + 16 * (8 * kb + ks)), *(const bf16x8*)(bp + 16 * (8 * kb + ks)), acc);
#pragma unroll
        for (int j = 0; j < 2; ++j) { v4u o; o.x = cvtpk(pv[j][0][0], pv[j][0][1]); o.y = cvtpk(pv[j][0][2], pv[j][0][3]); o.z = cvtpk(pv[j][1][0], pv[j][1][1]); o.w = cvtpk(pv[j][1][2], pv[j][1][3]);
            *(v4u*)(pb + (i0 + (size_t)(2 * kb + j) * (32 * NWAVES * 64)) * 8) = o; }
    }
    if (r32 < 8) { const float fb = fbias[r32];
#pragma unroll
        for (int r = 0; r < 16; ++r) { const int row = row0 + crow16(r, hi); const float x = acc[r] * pg8::row_rstd(ssq, row) + fb;
            lf[(size_t)row * 8 + r32] = fminf(x, 0.f) - __logf(1.0f + __expf(-fabsf(x))); } }
}

__device__ __forceinline__ void flogit_task(const bf16* hb, const bf16* wfb, const float* ssq, const float* fbias, float* lf, int G, int bx, int wave, int lane) {
    const int r32 = lane & 31, hi = lane >> 5;
    for (int blk = bx; blk < M / 256; blk += G) {
        const int row0 = blk * 256 + wave * 32;
        const bf16* ap = hb + (size_t)(row0 + r32) * DM + 8 * hi; const bf16* bp = wfb + (r32 & 7) * DM + 8 * hi;
        f32x16 acc; for (int i = 0; i < 16; ++i) acc[i] = 0.f;
#pragma unroll 8
        for (int ks = 0; ks < DM / 16; ++ks) acc = MFMA32(*(const bf16x8*)(ap + 16 * ks), *(const bf16x8*)(bp + 16 * ks), acc);
        if (r32 < 8) { const float fb = fbias[r32];
#pragma unroll
            for (int r = 0; r < 16; ++r) { const int row = row0 + crow16(r, hi); const float x = acc[r] * pg8::row_rstd(ssq, row) + fb;
                lf[(size_t)row * 8 + r32] = fminf(x, 0.f) - __logf(1.0f + __expf(-fabsf(x))); } }
    }
}
__device__ __forceinline__ void pb_task(const float* p, bf16* pb, int vcu, int tid) {
    const int i0 = (vcu >> 5) * (SEQ * PLE / 8);
    for (int j = (vcu & 31) * (NWAVES * 64) + tid; j < SEQ * PLE / 8; j += 32 * NWAVES * 64) { const int i = i0 + j; const f32x4 v0 = __builtin_nontemporal_load((const f32x4*)(p + (size_t)i * 8)), v1 = __builtin_nontemporal_load((const f32x4*)(p + (size_t)i * 8 + 4));
        v4u o; o.x = cvtpk(v0[0], v0[1]); o.y = cvtpk(v0[2], v0[3]); o.z = cvtpk(v1[0], v1[1]); o.w = cvtpk(v1[2], v1[3]); *(v4u*)(pb + (size_t)i * 8) = o; }
}

__device__ __forceinline__ float lane_up(float v, int lane, int o) { return __int_as_float(__builtin_amdgcn_ds_bpermute((lane - o) << 2, __float_as_int(v))); }
__device__ __forceinline__ void cumsum_task(const float* lf, float* cb, LAS float* red, int vcu, int tid) {
    const int b = vcu >> 5, r = vcu & 31, h = r & 7, qd = r >> 3, lane = tid & 63, wave = tid >> 6;
    const float* src = lf + ((size_t)b * SEQ) * 8 + h;
    float pre = 0.f, v[4];
    { float pv[3][4];
#pragma unroll
      for (int q = 0; q < 3; ++q)
#pragma unroll
          for (int i = 0; i < 4; ++i) pv[q][i] = (q < qd) ? src[(size_t)(q * 2048 + tid * 4 + i) * 8] : 0.f;
#pragma unroll
      for (int i = 0; i < 4; ++i) v[i] = src[(size_t)(qd * 2048 + tid * 4 + i) * 8];
#pragma unroll
      for (int q = 0; q < 3; ++q) pre += (pv[q][0] + pv[q][1]) + (pv[q][2] + pv[q][3]); }
    v[1] += v[0]; v[2] += v[1]; v[3] += v[2];
    float x = v[3];
#pragma unroll
    for (int o = 1; o < 64; o <<= 1) { const float y = lane_up(x, lane, o); if (lane >= o) x += y; }
    pre = wave_sum(pre, lane);
    if (lane == 63) red[wave] = x;
    if (lane == 0) red[8 + wave] = pre;
    __syncthreads();
    float off = 0.f;
#pragma unroll
    for (int w = 0; w < 8; ++w) { off += red[8 + w]; if (w < wave) off += red[w]; }
    off += x - v[3];
    *(f32x4*)(cb + (size_t)(b * 8 + h) * SEQ + qd * 2048 + tid * 4) = (f32x4){(off + v[0]) * LOG2E, (off + v[1]) * LOG2E, (off + v[2]) * LOG2E, (off + v[3]) * LOG2E};
    __syncthreads();
}
__device__ __forceinline__ void fill_img(LAS unsigned char* img, const bf16* g, int t256) {
#pragma unroll
    for (int i = 0; i < 4; ++i) { const int idx = t256 + 256 * i, row = idx >> 3, ch = idx & 7;
        *(LAS v4u*)(img + (ch >> 2) * 8192 + row * 64 + (ch & 3) * 16) = *(const v4u*)(g + (size_t)row * DM + ch * 8); }
}
#define RG_PREF(KR, VR, goff) do { _Pragma("unroll") for (int i_ = 0; i_ < 4; ++i_) { const int idx_ = t256 + 256 * i_, row_ = idx_ >> 3, ch_ = idx_ & 7; \
        KR[i_] = *(const v4u*)(KK + (goff) + (size_t)row_ * DM + ch_ * 8); VR[i_] = *(const v4u*)(VV + (goff) + (size_t)row_ * DM + ch_ * 8); } } while (0)
#define RG_PUT(KR, VR) do { _Pragma("unroll") for (int i_ = 0; i_ < 4; ++i_) { const int idx_ = t256 + 256 * i_, row_ = idx_ >> 3, ch_ = idx_ & 7; \
        *(LAS v4u*)(base + (ch_ >> 2) * 8192 + row_ * 64 + (ch_ & 3) * 16) = KR[i_]; *(LAS v4u*)(base + 16384 + (ch_ >> 2) * 8192 + row_ * 64 + (ch_ & 3) * 16) = VR[i_]; } } while (0)
#define RG_STATE(ACC) do { _Pragma("unroll") for (int s_ = 0; s_ < 8; ++s_) ACC = MFMA32(cat8(trd(va + s_ * 1024), trd(va + s_ * 1024 + 256)), cat8(trd(ka + s_ * 1024), trd(ka + s_ * 1024 + 256)), ACC); } while (0)
__device__ __forceinline__ void ret_group_state(LAS unsigned char* ldsl, const bf16* KK, const bf16* VV, float* AG, int bx, int tid) {
    const int lane = tid & 63, wave = __builtin_amdgcn_readfirstlane(tid >> 6), h2 = wave >> 2, w4 = wave & 3, t256 = tid & 255;
    const int r32 = lane & 31, hi = lane >> 5, g1 = (lane >> 4) & 1, q = (lane & 15) >> 2, p = lane & 3;
    LAS unsigned char* base = ldsl + h2 * 32768;
    const int uid = 2 * bx + h2, bh = uid >> 3, g = uid & 7, b = bh >> 3, h = bh & 7, eb = w4 & 1, db = w4 >> 1;
    const size_t goff0 = ((size_t)b * SEQ + (size_t)g * 1024) * DM + 512 + h * 64;
    LAS unsigned char* va = base + 16384 + eb * 8192 + (8 * hi + q) * 64 + g1 * 32 + p * 8;
    LAS unsigned char* ka = base + db * 8192 + (8 * hi + q) * 64 + g1 * 32 + p * 8;
    const float g128 = __builtin_amdgcn_exp2f(128.0f * pg8::lg2gamma(h));
    v4u kr[4], vr[4];
    RG_PREF(kr, vr, goff0); RG_PUT(kr, vr); RG_PREF(kr, vr, goff0 + (size_t)128 * DM);
    __syncthreads();
    f32x16 acc; for (int i = 0; i < 16; ++i) acc[i] = 0.f;
#pragma unroll 1
    for (int i = 0; i < 8; ++i) {
        RG_STATE(acc);
#pragma unroll
        for (int r = 0; r < 16; ++r) acc[r] *= g128;
        __syncthreads();
        if (i < 7) { RG_PUT(kr, vr); if (i < 6) RG_PREF(kr, vr, goff0 + (size_t)(i + 2) * 128 * DM); __syncthreads(); }
    }
    float* up = AG + (size_t)uid * 4096 + (32 * db + r32) * 64 + 32 * eb + 4 * hi;
#pragma unroll
    for (int gg = 0; gg < 4; ++gg) *(pg8::f32x4*)(up + 8 * gg) = (pg8::f32x4){acc[4 * gg], acc[4 * gg + 1], acc[4 * gg + 2], acc[4 * gg + 3]};
}
__device__ __forceinline__ void qknorm_task(const float* nrm, unsigned* qk, int gw, int NGW, int lane) {
    for (int blk = gw; blk < M / 32; blk += NGW) {
        float mq = 0.f, mk = 0.f;
#pragma unroll
        for (int i = 0; i < 4; ++i) { const int rh = (blk * 32 + i * 8) * 8 + lane;
            const f32x2_ a = *(const f32x2_*)(nrm + (size_t)rh * 2), k = *(const f32x2_*)(nrm + (size_t)M * 16 + (size_t)rh * 2);
            mq = fmaxf(mq, a.x + a.y); mk = fmaxf(mk, k.x + k.y); }
        mq = fmaxf(mq, bpx(mq, lane, 8)); mq = fmaxf(mq, bpx(mq, lane, 16)); mq = fmaxf(mq, bpx(mq, lane, 32));
        mk = fmaxf(mk, bpx(mk, lane, 8)); mk = fmaxf(mk, bpx(mk, lane, 16)); mk = fmaxf(mk, bpx(mk, lane, 32));
        if (lane < 8) { const int bh = ((blk * 32) >> 13) * 8 + lane;
            atomicMax(qk + 2 * bh, __float_as_uint(sqrtf(mq))); atomicMax(qk + 2 * bh + 1, __float_as_uint(sqrtf(mk))); }
    }
}
__device__ __forceinline__ void ret_group_out(LAS unsigned char* ldsl, const bf16* QO, bf16* OUT, const bf16* KK, const bf16* VV, const bf16* Gt, const float* AG, int bx, int tid) {
    const int lane = tid & 63, wave = __builtin_amdgcn_readfirstlane(tid >> 6), h2 = wave >> 2, w4 = wave & 3, qb = w4, t256 = tid & 255;
    const int r32 = lane & 31, hi = lane >> 5, g1 = (lane >> 4) & 1, q = (lane & 15) >> 2, p = lane & 3;
    LAS unsigned char* base = ldsl + h2 * 59392;
    LAS unsigned char* simg = base + 32768;
    LAS unsigned char* stg = base + 40960 + qb * 4608;
    const int uid = 2 * bx + h2, bh = uid >> 3, g = uid & 7, b = bh >> 3, h = bh & 7, eb = w4 & 1, db = w4 >> 1;
    const size_t grow00 = (size_t)b * SEQ + (size_t)g * 1024; const int colh = 512 + h * 64;
    const size_t goff0 = grow00 * DM + colh;
    LAS unsigned char* va = base + 16384 + eb * 8192 + (8 * hi + q) * 64 + g1 * 32 + p * 8;
    LAS unsigned char* ka = base + db * 8192 + (8 * hi + q) * 64 + g1 * 32 + p * 8;
    LAS unsigned char* vb = base + 16384 + (4 * hi + q) * 64 + g1 * 32 + p * 8;
    const float lg = pg8::lg2gamma(h), g128 = __builtin_amdgcn_exp2f(128.0f * lg);
    v4u kr[4], vr[4];
    RG_PREF(kr, vr, goff0);
    bf16x8 qf[4];
#pragma unroll
    for (int ks = 0; ks < 4; ++ks) qf[ks] = *(const bf16x8*)(QO + (grow00 + 32 * qb + r32) * DM + colh + 16 * ks + 8 * hi);
    f32x16 sacc; for (int i = 0; i < 16; ++i) sacc[i] = 0.f;
    { const float* ap0 = AG + (size_t)(bh * 8) * 4096 + (32 * db + r32) * 64 + 32 * eb + 4 * hi;
#pragma unroll
      for (int bt = 0; bt < 4; ++bt) { pg8::f32x4 av[2][4];
#pragma unroll
          for (int k = 0; k < 2; ++k) { const int gp = 2 * bt + k;
#pragma unroll
              for (int gg = 0; gg < 4; ++gg) av[k][gg] = (gp < g) ? *(const pg8::f32x4*)(ap0 + (size_t)(gp < g ? gp : 0) * 4096 + 8 * gg) : (pg8::f32x4){0.f, 0.f, 0.f, 0.f}; }
#pragma unroll
          for (int k = 0; k < 2; ++k) { const int gp = 2 * bt + k; const float wgt = (gp < g) ? __builtin_amdgcn_exp2f((float)(g - 1 - gp) * 1024.0f * lg) : 0.f;
#pragma unroll
              for (int gg = 0; gg < 4; ++gg)
#pragma unroll
                  for (int j = 0; j < 4; ++j) sacc[4 * gg + j] += wgt * av[k][gg][j]; } } }
    RG_PUT(kr, vr);
    RG_PREF(kr, vr, goff0 + (size_t)128 * DM);
#pragma unroll 1
    for (int i = 0; i < 8; ++i) {
        const size_t grow0 = grow00 + (size_t)i * 128;
#pragma unroll
        for (int r = 0; r < 16; ++r) *(LAS unsigned short*)(simg + (32 * eb + crow16(r, hi)) * 128 + (32 * db + r32) * 2) = (unsigned short)(cvtpk(sacc[r], 0.f) & 0xffffu);
        __syncthreads();
        bf16x8 qn[4]; v4u gv[4];
        if (i < 7) {
#pragma unroll
            for (int ks = 0; ks < 4; ++ks) qn[ks] = *(const bf16x8*)(QO + (grow0 + 128 + 32 * qb + r32) * DM + colh + 16 * ks + 8 * hi); }
#pragma unroll
        for (int j = 0; j < 4; ++j) gv[j] = *(const v4u*)(Gt + (grow0 + 32 * qb + j * 8 + (lane >> 3)) * 512 + h * 64 + (lane & 7) * 8);
        f32x16 o0, o1;
#if PROBE_RG == 1
        f32x16 sacc_keep = sacc;
        for (int prb = 0; prb < 2; ++prb) { sacc = sacc_keep; asm volatile("" : "+v"(sacc));
#endif
        for (int r = 0; r < 16; ++r) { o0[r] = 0.f; o1[r] = 0.f; }
#pragma unroll
        for (int kb = 0; kb < 4; ++kb) if (kb <= qb) {
            f32x16 st; for (int r = 0; r < 16; ++r) st[r] = 0.f;
#pragma unroll
            for (int ks = 0; ks < 4; ++ks) st = MFMA32(*(const LAS bf16x8*)(base + (ks >> 1) * 8192 + (32 * kb + r32) * 64 + (16 * (ks & 1) + 8 * hi) * 2), qf[ks], st);
            if (kb == qb) {
#pragma unroll
                for (int r = 0; r < 16; ++r) if (crow16(r, hi) > r32) st[r] = 0.f;
            }
#pragma unroll
            for (int s = 0; s < 2; ++s) { v4u w; w.x = cvtpk(st[8 * s], st[8 * s + 1]); w.y = cvtpk(st[8 * s + 2], st[8 * s + 3]); w.z = cvtpk(st[8 * s + 4], st[8 * s + 5]); w.w = cvtpk(st[8 * s + 6], st[8 * s + 7]);
                const bf16x8 pk = __builtin_bit_cast(bf16x8, w); LAS unsigned char* vr_ = vb + (32 * kb + 16 * s) * 64;
                o0 = MFMA32(cat8(trd(vr_), trd(vr_ + 512)), pk, o0); o1 = MFMA32(cat8(trd(vr_ + 8192), trd(vr_ + 8192 + 512)), pk, o1); }
        }
#pragma unroll
        for (int ks = 0; ks < 4; ++ks) { o0 = MFMA32(*(const LAS bf16x8*)(simg + r32 * 128 + (16 * ks + 8 * hi) * 2), qf[ks], o0); o1 = MFMA32(*(const LAS bf16x8*)(simg + (32 + r32) * 128 + (16 * ks + 8 * hi) * 2), qf[ks], o1); }
        RG_STATE(sacc);
#pragma unroll
        for (int r = 0; r < 16; ++r) sacc[r] *= g128;
#if PROBE_RG == 1
        }
#endif
        __syncthreads();
        if (i < 7) RG_PUT(kr, vr);
        if (i < 6) RG_PREF(kr, vr, goff0 + (size_t)(i + 2) * 128 * DM);
#if PROBE_RG == 2
        for (int prb = 0; prb < 2; ++prb) { asm volatile("" : "+v"(o0), "+v"(o1));
#endif
        float sm = 0.f;
#pragma unroll
        for (int r = 0; r < 16; ++r) sm += o0[r] + o1[r];
        sm = pg8::halves_sum(sm); const float mu = sm * (1.0f / 64.0f); float vs = 0.f;
#pragma unroll
        for (int r = 0; r < 16; ++r) { const float d0 = o0[r] - mu, d1 = o1[r] - mu; vs += d0 * d0 + d1 * d1; }
        vs = pg8::halves_sum(vs); const float rstd = __builtin_amdgcn_rsqf(vs * (1.0f / 64.0f) + 1e-5f);
        typedef unsigned u32x2_ __attribute__((ext_vector_type(2)));
#pragma unroll
        for (int gg = 0; gg < 4; ++gg) {
            u32x2_ w0, w1; w0.x = cvtpk((o0[4 * gg] - mu) * rstd, (o0[4 * gg + 1] - mu) * rstd); w0.y = cvtpk((o0[4 * gg + 2] - mu) * rstd, (o0[4 * gg + 3] - mu) * rstd);
            w1.x = cvtpk((o1[4 * gg] - mu) * rstd, (o1[4 * gg + 1] - mu) * rstd); w1.y = cvtpk((o1[4 * gg + 2] - mu) * rstd, (o1[4 * gg + 3] - mu) * rstd);
            *(LAS u32x2_*)(stg + r32 * 136 + (8 * gg + 4 * hi) * 2) = w0; *(LAS u32x2_*)(stg + r32 * 136 + (32 + 8 * gg + 4 * hi) * 2) = w1; }
        LDS_WAIT(); asm volatile("" ::: "memory");
#pragma unroll
        for (int j = 0; j < 4; ++j) {
            const int row = j * 8 + (lane >> 3), ch = lane & 7; const u32x2_ a = *(LAS u32x2_*)(stg + row * 136 + ch * 16), bq = *(LAS u32x2_*)(stg + row * 136 + ch * 16 + 8);
            const v4u y = (v4u){a.x, a.y, bq.x, bq.y};
            pg8::f32x4 y0, y1, g0, g1_; pg8::unpack8(y, y0, y1); pg8::unpack8(gv[j], g0, g1_);
            *(v4u*)(OUT + (grow0 + 32 * qb + row) * DM + colh + ch * 8) = pg8::pack8(y0 * g0, y1 * g1_); }
        LDS_WAIT(); asm volatile("" ::: "memory");
#if PROBE_RG == 2
        }
#endif
        if (i < 7) {
#pragma unroll
            for (int ks = 0; ks < 4; ++ks) qf[ks] = qn[ks]; }
    }
}
#undef RG_PREF
#undef RG_PUT
#undef RG_STATE
struct FxItem { pg8::f32x4 f0, f1, h1, h2, w0, w1; };
__device__ __forceinline__ void fx_load(FxItem (&it)[3], const float* FIX, const float* HAL, const float* cw, int pm, int tid) {
#pragma unroll
    for (int k = 0; k < 3; ++k) { const int j = tid + k * (NWAVES * 64);
        if (j < 22 * 2 * 32) { const int c4 = (j & 31) * 4, r = (j >> 5) & 1, pn = j >> 6, unit = pm * 22 + pn; const size_t idx = (size_t)unit * 256 + r * 128 + c4; const int colg = pn * 128 + c4;
            it[k].f0 = *(const pg8::f32x4*)(FIX + idx * 2); it[k].f1 = *(const pg8::f32x4*)(FIX + idx * 2 + 4);
            it[k].h1 = *(const pg8::f32x4*)(HAL + ((size_t)(unit - 22) * 2 + 1) * 128 + c4); it[k].h2 = *(const pg8::f32x4*)(HAL + ((size_t)(unit - 22) * 2) * 128 + c4);
            it[k].w0 = *(const pg8::f32x4*)(cw + colg); it[k].w1 = *(const pg8::f32x4*)(cw + FF + colg); } }
}
__device__ __forceinline__ void fx_store(const FxItem (&it)[3], bf16* ACT, int pm, int tid) {
#pragma unroll
    for (int k = 0; k < 3; ++k) { const int j = tid + k * (NWAVES * 64);
        if (j < 22 * 2 * 32) { const int c4 = (j & 31) * 4, r = (j >> 5) & 1, pn = j >> 6, colg = pn * 128 + c4;
            const pg8::f32x4 yp = (pg8::f32x4){it[k].f0[0], it[k].f0[2], it[k].f1[0], it[k].f1[2]}, g = (pg8::f32x4){it[k].f0[1], it[k].f0[3], it[k].f1[1], it[k].f1[3]};
            const pg8::f32x4 y = (r == 0) ? yp + it[k].w1 * it[k].h1 + it[k].w0 * it[k].h2 : yp + it[k].w0 * it[k].h1;
            const pg8::f32x2 ga = pg8::gelu_pk((pg8::f32x2){y[0], y[1]}), gb = pg8::gelu_pk((pg8::f32x2){y[2], y[3]});
            typedef unsigned u32x2_ __attribute__((ext_vector_type(2)));
            u32x2_ o; o.x = cvtpk(ga.x * g[0], ga.y * g[1]); o.y = cvtpk(gb.x * g[2], gb.y * g[3]);
            *(u32x2_*)(ACT + (size_t)(pm * 256 + r) * FF + colg) = o; } }
}
__device__ __forceinline__ void ffn_fixup_own(const float* FIX, const float* HAL, const float* cw, bf16* ACT, const pg8::StaticOrder& S, int tid) {
    pg8::Unit u; int pms[4];
#pragma unroll
    for (int i = 0; i < 4; ++i) pms[i] = S.next(i, u) ? u.pm : 0;
    FxItem a[3], b[3];
    if (pms[0] & 31) fx_load(a, FIX, HAL, cw, pms[0], tid);
    if (pms[1] & 31) fx_load(b, FIX, HAL, cw, pms[1], tid);
    if (pms[0] & 31) fx_store(a, ACT, pms[0], tid);
    if (pms[2] & 31) fx_load(a, FIX, HAL, cw, pms[2], tid);
    if (pms[1] & 31) fx_store(b, ACT, pms[1], tid);
    if (pms[3] & 31) fx_load(b, FIX, HAL, cw, pms[3], tid);
    if (pms[2] & 31) fx_store(a, ACT, pms[2], tid);
    if (pms[3] & 31) fx_store(b, ACT, pms[3], tid);
    VM_WAIT(); __syncthreads();
    __builtin_amdgcn_fence(__ATOMIC_ACQUIRE, "agent");
}
__device__ __forceinline__ void final_task(const bf16* h, float* out, const float* ssq, const float* wf, int vcu, int wave, int lane) {
    constexpr int NGW = 32 * NWAVES; const int gw = (vcu >> 5) * SEQ + (vcu & 31) * NWAVES + wave, mend = ((vcu >> 5) + 1) * SEQ;
    pg8::f32x4 w[4];
#pragma unroll
    for (int j = 0; j < 4; ++j) w[j] = *(const pg8::f32x4*)(wf + (j >> 1) * 512 + lane * 8 + (j & 1) * 4);
    for (int m0 = gw; m0 < mend; m0 += 4 * NGW) {
        v4u hv[4][2]; float rs[4];
#pragma unroll
        for (int k = 0; k < 4; ++k) { const int m = m0 + k * NGW; rs[k] = pg8::row_rstd(ssq, m);
#pragma unroll
            for (int j = 0; j < 2; ++j) hv[k][j] = *(const v4u*)(h + (size_t)m * DM + j * 512 + lane * 8); }
#pragma unroll
        for (int k = 0; k < 4; ++k) { float* o = out + (size_t)(m0 + k * NGW) * DM;
#pragma unroll
            for (int j = 0; j < 2; ++j) { pg8::f32x4 v0, v1; pg8::unpack8(hv[k][j], v0, v1);
                __builtin_nontemporal_store(v0 * rs[k] * w[2 * j], (pg8::f32x4*)(o + j * 512 + lane * 8)); __builtin_nontemporal_store(v1 * rs[k] * w[2 * j + 1], (pg8::f32x4*)(o + j * 512 + lane * 8 + 4)); } } }
}

#ifndef STAGGER_TICKS_P7
#define STAGGER_TICKS_P7 0
#endif
__device__ __forceinline__ void stagger_wait(int bx, unsigned ticks) {
    if (ticks && ((bx >> 3) & 1)) { const unsigned long long t0 = __builtin_amdgcn_s_memrealtime(); while (__builtin_amdgcn_s_memrealtime() - t0 < ticks) __builtin_amdgcn_s_sleep(16); }
}
#define PH_BEGIN() int tq = tid_now(wvs); int zq = 0; asm volatile("" : "+v"(tq), "+v"(zq)); int mo_ = MISC_OFF + 44; asm volatile("" : "+v"(mo_));     int bx = __builtin_amdgcn_readfirstlane(*(volatile LAS int*)(ldsl + mo_)); asm volatile("" : "+s"(bx));     GAS unsigned char* wsg_ = (GAS unsigned char*)args.ws; asm volatile("" : "+s"(wsg_)); unsigned char* ws = (unsigned char*)wsg_;     \
    const int lq = tq & 63, wq = __builtin_amdgcn_readfirstlane(tq >> 6), gtq = bx * (NWAVES * 64) + tq, vcu = (G % 8 == 0) ? (bx % 8) * (G / 8) + bx / 8 : bx, gw = vcu * NWAVES + wq; (void)lq; (void)wq; (void)gtq; (void)gw
#ifndef DEPH_ODD
#define DEPH_ODD (bx & 1)
#endif
#define SSQB(n) ((float*)(ws + (((n) & 1) ? WS_SSQ1 : WS_SSQ0)))
__global__ void __launch_bounds__(NWAVES * 64, 2) fwd(Args args) {
    extern __shared__ __attribute__((aligned(16))) unsigned char lds[];
    LAS unsigned char* ldsl = (LAS unsigned char*)lds;
    const int wvs = __builtin_amdgcn_readfirstlane((int)threadIdx.x >> 6);
    volatile LAS unsigned* MISC = (volatile LAS unsigned*)(ldsl + MISC_OFF);
    const int G = gridDim.x;
    const int NGW = G * NWAVES, GT = G * NWAVES * 64;
    for (int u = threadIdx.x; u < (LDS_BYTES - LDSCTL_OFF) / 4; u += NWAVES * 64) ((LAS unsigned*)(ldsl + LDSCTL_OFF))[u] = 0u;
    if (args.ph_lo == 0 && threadIdx.x == 0) {
#pragma unroll
        for (int k = 0; k < 15; ++k) ((unsigned long long*)((unsigned*)(args.ws + WS_CTL) + CW_TAB))[k] = (unsigned long long)args.in[k]; }
    __syncthreads();
#if MK_ONE_LAUNCH
    constexpr int lo = 0, hi = NPH;
#else
    const int lo = args.ph_lo, hi = args.ph_hi;
#endif
    if (threadIdx.x == 0) MISC[11] = blockIdx.x;
    __syncthreads();
    XcdBarrier bar; bar.bar = (unsigned*)(args.ws + WS_CTL) + CW_BAR; bar.x = 0; bar.st = nullptr;
    if (hi - lo > 1) bar = xcd_barrier_post((unsigned*)(args.ws + WS_CTL) + CW_BAR, MISC + 8);
#ifndef ONLY
#define ONLY -1
#endif
#define PON(j) (ONLY < 0 || ONLY == (j))
#define IN(k) (lo <= (k) && (k) < hi)
#define SEAM(k, glob) do { if (IN(k) && IN((k) + 1)) { xcd_barrier(bar, (glob) || !MK_ONE_LAUNCH, wvs); if (PROBE_DUP == 15) xcd_barrier(bar, (glob) || !MK_ONE_LAUNCH, wvs); } } while (0)

    for (int rep = 0; rep < NREP(10); ++rep) if (PON(0) && IN(0)) { PH_BEGIN(); prologue(ws, zq, ldsl, gw, NGW, wq, lq, gtq, GT); }
    SEAM(0, true);

    for (int L = 0; L < DEPTH; ++L) {
        const int p0 = 1 + 9 * L;
        for (int rep = 0; rep < NREP(1); ++rep) if (PON(1) && IN(p0)) {
            PH_BEGIN();
            const bf16* hin = (const bf16*)(ws + ((L == 0) ? WS_HB : WS_HBT));
            flogit_task(hin, (const bf16*)(ws + WS_WFB) + (size_t)L * 8 * DM, SSQB(3 * L), INP(4) + L * NFH, (float*)(ws + WS_LF), G, vcu, wq, lq);
            if DEPH_ODD pb_task(INP(1) + (size_t)L * M * PLE, (bf16*)(ws + WS_PB), vcu, tq);
            pg8::Gemm g{hin, (const bf16*)(ws + WS_W + (size_t)L * W_LAYER + WO_IN), M, NIN, DM}; pg8::StaticOrder S; S.init(M, NIN, G, bx);
            pg8::EpiIn E{(bf16*)(ws + WS_QO), (bf16*)(ws + WS_KK), (bf16*)(ws + WS_VV), (bf16*)(ws + WS_G), SSQB(3 * L), (const float*)(ws + WS_CS), (float*)(ws + WS_NRM)};
            pg8::gemm_phase<pg8::EpiIn, pg8::StaticOrder, PG8_ALIGN, PG8_SP2, PROBE_KDUP == 1, PROBE_EDUP == 1>(ldsl, g, S, E, wvs);
            if (!DEPH_ODD) pb_task(INP(1) + (size_t)L * M * PLE, (bf16*)(ws + WS_PB), vcu, tq);
        }
        SEAM(p0, false);
        for (int rep = 0; rep < NREP(2); ++rep) if (PON(2) && IN(p0 + 1)) {
            PH_BEGIN();
            for (int rp2 = 0; rp2 < NREP(13); ++rp2) { cumsum_task((const float*)(ws + WS_LF), (float*)(ws + WS_CB), (LAS float*)ldsl, vcu, tq);
            qknorm_task((const float*)(ws + WS_NRM), (unsigned*)(ws + WS_CTL) + CW_QK + L * 128, gw, NGW, lq); }
            __syncthreads();
            ret_group_state(ldsl, (const bf16*)(ws + WS_KK), (const bf16*)(ws + WS_VV), (float*)(ws + WS_U), vcu, tq);
        }
        SEAM(p0 + 1, false);
        if (PON(3) && IN(p0 + 2)) {
            PH_BEGIN();
#pragma unroll 1
            for (int rep = 0; rep < NREP(4); ++rep) {
            ret_group_out(ldsl, (const bf16*)(ws + WS_QO), (PROBE_DUP == 4 && rep == 0) ? (bf16*)args.out : (bf16*)(ws + WS_QO), (const bf16*)(ws + WS_KK), (const bf16*)(ws + WS_VV), (const bf16*)(ws + WS_G), (const float*)(ws + WS_U), vcu, tq);
            __syncthreads(); }
            for (int rep = 0; rep < NREP(3); ++rep) {
            const attn_body::AttnTensors AT{(const attn_body::bf16*)(ws + WS_QO), (const attn_body::bf16*)(ws + WS_KK), (const attn_body::bf16*)(ws + WS_VV), (PROBE_DUP == 3 && rep == 0) ? (attn_body::bf16*)args.out : (attn_body::bf16*)(ws + WS_QO)};
            const attn_body::StaticOrder S(G, bx);
            attn_body::attn_phase<attn_body::StaticOrder>((char*)lds, AT, (const float*)(ws + WS_CB), (const float*)(ws + WS_CTL) + CW_QK + L * 128, S, wvs);
            __syncthreads(); }
        }
        SEAM(p0 + 2, false);
        for (int rep = 0; rep < NREP(5); ++rep) if (PON(5) && IN(p0 + 4)) {
            PH_BEGIN(); const bool dmy = (PROBE_DUP == 5 && rep == 0);
            pg8::Gemm g{(const bf16*)(ws + WS_QO), (const bf16*)(ws + WS_W + (size_t)L * W_LAYER + WO_OUT), M, DM, DM}; pg8::StaticOrder S; S.init(M, DM, G, bx);
            pg8::EpiRes<0> E{(const bf16*)(ws + ((L == 0) ? WS_HB : WS_HBT)), (bf16*)(ws + (dmy ? WS_X + 384 * MiB : WS_HB)), dmy ? SSQB(3 * L) : SSQB(3 * L + 1), nullptr, nullptr};
            pg8::gemm_phase<pg8::EpiRes<0>, pg8::StaticOrder, PG8_ALIGN, PG8_SP2, PROBE_KDUP == 5, PROBE_EDUP == 5>(ldsl, g, S, E, wvs);
            { VM_WAIT(); __syncthreads();
              pg8::Gemm g2{(const bf16*)(ws + WS_PB), (const bf16*)(ws + WS_W + (size_t)L * W_LAYER + WO_PROJ), M, DM, PLE}; pg8::StaticOrder S2; S2.init(M, DM, G, bx);
              pg8::EpiScaleBf16<false> E2{PP_BASE, DM, nullptr};
              pg8::gemm_phase<pg8::EpiScaleBf16<false>, pg8::StaticOrder, PG8_ALIGN, PG8_SP2>(ldsl, g2, S2, E2, wvs); }
        }
        SEAM(p0 + 4, false);
        for (int rep = 0; rep < NREP(6); ++rep) if (PON(6) && IN(p0 + 5)) {
            PH_BEGIN();
            pg8::Gemm g{(const bf16*)(ws + WS_HB), (const bf16*)(ws + WS_W + (size_t)L * W_LAYER + WO_A), M, 2 * FF, DM}; pg8::StaticOrder S; S.init(M, 2 * FF, G, bx);
            pg8::EpiFfnUp E{(bf16*)(ws + WS_ACT), SSQB(3 * L + 1), INP(8) + (size_t)L * 3 * FF, INP(9) + (size_t)L * FF, (float*)(ws + WS_FIX), (float*)(ws + WS_HAL), (LAS float*)(ldsl + LDSCTL_OFF + 1024)};
            pg8::gemm_phase<pg8::EpiFfnUp, pg8::StaticOrder, true, PG8_SP2, PROBE_KDUP == 6, PROBE_EDUP == 6>(ldsl, g, S, E, wvs);
        }
        SEAM(p0 + 5, false);
        if (PON(8) && IN(p0 + 7)) {
            PH_BEGIN();
            pg8::Gemm g{(const bf16*)(ws + WS_ACT), (const bf16*)(ws + WS_W + (size_t)L * W_LAYER + WO_DOWN), M, DM, FF}; pg8::StaticOrder S; S.init(M, DM, G, bx, 1);
            ffn_fixup_own((const float*)(ws + WS_FIX), (const float*)(ws + WS_HAL), INP(8) + (size_t)L * 3 * FF, (bf16*)(ws + WS_ACT), S, tq);
            pg8::EpiRes<0> E{(const bf16*)(ws + WS_HB), (bf16*)(ws + WS_HB), SSQB(3 * L + 2), nullptr, nullptr};
            pg8::gemm_phase<pg8::EpiRes<0>, pg8::StaticOrder, PG8_ALIGN, PG8_SP2, PROBE_KDUP == 8, PROBE_EDUP == 8>(ldsl, g, S, E, wvs);
        }
        SEAM(p0 + 7, false);
        if (PON(9) && IN(p0 + 8) && L + 1 < DEPTH) { PH_BEGIN(); if DEPH_ODD { convert_layer(ws, zq, ldsl, L + 1, gw, NGW, wq, lq); __syncthreads(); } }
        for (int rep = 0; rep < NREP(9); ++rep) if (PON(9) && IN(p0 + 8)) {
            PH_BEGIN(); const bool dmy = (PROBE_DUP == 9 && rep == 0);
            pg8::Gemm g{(const bf16*)(ws + WS_HB), (const bf16*)(ws + WS_W + (size_t)L * W_LAYER + WO_GATE), M, DM, DM}; pg8::StaticOrder S; S.init(M, DM, G, bx);
            pg8::EpiRes<1> E{(const bf16*)(ws + WS_HB), (bf16*)(ws + (dmy ? WS_X + 384 * MiB : WS_HBT)), dmy ? (float*)(ws + WS_X + 512 * MiB) : SSQB(3 * L + 3), SSQB(3 * L + 2), PP_BASE};
            pg8::gemm_phase<pg8::EpiRes<1>, pg8::StaticOrder, PG8_ALIGN, PG8_SP2, PROBE_KDUP == 9, PROBE_EDUP == 9>(ldsl, g, S, E, wvs);
        }
        if (PON(9) && IN(p0 + 8) && L + 1 < DEPTH) { PH_BEGIN(); if (!DEPH_ODD) { __syncthreads(); convert_layer(ws, zq, ldsl, L + 1, gw, NGW, wq, lq); __syncthreads(); } }
        SEAM(p0 + 8, L + 1 < DEPTH);
    }
    if (PON(10) && IN(NPH - 1)) { PH_BEGIN(); final_task((const bf16*)(ws + WS_HBT), args.out, SSQB(3 * DEPTH), INP(14), vcu, wq, lq); }
#undef IN
#undef SEAM
}

extern "C" void kernel_launch(void* const* d_in, const int* in_sizes, int n_in, void* d_out, int out_size, void* d_ws, size_t ws_size, hipStream_t stream) {
    static int grid = 0;
    if (grid == 0) {
        if (n_in != 15 || out_size != M * DM || ws_size < WS_END) { fprintf(stderr, "kernel_launch: unexpected sizes (n_in %d, out %d, ws %zu)\n", n_in, out_size, ws_size); grid = -1; return; }
        if (hipFuncSetAttribute((const void*)fwd, hipFuncAttributeMaxDynamicSharedMemorySize, LDS_BYTES) != hipSuccess) { fprintf(stderr, "kernel_launch: hipFuncSetAttribute failed\n"); grid = -1; return; }
        int dev = 0, cus = 0, per_cu = 0;
        (void)hipGetDevice(&dev); (void)hipDeviceGetAttribute(&cus, hipDeviceAttributeMultiprocessorCount, dev);
        if (hipOccupancyMaxActiveBlocksPerMultiprocessor(&per_cu, (const void*)fwd, NWAVES * 64, LDS_BYTES) != hipSuccess || per_cu < 1) fprintf(stderr, "kernel_launch: occupancy query says %d\n", per_cu);
        (void)hipGetLastError();
        grid = 256;
        if (cus != 256) fprintf(stderr, "kernel_launch: device has %d CUs; this kernel's unit maps are built for 256\n", cus);
    }
    if (grid < 0) return;
    (void)hipMemsetAsync((char*)d_ws + WS_CTL, 0, CTL_ZERO_BYTES, stream);
    Args a{};
    for (int i = 0; i < 15; ++i) a.in[i] = (const float*)d_in[i];
    a.out = (float*)d_out; a.ws = (unsigned char*)d_ws;
#if MK_ONE_LAUNCH
    a.ph_lo = 0; a.ph_hi = NPH;
    hipLaunchKernelGGL(fwd, dim3(grid), dim3(NWAVES * 64), LDS_BYTES, stream, a);
#else
    for (int ph = 0; ph < NPH; ++ph) { a.ph_lo = ph; a.ph_hi = ph + 1; hipLaunchKernelGGL(fwd, dim3(grid), dim3(NWAVES * 64), LDS_BYTES, stream, a); }
#endif
}
```
